# Optimizing an MI355X kernel written in HIP

```python
import math
import jax, jax.numpy as jnp
from jax import lax
import numpy as np

D_MODEL = 1024
BATCH = 32
SEQ = 256
DEPTH = 2
DEC_BATCH = 8
DEC_SEQ = 2048
PAST_LEN = 256

GRID_W = 64
HEAD_DIM = 64
N_HEADS_A = 8
N_KV_A = 2
N_HEADS_B = 8
N_KV_CACHE = N_KV_A + N_HEADS_B
WIN_R = 8
WIN_C = 16
Q_BLOCK = 128
ROPE_THETA = 10000.0
N_HEADS_C = 8
DK_C = 128
DV_C = 128
CONV_K = 3
CHUNK = 64
D_FF = 4 * D_MODEL
N_MOD = 6
EPS = 1e-6
ATTN_IN = (N_HEADS_A + 2 * N_KV_A + 3 * N_HEADS_B) * HEAD_DIM
ATTN_OUT = (N_HEADS_A + N_HEADS_B) * HEAD_DIM
DELTA_QKV = N_HEADS_C * (2 * DK_C + DV_C)
DELTA_OUT = N_HEADS_C * DV_C
DELTA_IN = DELTA_QKV + DELTA_OUT + 4 * N_HEADS_C

kernel_name = 'hybrid_diffusion_prefix_step'


def split_last(x, sizes):
    offs, acc = [], 0
    for s in sizes[:-1]:
        acc += s
        offs.append(acc)
    return jnp.split(x, offs, axis=-1)


def rms_norm(x, g):
    xf = x.astype(jnp.float32)
    y = xf * lax.rsqrt(jnp.mean(xf * xf, axis=-1, keepdims=True) + EPS)
    return (y * g.astype(jnp.float32)).astype(x.dtype)


def l2_normalize(x):
    return x * lax.rsqrt(jnp.sum(x * x, axis=-1, keepdims=True) + EPS)


def modulation(cvec, w, b):
    m = jax.nn.silu(cvec) @ w + b
    return jnp.split(m[:, None, :], N_MOD, axis=-1)


def squared_relu_mlp(h, w1, w2):
    return jnp.square(jax.nn.relu(h @ w1)) @ w2


def axial_rope_tables(T, dtype):
    t = jnp.arange(T, dtype=jnp.int32)
    pos = jnp.stack([t // GRID_W, t % GRID_W], axis=-1).astype(jnp.float32)
    axis_dim = HEAD_DIM // 2
    inv_freq = 1.0 / (ROPE_THETA ** (jnp.arange(0, axis_dim, 2, dtype=jnp.float32) / axis_dim))
    ang = pos[:, :, None] * inv_freq
    return jnp.cos(ang).astype(dtype), jnp.sin(ang).astype(dtype)


def apply_axial_rope(x, cos, sin):
    B, T, H, _ = x.shape
    xs = x.reshape(B, T, H, 2, 2, HEAD_DIM // 4)
    x1, x2 = xs[..., 0, :], xs[..., 1, :]
    c = cos[None, :, None]
    s = sin[None, :, None]
    out = jnp.stack([x1 * c - x2 * s, x2 * c + x1 * s], axis=-2)
    return out.reshape(B, T, H, HEAD_DIM)


def blocked_attention(q, k, v):
    B, T = q.shape[:2]
    nb = T // Q_BLOCK
    qb = jnp.swapaxes(q.reshape(B, nb, Q_BLOCK, *q.shape[2:]), 0, 1)
    scale = HEAD_DIM ** -0.5

    def one_block(qi):
        s = jnp.einsum('bqkgd,bskd->bkgqs', qi, k).astype(jnp.float32) * scale
        p = jax.nn.softmax(s, axis=-1).astype(v.dtype)
        return jnp.einsum('bkgqs,bskd->bqkgd', p, v)

    o = lax.map(one_block, qb)
    return jnp.swapaxes(o, 0, 1).reshape(q.shape)


def neighbourhood_attention(q, k, v, k_ctx, v_ctx, rel_bias):
    B, T, H, hd = q.shape
    rows = T // GRID_W
    wr = min(WIN_R, rows)
    qg = q.reshape(B, rows, GRID_W, H, hd)
    kg = k.reshape(B, rows, GRID_W, H, hd)
    vg = v.reshape(B, rows, GRID_W, H, hd)
    cols = jnp.arange(GRID_W, dtype=jnp.int32)
    col_start = jnp.clip(cols - WIN_C // 2, 0, GRID_W - WIN_C)
    col_idx = col_start[:, None] + jnp.arange(WIN_C, dtype=jnp.int32)
    col_off = col_idx - cols[:, None] + (WIN_C - 1)
    n_loc = wr * WIN_C
    scale = hd ** -0.5

    def row_block(r):
        rs = jnp.clip(r - wr // 2, 0, rows - wr)
        kb = lax.dynamic_slice_in_dim(kg, rs, wr, axis=1)
        vb = lax.dynamic_slice_in_dim(vg, rs, wr, axis=1)
        kn = kb[:, :, col_idx]
        vn = vb[:, :, col_idx]
        qr = lax.dynamic_index_in_dim(qg, r, axis=1, keepdims=False)
        row_off = rs + jnp.arange(wr, dtype=jnp.int32) - r + (WIN_R - 1)
        bias = rel_bias[:, row_off][:, :, col_off].astype(jnp.float32)
        s_loc = jnp.einsum('bqhd,brqwhd->bhqrw', qr, kn).astype(jnp.float32) * scale
        s_loc = s_loc + jnp.transpose(bias, (0, 2, 1, 3))[None]
        s_ctx = jnp.einsum('bqhd,bphd->bhqp', qr, k_ctx).astype(jnp.float32) * scale
        s = jnp.concatenate([s_loc.reshape(B, H, GRID_W, n_loc), s_ctx], axis=-1)
        p = jax.nn.softmax(s, axis=-1).astype(v.dtype)
        p_loc = p[..., :n_loc].reshape(B, H, GRID_W, wr, WIN_C)
        p_ctx = p[..., n_loc:]
        return (jnp.einsum('bhqrw,brqwhd->bqhd', p_loc, vn)
                + jnp.einsum('bhqp,bphd->bqhd', p_ctx, v_ctx))

    out = lax.map(row_block, jnp.arange(rows, dtype=jnp.int32))
    return jnp.transpose(out, (1, 0, 2, 3, 4)).reshape(B, T, H, hd)


def attn_project(h, w_in, qn_a, kn_a, qn_b, kn_b):
    B, T, _ = h.shape
    sizes = tuple(n * HEAD_DIM for n in (N_HEADS_A, N_KV_A, N_KV_A, N_HEADS_B, N_HEADS_B, N_HEADS_B))
    parts = [p.reshape(B, T, -1, HEAD_DIM) for p in split_last(h @ w_in, sizes)]
    q_a, k_a, v_a, q_b, k_b, v_b = parts
    return (rms_norm(q_a, qn_a), rms_norm(k_a, kn_a), v_a,
            rms_norm(q_b, qn_b), rms_norm(k_b, kn_b), v_b)


def attn_mixer_context(h, w_in, qn_a, kn_a, qn_b, kn_b, w_out):
    B, T, _ = h.shape
    q_a, k_a, v_a, q_b, k_b, v_b = attn_project(h, w_in, qn_a, kn_a, qn_b, kn_b)
    o_a = blocked_attention(q_a.reshape(B, T, N_KV_A, N_HEADS_A // N_KV_A, HEAD_DIM), k_a, v_a)
    o_b = blocked_attention(q_b[:, :, :, None, :], k_b, v_b)
    o = jnp.concatenate([o_a.reshape(B, T, -1), o_b.reshape(B, T, -1)], axis=-1)
    return (o @ w_out, jnp.concatenate([k_a, k_b], axis=2), jnp.concatenate([v_a, v_b], axis=2))


def attn_mixer_latent(h, ctx_k, ctx_v, w_in, qn_a, kn_a, qn_b, kn_b, rel_bias, w_out):
    B, T, _ = h.shape
    q_a, k_a, v_a, q_b, k_b, v_b = attn_project(h, w_in, qn_a, kn_a, qn_b, kn_b)
    cos, sin = axial_rope_tables(T, h.dtype)
    q_a = apply_axial_rope(q_a, cos, sin)
    k_a = apply_axial_rope(k_a, cos, sin)
    k_all = jnp.concatenate([k_a, ctx_k[:, :, :N_KV_A]], axis=1)
    v_all = jnp.concatenate([v_a, ctx_v[:, :, :N_KV_A]], axis=1)
    o_a = blocked_attention(q_a.reshape(B, T, N_KV_A, N_HEADS_A // N_KV_A, HEAD_DIM), k_all, v_all)
    o_b = neighbourhood_attention(q_b, k_b, v_b, ctx_k[:, :, N_KV_A:], ctx_v[:, :, N_KV_A:], rel_bias)
    o = jnp.concatenate([o_a.reshape(B, T, -1), o_b.reshape(B, T, -1)], axis=-1)
    return o @ w_out


def centred_depthwise_conv(x, w):
    K = w.shape[0]
    return lax.conv_general_dilated(x, w.astype(x.dtype)[:, None, :], window_strides=(1,),
                                    padding=[((K - 1) // 2, K // 2)],
                                    dimension_numbers=('NWC', 'WIO', 'NWC'),
                                    feature_group_count=x.shape[-1])


def gated_delta_chunked(q, k, v, log_a, beta, s0):
    B, T, H, _ = q.shape
    DV = v.shape[-1]
    N = T // CHUNK

    def to_chunks(x):
        x = x.reshape(B, N, CHUNK, H, *x.shape[3:])
        return jnp.moveaxis(jnp.moveaxis(x, 1, 0), 3, 2)

    qc, kc, vc = to_chunks(q), to_chunks(k), to_chunks(v)
    bc = to_chunks(beta)
    g = jnp.cumsum(to_chunks(log_a), axis=-1)
    incl = jnp.tril(jnp.ones((CHUNK, CHUNK), dtype=bool))
    strict = jnp.tril(jnp.ones((CHUNK, CHUNK), dtype=bool), -1)
    diff = g[..., :, None] - g[..., None, :]
    decay = jnp.where(incl, jnp.exp(jnp.where(incl, diff, 0.0)), 0.0)
    kbeta = kc * bc[..., None]
    a_mat = jnp.where(strict, jnp.einsum('nbhid,nbhjd->nbhij', kbeta, kc) * decay, 0.0)
    m = a_mat + jnp.eye(CHUNK, dtype=a_mat.dtype)
    u = lax.linalg.triangular_solve(m, vc * bc[..., None], left_side=True, lower=True, unit_diagonal=True)
    w = lax.linalg.triangular_solve(m, kbeta * jnp.exp(g)[..., None], left_side=True, lower=True,
                                    unit_diagonal=True)

    def step(s, inp):
        qi, ki, ui, wi, gi, di = inp
        v_new = ui - jnp.einsum('bhck,bhkv->bhcv', wi, s)
        att = jnp.einsum('bhik,bhjk->bhij', qi, ki) * di
        o = (jnp.einsum('bhck,bhkv->bhcv', qi * jnp.exp(gi)[..., None], s)
             + jnp.einsum('bhij,bhjv->bhiv', att, v_new))
        g_last = gi[..., -1:]
        s = (s * jnp.exp(g_last)[..., None]
             + jnp.einsum('bhck,bhcv->bhkv', ki * jnp.exp(g_last - gi)[..., None], v_new))
        return s, o

    s_fin, o = lax.scan(step, s0, (qc, kc, u, w, g, decay))
    o = jnp.moveaxis(jnp.moveaxis(o, 2, 3), 0, 1).reshape(B, T, H, DV)
    return o, s_fin


def delta_project(h, w_in, conv_w, a_log, dt_bias):
    B, T, _ = h.shape
    qkv, z, ab = split_last(h @ w_in, (DELTA_QKV, DELTA_OUT, 4 * N_HEADS_C))
    qkv = jax.nn.silu(centred_depthwise_conv(qkv, conv_w))
    q, k, v = split_last(qkv, (N_HEADS_C * DK_C, N_HEADS_C * DK_C, N_HEADS_C * DV_C))
    q = l2_normalize(q.reshape(B, T, N_HEADS_C, DK_C).astype(jnp.float32)) * (DK_C ** -0.5)
    k = l2_normalize(k.reshape(B, T, N_HEADS_C, DK_C).astype(jnp.float32))
    v = v.reshape(B, T, N_HEADS_C, DV_C).astype(jnp.float32)
    ab = ab.astype(jnp.float32).reshape(B, T, 2, 2, N_HEADS_C)
    log_a = -jnp.exp(a_log.astype(jnp.float32)) * jax.nn.softplus(ab[:, :, 0] + dt_bias.astype(jnp.float32))
    beta = jax.nn.sigmoid(ab[:, :, 1])
    return q, k, v, z, log_a, beta


def bidirectional_delta(q, k, v, log_a, beta, s0_f, s0_b):
    flip = lambda t: jnp.flip(t, axis=1)
    o_f, s_f = gated_delta_chunked(q, k, v, log_a[:, :, 0], beta[:, :, 0], s0_f)
    o_b, s_b = gated_delta_chunked(flip(q), flip(k), flip(v), flip(log_a[:, :, 1]), flip(beta[:, :, 1]), s0_b)
    return o_f + flip(o_b), s_f, s_b


def delta_output(o, z, out_norm, w_out):
    B, T = o.shape[:2]
    zh = z.reshape(B, T, N_HEADS_C, DV_C)
    y = rms_norm(o.astype(z.dtype), out_norm) * jax.nn.silu(zh)
    return y.reshape(B, T, DELTA_OUT) @ w_out


def delta_mixer_context(h, w_in, conv_w, a_log, dt_bias, out_norm, w_out):
    q, k, v, z, log_a, beta = delta_project(h, w_in, conv_w, a_log, dt_bias)
    s0 = jnp.zeros((h.shape[0], N_HEADS_C, DK_C, DV_C), jnp.float32)
    o, s_f, s_b = bidirectional_delta(q, k, v, log_a, beta, s0, s0)
    return delta_output(o, z, out_norm, w_out), jnp.stack([s_f, s_b], axis=1)


def delta_mixer_latent(h, state, w_in, conv_w, a_log, dt_bias, out_norm, w_out):
    q, k, v, z, log_a, beta = delta_project(h, w_in, conv_w, a_log, dt_bias)
    st = state.astype(jnp.float32)
    o, _, _ = bidirectional_delta(q, k, v, log_a, beta, st[:, 0], st[:, 1])
    return delta_output(o, z, out_norm, w_out)


def setup_inputs(seed: int = 0) -> dict:
    key = jax.random.key(seed)
    ks = jax.random.split(key, 32)
    nrm = lambda i, shape, scale: jax.random.normal(ks[i], shape, jnp.float32) * scale
    gain = lambda i, n: 1.0 + nrm(i, (n,), 0.05)
    dt = jnp.exp(jax.random.uniform(ks[26], (2, N_HEADS_C), jnp.float32, math.log(1e-3), math.log(1e-1)))
    return {
        'x_prompt': nrm(0, (BATCH, SEQ, D_MODEL), 1.0),
        'x_sample': nrm(1, (DEC_BATCH, DEC_SEQ, D_MODEL), 1.0),
        'c': nrm(2, (DEC_BATCH, D_MODEL), 1.0),
        'cache_l0_k': nrm(3, (DEC_BATCH, PAST_LEN, N_KV_CACHE, HEAD_DIM), 1.0),
        'cache_l0_v': nrm(4, (DEC_BATCH, PAST_LEN, N_KV_CACHE, HEAD_DIM), 1.0),
        'state_l1': nrm(5, (DEC_BATCH, 2, N_HEADS_C, DK_C, DV_C), 0.1),
        'c_ctx': nrm(6, (D_MODEL,), 1.0),
        'l0_mod_w': nrm(7, (D_MODEL, N_MOD * D_MODEL), 0.5 * D_MODEL ** -0.5),
        'l0_mod_b': nrm(8, (N_MOD * D_MODEL,), 0.02),
        'l0_norm1': gain(9, D_MODEL),
        'l0_w_in': nrm(10, (D_MODEL, ATTN_IN), D_MODEL ** -0.5),
        'l0_q_norm_a': gain(11, HEAD_DIM),
        'l0_k_norm_a': gain(12, HEAD_DIM),
        'l0_q_norm_b': gain(13, HEAD_DIM),
        'l0_k_norm_b': gain(14, HEAD_DIM),
        'l0_rel_bias': nrm(15, (N_HEADS_B, 2 * WIN_R - 1, 2 * WIN_C - 1), 0.1),
        'l0_w_out': nrm(16, (ATTN_OUT, D_MODEL), ATTN_OUT ** -0.5),
        'l0_norm2': gain(17, D_MODEL),
        'l0_mlp_w1': nrm(18, (D_MODEL, D_FF), D_MODEL ** -0.5),
        'l0_mlp_w2': nrm(19, (D_FF, D_MODEL), D_FF ** -0.5),
        'l1_mod_w': nrm(20, (D_MODEL, N_MOD * D_MODEL), 0.5 * D_MODEL ** -0.5),
        'l1_mod_b': nrm(21, (N_MOD * D_MODEL,), 0.02),
        'l1_norm1': gain(22, D_MODEL),
        'l1_w_in': nrm(23, (D_MODEL, DELTA_IN), D_MODEL ** -0.5),
        'l1_conv_w': nrm(24, (CONV_K, DELTA_QKV), CONV_K ** -0.5),
        'l1_a_log': jnp.log(jax.random.uniform(ks[25], (2, N_HEADS_C), jnp.float32, 1.0, 16.0)),
        'l1_dt_bias': dt + jnp.log(-jnp.expm1(-dt)),
        'l1_out_norm': gain(27, DV_C),
        'l1_w_out': nrm(28, (DELTA_OUT, D_MODEL), DELTA_OUT ** -0.5),
        'l1_norm2': gain(29, D_MODEL),
        'l1_mlp_w1': nrm(30, (D_MODEL, D_FF), D_MODEL ** -0.5),
        'l1_mlp_w2': nrm(31, (D_FF, D_MODEL), D_FF ** -0.5),
    }


def reference(x_prompt, x_sample, c, cache_l0_k, cache_l0_v, state_l1, c_ctx,
              l0_mod_w, l0_mod_b, l0_norm1, l0_w_in, l0_q_norm_a, l0_k_norm_a, l0_q_norm_b, l0_k_norm_b,
              l0_rel_bias, l0_w_out, l0_norm2, l0_mlp_w1, l0_mlp_w2,
              l1_mod_w, l1_mod_b, l1_norm1, l1_w_in, l1_conv_w, l1_a_log, l1_dt_bias, l1_out_norm,
              l1_w_out, l1_norm2, l1_mlp_w1, l1_mlp_w2):
    common = ((l0_mod_w, l0_mod_b, l0_norm1, l0_norm2, l0_mlp_w1, l0_mlp_w2),
              (l1_mod_w, l1_mod_b, l1_norm1, l1_norm2, l1_mlp_w1, l1_mlp_w2))
    xp, xs = x_prompt, x_sample
    for layer in range(DEPTH):
        mod_w, mod_b, norm1, norm2, mlp_w1, mlp_w2 = common[layer]
        sh1_p, sc1_p, g1_p, sh2_p, sc2_p, g2_p = modulation(c_ctx[None, :], mod_w, mod_b)
        sh1_s, sc1_s, g1_s, sh2_s, sc2_s, g2_s = modulation(c, mod_w, mod_b)
        hp = rms_norm(xp, norm1) * (1 + sc1_p) + sh1_p
        hs = rms_norm(xs, norm1) * (1 + sc1_s) + sh1_s
        if layer % 2 == 0:
            mp, new_k, new_v = attn_mixer_context(hp, l0_w_in, l0_q_norm_a, l0_k_norm_a,
                                                  l0_q_norm_b, l0_k_norm_b, l0_w_out)
            ms = attn_mixer_latent(hs, cache_l0_k, cache_l0_v, l0_w_in, l0_q_norm_a, l0_k_norm_a,
                                   l0_q_norm_b, l0_k_norm_b, l0_rel_bias, l0_w_out)
        else:
            mp, new_s = delta_mixer_context(hp, l1_w_in, l1_conv_w, l1_a_log, l1_dt_bias, l1_out_norm, l1_w_out)
            ms = delta_mixer_latent(hs, state_l1, l1_w_in, l1_conv_w, l1_a_log, l1_dt_bias,
                                    l1_out_norm, l1_w_out)
        xp = xp + g1_p * mp
        xs = xs + g1_s * ms
        xp = xp + g2_p * squared_relu_mlp(rms_norm(xp, norm2) * (1 + sc2_p) + sh2_p, mlp_w1, mlp_w2)
        xs = xs + g2_s * squared_relu_mlp(rms_norm(xs, norm2) * (1 + sc2_s) + sh2_s, mlp_w1, mlp_w2)
    return (xp, xs, new_k, new_v, new_s.astype(x_prompt.dtype))
```

```cpp
#include <hip/hip_runtime.h>
#include <hip/hip_cooperative_groups.h>
#include <cstdio>
namespace cg = cooperative_groups;

#define LAS __attribute__((address_space(3)))
#define DI __device__ __forceinline__
typedef unsigned short bf16_t;
typedef short bf16x8 __attribute__((ext_vector_type(8)));
typedef short s16x4 __attribute__((ext_vector_type(4)));
typedef float f32x2 __attribute__((ext_vector_type(2)));
typedef float f32x4 __attribute__((ext_vector_type(4)));
typedef float f32x16 __attribute__((ext_vector_type(16)));
typedef unsigned u32x2 __attribute__((ext_vector_type(2)));
typedef unsigned u32x4 __attribute__((ext_vector_type(4)));
typedef __bf16 nbf16x2 __attribute__((ext_vector_type(2)));

DI unsigned pk2(float a, float b) { f32x2 v = {a, b}; nbf16x2 r = __builtin_convertvector(v, nbf16x2); return __builtin_bit_cast(unsigned, r); }
DI float bf2f(unsigned short h) { return __builtin_bit_cast(float, (unsigned)h << 16); }
DI float bflo(unsigned w) { return __builtin_bit_cast(float, w << 16); }
DI float bfhi(unsigned w) { return __builtin_bit_cast(float, w & 0xffff0000u); }
DI float sigmoidf_(float x) { return __builtin_amdgcn_rcpf(1.0f + __expf(-x)); }
DI float siluf_(float x) { return x * __builtin_amdgcn_rcpf(1.0f + __expf(-x)); }
DI int opq(int x) { asm volatile("" : "+v"(x)); return x; }

constexpr int NTOK = 24576, NPR = 8192, DM = 1024;
constexpr int MODW = 6144;
constexpr size_t OUT_Y = 0, OUT_NEWK = 25165824, OUT_NEWV = OUT_NEWK + 5242880, OUT_NEWS = OUT_NEWV + 5242880;
constexpr size_t WS_MOD = 0;
constexpr size_t WS_WQKV1 = 1048576;
constexpr size_t WS_WZ1 = WS_WQKV1 + 3328ull * 1024 * 2;
constexpr size_t WS_WOUT1 = WS_WZ1 + 1024ull * 1024 * 2;
constexpr size_t WS_BIG = WS_WOUT1 + 1024ull * 1024 * 2;
constexpr size_t B_WIN0 = WS_BIG, B_WOUT0 = B_WIN0 + 2304ull * 1024 * 2, B_W1_0 = B_WOUT0 + 1024ull * 1024 * 2, B_W2_0 = B_W1_0 + 4096ull * 1024 * 2;
constexpr size_t B_H0 = B_W2_0 + 4096ull * 1024 * 2;
constexpr size_t B_Q = B_H0 + (size_t)NTOK * 1024 * 2;
constexpr size_t B_KS = B_Q + (size_t)NTOK * 1024 * 2;
constexpr size_t B_VTS = B_KS + 8ull * 2304 * 640 * 2;
constexpr size_t B_KP = B_VTS + 8ull * 2304 * 640 * 2;
constexpr size_t B_VTP = B_KP + 8192ull * 640 * 2;
constexpr size_t B_FF0 = B_Q;
constexpr size_t B_QKV1 = WS_BIG;
constexpr size_t B_AB = B_QKV1 + (size_t)NTOK * 3072 * 2;
constexpr size_t B_OF = B_AB + (size_t)NTOK * 32 * 4;
constexpr size_t B_OB = B_OF + (size_t)NTOK * 1024 * 2;
constexpr size_t B_H1 = B_OF;
constexpr size_t B_W1_1 = WS_BIG, B_W2_1 = B_W1_1 + 4096ull * 1024 * 2;
constexpr size_t B_H1B = B_W2_1 + 4096ull * 1024 * 2;
constexpr size_t B_Z = B_H1B + (size_t)NTOK * 1024 * 2;
constexpr size_t B_FF1 = B_Z;
constexpr size_t B_FFL0 = B_H0, B_FFL1 = B_H1B;
constexpr size_t B_PS = B_FFL0 + (size_t)NTOK * 4096 * 2;
constexpr size_t WS_NEED = B_PS + 8192ull * 1024 * 4;
static_assert(B_FFL1 + (size_t)NTOK * 4096 * 2 <= B_PS && B_OB + (size_t)NTOK * 1024 * 2 <= WS_NEED, "ws map (mlp)");
static_assert(B_VTP + 8192ull * 640 * 2 <= WS_NEED && B_FF0 + (size_t)NTOK * 2048 * 2 <= WS_NEED && B_FF1 + (size_t)NTOK * 2048 * 2 <= WS_NEED, "ws map");
static_assert(B_Z + (size_t)NTOK * 1024 * 2 <= B_AB, "z inside dead qkv region");
static_assert(WS_NEED <= 271868064ull, "ws budget");

constexpr int LDS_BYTES = 151552;

struct Params { const float* in[32]; float* out; unsigned char* ws; };

namespace pg8 {
constexpr int BM = 256, BK = 64, HALF = 128, HTB = HALF * BK * 2, STAGE_BYTES = 8 * HTB, NXCD = 8, WGM = 8;
DI int lds_byte(int r, int c) { const int st = (r >> 4) * 2 + (c >> 5), rr = r & 15, cc = c & 31, ob = rr * 64 + cc * 2; return st * 1024 + (ob ^ (((ob >> 9) & 1) << 5)); }
DI void stage_rc(int b, int& R, int& C) { const int st = b / 1024, sb = b % 1024, swz = sb ^ (((sb >> 9) & 1) << 5); R = (st >> 1) * 16 + swz / 64; C = (st & 1) * 32 + (swz % 64) / 2; }
struct Unit { int pm, pn, kofs, nt, mode; };
struct Gemm { const bf16_t* A; const bf16_t* Bt; int lda, ldb, M, N, K; };
struct StaticOrder {
    int nM, nN, nwg, G, c;
    DI void init(int M, int N, int G_, int c_) { nM = M / BM; nN = N / BM; nwg = nM * nN; G = G_; c = c_; }
    DI bool next(int i, Unit& u) const {
        const long L = (long)i * G + c; if (L >= nwg) return false;
        int wgid = (int)L; { const int q = nwg / NXCD, r = nwg % NXCD, xcd = wgid % NXCD, off = wgid / NXCD; wgid = (xcd < r ? xcd * (q + 1) : r * (q + 1) + (xcd - r) * q) + off; }
        const int nig = WGM * nN, gid = wgid / nig, fm = gid * WGM, gsz = (nM - fm) < WGM ? (nM - fm) : WGM;
        u.pm = fm + ((wgid % nig) % gsz); u.pn = (wgid % nig) / gsz; u.kofs = 0; u.nt = 0; u.mode = 0; return true;
    }
};

struct W2Order { int c, ntf;
    DI bool next(int i, Unit& u) const {
        const int x = c & 7, j = c >> 3;
        if (i == 0) { u.pm = 8 * x + (j >> 2); u.pn = j & 3; u.kofs = 0; u.nt = ntf; u.mode = 0; return true; }
        if (i == 1) { const int st = j >> 1; u.pm = 64 + 4 * x + (st >> 2); u.pn = st & 3; u.kofs = (j & 1) * (ntf * 32); u.nt = ntf / 2; u.mode = j & 1; return true; }
        return false; } };

template <class Epi, class Sched>
DI void gemm_phase(LAS unsigned char* lds, const Gemm g, const Sched& S, const Epi& E) {
    const int tid = opq(threadIdx.x), wid = __builtin_amdgcn_readfirstlane(tid >> 6), lane = tid & 63, wr = wid >> 2, wc = wid & 3, fr = lane & 15, fq = lane >> 4;
    const int K = g.K;
    unsigned voffA[2], voffB[2];
#pragma unroll
    for (int i = 0; i < 2; ++i) { int R, C; stage_rc(tid * 16 + i * 8192, R, C);
        voffA[i] = (unsigned)(R * g.lda + C) * 2u; voffB[i] = (unsigned)(R * g.ldb + C) * 2u; }
    const size_t kstep = (size_t)(BK * 2);
    const size_t hstepA = (size_t)HALF * g.lda * 2, hstepB = (size_t)HALF * g.ldb * 2;
    const size_t tstepA = 2 * hstepA, tstepB = 2 * hstepB;
    const unsigned ldsw = (unsigned)wid * 1024u;
    const int aoff = lds_byte(wr * 64 + fr, fq * 8), boff = lds_byte(wc * 32 + fr, fq * 8);
#define PG8_SA(b, h) (((b) * 2 + (h)) * HTB)
#define PG8_SB(b, h) ((4 + (b) * 2 + (h)) * HTB)
#define PG8_STAGE(bufoff, gbase, voff) do { _Pragma("unroll") for (int _i = 0; _i < 2; ++_i) \
        __builtin_amdgcn_global_load_lds((const unsigned*)((const char*)(gbase) + (voff)[_i]), (LAS unsigned*)(lds + (bufoff) + ldsw + _i * 8192), 16, 0, 0); } while (0)
#define PG8_LDA(dst, b, h) do { _Pragma("unroll") for (int m = 0; m < 4; ++m) _Pragma("unroll") for (int k = 0; k < 2; ++k) dst[m][k] = *(const LAS bf16x8*)(lds + PG8_SA(b, h) + aoff + m * 2048 + k * 1024); } while (0)
#define PG8_LDB(dst, b, h) do { _Pragma("unroll") for (int n = 0; n < 2; ++n) _Pragma("unroll") for (int k = 0; k < 2; ++k) dst[n][k] = *(const LAS bf16x8*)(lds + PG8_SB(b, h) + boff + n * 2048 + k * 1024); } while (0)
#define PG8_MMA(ai, bj, At, Bt) do { __builtin_amdgcn_s_setprio(1); _Pragma("unroll") for (int m = 0; m < 4; ++m) _Pragma("unroll") for (int n = 0; n < 2; ++n) _Pragma("unroll") for (int k = 0; k < 2; ++k) \
        acc[ai][bj][m][n] = __builtin_amdgcn_mfma_f32_16x16x32_bf16(Bt[n][k], At[m][k], acc[ai][bj][m][n], 0, 0, 0); __builtin_amdgcn_s_setprio(0); } while (0)
#define PG8_WAIT_V(n) asm volatile("s_waitcnt vmcnt(" #n ")" ::: "memory")
#define PG8_WAIT_L(n) asm volatile("s_waitcnt lgkmcnt(" #n ")" ::: "memory")
#define PG8_BAR __builtin_amdgcn_s_barrier()
#define PG8_SCHED __builtin_amdgcn_sched_barrier(0)
    Unit cur, nxt; int ui = 0;
    if (!S.next(0, cur)) return;
    if (cur.nt == 0) cur.nt = K / BK;
    f32x4 acc[2][2][4][2];
#pragma unroll
    for (int a = 0; a < 2; ++a)
#pragma unroll
        for (int b = 0; b < 2; ++b)
#pragma unroll
            for (int m = 0; m < 4; ++m)
#pragma unroll
                for (int n = 0; n < 2; ++n) acc[a][b][m][n] = (f32x4){0.f, 0.f, 0.f, 0.f};
    bf16x8 At[4][2], B0[2][2], B1[2][2];
    const char* cA = (const char*)g.A + (size_t)cur.pm * tstepA + (size_t)cur.kofs * 2; const char* cB = (const char*)g.Bt + (size_t)cur.pn * tstepB + (size_t)cur.kofs * 2;
    PG8_STAGE(PG8_SB(0, 0), cB, voffB); PG8_STAGE(PG8_SB(0, 1), cB + hstepB, voffB); PG8_STAGE(PG8_SA(0, 0), cA, voffA); PG8_STAGE(PG8_SA(0, 1), cA + hstepA, voffA);
    if (wr == 1) PG8_BAR;
    PG8_WAIT_V(2); PG8_BAR;
    PG8_STAGE(PG8_SB(1, 0), cB + kstep, voffB); PG8_STAGE(PG8_SA(1, 0), cA + kstep, voffA); PG8_STAGE(PG8_SB(1, 1), cB + hstepB + kstep, voffB);
    PG8_WAIT_V(6); PG8_BAR;
    for (;;) {
        const bool has_next = S.next(ui + 1, nxt);
        if (has_next && nxt.nt == 0) nxt.nt = K / BK;
        const char* nA = has_next ? (const char*)g.A + (size_t)nxt.pm * tstepA + (size_t)nxt.kofs * 2 : cA; const char* nB = has_next ? (const char*)g.Bt + (size_t)nxt.pn * tstepB + (size_t)nxt.kofs * 2 : cB;
        const int nt = cur.nt;
        for (int t = 0; t < nt; t += 2) {
            const bool last = (t == nt - 2);
            const char* a1 = cA + (size_t)(t + 1) * kstep;
            const char* a2 = last ? nA : cA + (size_t)(t + 2) * kstep; const char* b2 = last ? nB : cB + (size_t)(t + 2) * kstep;
            const char* a3 = a2 + kstep; const char* b3 = b2 + kstep;
            PG8_LDB(B0, 0, 0); PG8_LDB(B1, 0, 1); PG8_SCHED; PG8_LDA(At, 0, 0); PG8_STAGE(PG8_SA(1, 1), a1 + hstepA, voffA);
            PG8_WAIT_V(8); PG8_WAIT_L(0); PG8_BAR; PG8_MMA(0, 0, At, B0); PG8_MMA(0, 1, At, B1); PG8_BAR; PG8_SCHED;
            PG8_LDA(At, 0, 1); PG8_STAGE(PG8_SB(0, 0), b2, voffB); PG8_STAGE(PG8_SB(0, 1), b2 + hstepB, voffB); PG8_STAGE(PG8_SA(0, 0), a2, voffA);
            PG8_WAIT_V(8); PG8_WAIT_L(0); PG8_BAR; PG8_MMA(1, 0, At, B0); PG8_MMA(1, 1, At, B1); PG8_BAR; PG8_SCHED;
            PG8_LDB(B0, 1, 0); PG8_LDB(B1, 1, 1); PG8_SCHED; PG8_LDA(At, 1, 0); PG8_STAGE(PG8_SA(0, 1), a2 + hstepA, voffA);
            PG8_WAIT_V(8); PG8_WAIT_L(0); PG8_BAR; PG8_MMA(0, 0, At, B0); PG8_MMA(0, 1, At, B1); PG8_BAR; PG8_SCHED;
            PG8_LDA(At, 1, 1); PG8_STAGE(PG8_SB(1, 0), b3, voffB); PG8_STAGE(PG8_SB(1, 1), b3 + hstepB, voffB); PG8_STAGE(PG8_SA(1, 0), a3, voffA);
            PG8_WAIT_V(8); PG8_WAIT_L(0); PG8_BAR; PG8_MMA(1, 0, At, B0); PG8_MMA(1, 1, At, B1); PG8_BAR; PG8_SCHED;
        }
        if (wr == 0) PG8_BAR;
        E(acc, cur, wr, wc, fr, fq);
        if (!has_next) break;
#pragma unroll
        for (int a = 0; a < 2; ++a)
#pragma unroll
            for (int b = 0; b < 2; ++b)
#pragma unroll
                for (int m = 0; m < 4; ++m)
#pragma unroll
                    for (int n = 0; n < 2; ++n) acc[a][b][m][n] = (f32x4){0.f, 0.f, 0.f, 0.f};
        cur = nxt; cA = nA; cB = nB; ++ui;
        if (wr == 1) PG8_BAR;
    }
    PG8_WAIT_V(0);
    PG8_BAR;
#undef PG8_SA
#undef PG8_SB
#undef PG8_STAGE
#undef PG8_LDA
#undef PG8_LDB
#undef PG8_MMA
#undef PG8_WAIT_V
#undef PG8_WAIT_L
#undef PG8_BAR
#undef PG8_SCHED
}
}
using pg8::Unit;

#define XB_TMO      128
#define XB_XCNT(j)  (256  + 64 * (j))
#define XB_XSUB(j)  (1280 + 64 * (j))
#define XB_XGEN(j)  (2304 + 64 * (j))
#define XB_TOP      3328
#define XB_TOPGEN   3392
#define XCD_BAR_WORDS 3456
#define XB_SPIN_CAP (1u << 18)

__device__ __forceinline__ unsigned xb_ld(unsigned* p)              { return __hip_atomic_load(p, __ATOMIC_RELAXED, __HIP_MEMORY_SCOPE_AGENT); }
__device__ __forceinline__ unsigned xb_add(unsigned* p, unsigned v) { return __hip_atomic_fetch_add(p, v, __ATOMIC_RELAXED, __HIP_MEMORY_SCOPE_AGENT); }
__device__ __forceinline__ unsigned xb_xcc_id() { return (unsigned)__builtin_amdgcn_s_getreg((3 << 11) | 20) & 0xFu; }
#define XB_SPIN(cond, bar) do { unsigned _sp = 0; while (cond) { __builtin_amdgcn_s_sleep(1); \
    if ((++_sp & 255u) == 0u) { if (xb_ld(&(bar)[XB_TMO])) break; if (_sp > XB_SPIN_CAP) { atomicAdd(&(bar)[XB_TMO], 1u); break; } } } } while (0)

struct XcdBarrier {
    unsigned* bar; unsigned x;
    volatile LAS unsigned* st;
};

__device__ __forceinline__ XcdBarrier xcd_barrier_post(unsigned* bar, volatile LAS unsigned* st) {
    XcdBarrier b; b.bar = bar; b.x = xb_xcc_id(); b.st = st;
    if (threadIdx.x == 0) (void)xb_add(&bar[XB_XCNT(b.x)], 1u);
    return b;
}
__device__ __forceinline__ void xcd_barrier_complete(unsigned* bar, unsigned x, unsigned& nloc, unsigned& nx) {
    const unsigned G = gridDim.x * gridDim.y * gridDim.z;
    unsigned sum, cnt, mine, sp = 0u;
    for (;;) {
        sum = 0u; cnt = 0u; mine = 0u;
#pragma unroll
        for (unsigned j = 0; j < 16; ++j) { const unsigned c = xb_ld(&bar[XB_XCNT(j)]); sum += c; cnt += (c > 0u) ? 1u : 0u; mine = (j == x) ? c : mine; }
        if (sum == G) break;
        __builtin_amdgcn_s_sleep(1);
        if ((++sp & 255u) == 0u) { if (xb_ld(&bar[XB_TMO])) break; if (sp > XB_SPIN_CAP) { atomicAdd(&bar[XB_TMO], 1u); break; } }
    }
    nloc = mine > 0u ? mine : 1u; nx = cnt > 0u ? cnt : 1u;
}

__device__ __forceinline__ void xcd_barrier(const XcdBarrier& b) {
    asm volatile("s_waitcnt vmcnt(0)" ::: "memory");
    __syncthreads();
    if (threadIdx.x == 0) {
        unsigned* bar = b.bar;
        __builtin_amdgcn_s_waitcnt(0);
        unsigned nloc = b.st[0], nx = b.st[1];
        if (nloc == 0u) { xcd_barrier_complete(bar, b.x, nloc, nx); b.st[0] = nloc; b.st[1] = nx; }
        const unsigned old = xb_add(&bar[XB_XSUB(b.x)], 1u);
        const unsigned gen = old / nloc;
        if (old + 1u == (gen + 1u) * nloc) {
            __builtin_amdgcn_fence(__ATOMIC_RELEASE, "agent");
            asm volatile("s_waitcnt vmcnt(0)" ::: "memory");
            const unsigned og = xb_add(&bar[XB_TOP], 1u);
            const unsigned tg = og / nx;
            if (og + 1u == (tg + 1u) * nx) xb_add(&bar[XB_TOPGEN], 1u);
            else XB_SPIN(xb_ld(&bar[XB_TOPGEN]) == tg, bar);
            __builtin_amdgcn_fence(__ATOMIC_ACQUIRE, "agent");
            xb_add(&bar[XB_XGEN(b.x)], 1u);
            asm volatile("s_waitcnt vmcnt(0)" ::: "memory");
        } else {
            XB_SPIN(xb_ld(&bar[XB_XGEN(b.x)]) == gen, bar);
            __builtin_amdgcn_fence(__ATOMIC_ACQUIRE, "agent");
            asm volatile("s_waitcnt vmcnt(0)" ::: "memory");
        }
    }
    __syncthreads();
}


DI int mod_row(int pm) { return pm < 32 ? 0 : 1 + ((pm - 32) >> 3); }

constexpr int XBP = 2048;
struct EpiRes {
    const float* inA; const float* inB; bf16_t* XB; const float* gate;
    float* P; int accum;
    DI void operator()(const f32x4 (&acc)[2][2][4][2], const Unit& u, int wr, int wc, int fr, int fq) const {
        const int col0 = u.pn * 256 + wc * 64 + 4 * fq;
        const float* gp = gate + mod_row(u.pm) * MODW + col0;
        f32x4 gv[2][2];
#pragma unroll
        for (int bj = 0; bj < 2; ++bj)
#pragma unroll
            for (int n = 0; n < 2; ++n) gv[bj][n] = *(const f32x4*)(gp + 32 * bj + 16 * n);
        const int row0 = u.pm * 256 + wr * 64 + fr;
        const float* xin = inA ? ((u.pm < 32) ? inA + (size_t)row0 * DM : inB + (size_t)(row0 - NPR) * DM) : nullptr;
#pragma unroll
        for (int ai = 0; ai < 2; ++ai)
#pragma unroll
            for (int m = 0; m < 4; ++m) {
                const size_t ro = (size_t)(ai * 128 + m * 16) * DM + col0;
                bf16_t* xp = XB + (size_t)(row0 + ai * 128 + m * 16) * XBP + col0;
#pragma unroll
                for (int bj = 0; bj < 2; ++bj)
#pragma unroll
                    for (int n = 0; n < 2; ++n) {
                        if (u.mode == 0) {
                            f32x4 x;
                            if (xin) x = *(const f32x4*)(xin + ro + 32 * bj + 16 * n);
                            else { const u32x2 w = *(const u32x2*)(xp + 32 * bj + 16 * n); x = (f32x4){bflo(w.x), bfhi(w.x), bflo(w.y), bfhi(w.y)}; }
                            x = x + gv[bj][n] * acc[ai][bj][m][n];
                            u32x2 o; o.x = pk2(x.x, x.y); o.y = pk2(x.z, x.w);
                            *(u32x2*)(xp + 32 * bj + 16 * n) = o;
                        } else {
                            f32x4* pp = (f32x4*)(P + (size_t)(row0 - 16384) * DM + ro + 32 * bj + 16 * n);
                            f32x4 v = gv[bj][n] * acc[ai][bj][m][n];
                            if (accum) v = v + *pp;
                            *pp = v;
                        }
                    }
            }
    }
};

template <int ACT> struct EpiBf16 {
    bf16_t* O; int ldc;
    DI void operator()(const f32x4 (&acc)[2][2][4][2], const Unit& u, int wr, int wc, int fr, int fq) const {
        const int col0 = u.pn * 256 + wc * 64 + 4 * fq;
        const int row0 = u.pm * 256 + wr * 64 + fr;
#pragma unroll
        for (int ai = 0; ai < 2; ++ai)
#pragma unroll
            for (int m = 0; m < 4; ++m) {
                bf16_t* op = O + (size_t)(row0 + ai * 128 + m * 16) * ldc + col0;
#pragma unroll
                for (int bj = 0; bj < 2; ++bj)
#pragma unroll
                    for (int n = 0; n < 2; ++n) {
                        f32x4 v = acc[ai][bj][m][n];
                        if (ACT == 1) { v.x = fmaxf(v.x, 0.f); v.y = fmaxf(v.y, 0.f); v.z = fmaxf(v.z, 0.f); v.w = fmaxf(v.w, 0.f); v = v * v; }
                        u32x2 w; w.x = pk2(v.x, v.y); w.y = pk2(v.z, v.w);
                        *(u32x2*)(op + 32 * bj + 16 * n) = w;
                    }
            }
    }
};

struct EpiZY {
    bf16_t* OF; const bf16_t* OB; const float* out_norm; LAS float* X;
    DI void operator()(const f32x4 (&acc)[2][2][4][2], const Unit& u, int wr, int wc, int fr, int fq) const {
        asm volatile("" : "+v"(fr), "+v"(fq));
        const int col0 = u.pn * 256 + wc * 64 + 4 * fq;
        const int row0 = u.pm * 256 + wr * 64 + fr;
#pragma unroll
        for (int ai = 0; ai < 2; ++ai)
#pragma unroll
            for (int m = 0; m < 4; ++m) {
                const size_t off = (size_t)(row0 + ai * 128 + m * 16) * 1024 + col0;
                float ss = 0.f;
#pragma unroll
                for (int bj = 0; bj < 2; ++bj)
#pragma unroll
                    for (int n = 0; n < 2; ++n) {
                        const u32x2 f = *(const u32x2*)(OF + off + 32 * bj + 16 * n), b = *(const u32x2*)(OB + off + 32 * bj + 16 * n);
                        const float o0 = bflo(f.x) + bflo(b.x), o1 = bfhi(f.x) + bfhi(b.x), o2 = bflo(f.y) + bflo(b.y), o3 = bfhi(f.y) + bfhi(b.y);
                        ss += (o0 * o0 + o1 * o1) + (o2 * o2 + o3 * o3);
                    }
                ss += __shfl_xor(ss, 16); ss += __shfl_xor(ss, 32);
                if (fq == 0) X[(ai * 128 + wr * 64 + m * 16 + fr) * 4 + wc] = ss;
            }
        asm volatile("s_waitcnt lgkmcnt(0)" ::: "memory"); __builtin_amdgcn_s_barrier(); asm volatile("" ::: "memory");
#pragma unroll
        for (int ai = 0; ai < 2; ++ai)
#pragma unroll
            for (int m = 0; m < 4; ++m) {
                const int rl = ai * 128 + wr * 64 + m * 16 + fr;
                const float rstd = __builtin_amdgcn_rsqf((X[rl * 4 + wc] + X[rl * 4 + (wc ^ 1)]) * (1.0f / 128.0f) + 1e-6f);
                const size_t off = (size_t)(row0 + ai * 128 + m * 16) * 1024 + col0;
#pragma unroll
                for (int bj = 0; bj < 2; ++bj)
#pragma unroll
                    for (int n = 0; n < 2; ++n) {
                        const u32x2 f = *(const u32x2*)(OF + off + 32 * bj + 16 * n), b = *(const u32x2*)(OB + off + 32 * bj + 16 * n);
                        const f32x4 g = *(const f32x4*)(out_norm + ((col0 + 32 * bj + 16 * n) & 127));
                        const f32x4 z = acc[ai][bj][m][n];
                        const float y0 = (bflo(f.x) + bflo(b.x)) * rstd * g.x * siluf_(z.x), y1 = (bfhi(f.x) + bfhi(b.x)) * rstd * g.y * siluf_(z.y);
                        const float y2 = (bflo(f.y) + bflo(b.y)) * rstd * g.z * siluf_(z.z), y3 = (bfhi(f.y) + bfhi(b.y)) * rstd * g.w * siluf_(z.w);
                        u32x2 w; w.x = pk2(y0, y1); w.y = pk2(y2, y3);
                        *(u32x2*)(OF + off + 32 * bj + 16 * n) = w;
                    }
                asm volatile("" ::: "memory");
            }
    }
};

struct EpiQKV1 {
    bf16_t* QKV; float* AB;
    DI void operator()(const f32x4 (&acc)[2][2][4][2], const Unit& u, int wr, int wc, int fr, int fq) const {
        const int row0 = u.pm * 256 + wr * 64 + fr;
        if (u.pn < 12) {
            const int col0 = u.pn * 256 + wc * 64 + 4 * fq;
#pragma unroll
            for (int ai = 0; ai < 2; ++ai)
#pragma unroll
                for (int m = 0; m < 4; ++m) {
                    bf16_t* op = QKV + (size_t)(row0 + ai * 128 + m * 16) * 3072 + col0;
#pragma unroll
                    for (int bj = 0; bj < 2; ++bj)
#pragma unroll
                        for (int n = 0; n < 2; ++n) {
                            const f32x4 v = acc[ai][bj][m][n];
                            u32x2 w; w.x = pk2(v.x, v.y); w.y = pk2(v.z, v.w);
                            *(u32x2*)(op + 32 * bj + 16 * n) = w;
                        }
                }
        } else if (wc == 0) {
#pragma unroll
            for (int ai = 0; ai < 2; ++ai)
#pragma unroll
                for (int m = 0; m < 4; ++m) {
                    float* op = AB + (size_t)(row0 + ai * 128 + m * 16) * 32 + 4 * fq;
#pragma unroll
                    for (int n = 0; n < 2; ++n) *(f32x4*)(op + 16 * n) = acc[ai][0][m][n];
                }
        }
    }
};

struct EpiQKV0 {
    bf16_t *Q, *KS, *VTS, *KP, *VTP; float *newk, *newv;
    const float *qna, *kna, *qnb, *knb;
    DI void operator()(const f32x4 (&acc)[2][2][4][2], const Unit& u, int wr, int wc, int fr, int fq) const {
        asm volatile("" : "+v"(fr), "+v"(fq));
        const int pn = u.pn; const bool prompt = u.pm < 32;
        int type, head; const float* gain = qna; bool rope = false;
        if (pn < 2) { type = 0; head = 4 * pn + wc; gain = qna; rope = true; }
        else if (pn == 2) { if (wc < 2) { type = 1; head = wc; gain = kna; rope = true; } else { type = 2; head = wc - 2; } }
        else if (pn < 5) { type = 0; head = 8 + 4 * (pn - 3) + wc; gain = qnb; }
        else if (pn < 7) { type = 1; head = 2 + 4 * (pn - 5) + wc; gain = knb; }
        else { type = 2; head = 2 + 4 * (pn - 7) + wc; }
        rope = rope && !prompt;
        float invf[4];
#pragma unroll
        for (int j = 0; j < 4; ++j) invf[j] = __builtin_amdgcn_exp2f(-(float)(4 * fq + j) * 0.83048202372184059f);
        const int row0 = u.pm * 256 + wr * 64 + fr;
#pragma unroll
        for (int ai = 0; ai < 2; ++ai)
#pragma unroll
            for (int m = 0; m < 4; ++m) {
                const int mg = row0 + ai * 128 + m * 16;
                f32x4 v[2][2];
#pragma unroll
                for (int bj = 0; bj < 2; ++bj)
#pragma unroll
                    for (int n = 0; n < 2; ++n) v[bj][n] = acc[ai][bj][m][n];
                if (type != 2) {
                    float ss = 0.f;
#pragma unroll
                    for (int bj = 0; bj < 2; ++bj)
#pragma unroll
                        for (int n = 0; n < 2; ++n) { const f32x4 x = v[bj][n]; ss += (x.x * x.x + x.y * x.y) + (x.z * x.z + x.w * x.w); }
                    ss += __shfl_xor(ss, 16); ss += __shfl_xor(ss, 32);
                    const float rinv = __builtin_amdgcn_rsqf(ss * (1.0f / 64.0f) + 1e-6f);
#pragma unroll
                    for (int bj = 0; bj < 2; ++bj)
#pragma unroll
                        for (int n = 0; n < 2; ++n) v[bj][n] = v[bj][n] * rinv * *(const f32x4*)(gain + 32 * bj + 16 * n + 4 * fq);
                    if (rope) {
                        const int t = (mg - NPR) & 2047;
                        const float pos[2] = {(float)(t >> 6), (float)(t & 63)};
#pragma unroll
                        for (int bj = 0; bj < 2; ++bj)
#pragma unroll
                            for (int j = 0; j < 4; ++j) {
                                const float ang = pos[bj] * invf[j];
                                const float cs = __cosf(ang), sn = __sinf(ang);
                                const float x1 = v[bj][0][j], x2 = v[bj][1][j];
                                v[bj][0][j] = x1 * cs - x2 * sn; v[bj][1][j] = x2 * cs + x1 * sn;
                            }
                    }
                }
                int b, t, ntile; bf16_t* kbase; bf16_t* vbase;
                if (prompt) { b = mg >> 8; t = mg & 255; ntile = 8; kbase = KP; vbase = VTP; }
                else { b = (mg - NPR) >> 11; t = (mg - NPR) & 2047; ntile = 72; kbase = KS; vbase = VTS; }
                const size_t tbase = ((size_t)(b * 10 + head) * ntile + (t >> 5)) * 2048; const int kk = t & 31;
#pragma unroll
                for (int bj = 0; bj < 2; ++bj)
#pragma unroll
                    for (int n = 0; n < 2; ++n) {
                        const int d0 = 32 * bj + 16 * n + 4 * fq;
                        const f32x4 x = v[bj][n];
                        if (type == 0) { u32x2 w; w.x = pk2(x.x, x.y); w.y = pk2(x.z, x.w); *(u32x2*)(Q + (size_t)mg * 1024 + head * 64 + d0) = w; }
                        else if (type == 1) {
                            u32x2 w; w.x = pk2(x.x, x.y); w.y = pk2(x.z, x.w); *(u32x2*)(kbase + tbase + ((d0 >> 3) * 32 + kk) * 8 + (d0 & 7)) = w;
                            if (prompt) *(f32x4*)(newk + (size_t)mg * 640 + head * 64 + d0) = x;
                        } else {
                            bf16_t* vp = vbase + tbase + ((((((d0 >> 5) * 2 + (kk >> 4)) * 2 + ((kk >> 3) & 1)) * 2 + ((kk >> 2) & 1)) * 32 + (d0 & 31)) << 2) + (kk & 3);
                            const unsigned w0 = pk2(x.x, x.y), w1 = pk2(x.z, x.w);
                            vp[0] = (bf16_t)(w0 & 0xffffu); vp[4] = (bf16_t)(w0 >> 16); vp[8] = (bf16_t)(w1 & 0xffffu); vp[12] = (bf16_t)(w1 >> 16);
                            if (prompt) *(f32x4*)(newv + (size_t)mg * 640 + head * 64 + d0) = x;
                        }
                    }
                asm volatile("" ::: "memory");
            }
    }
};

DI float wave_sum(float v) {
#pragma unroll
    for (int o = 1; o < 64; o <<= 1) v += __shfl_xor(v, o);
    return v;
}
DI int perm_row32(int n0) { return (n0 & ~255) + 128 * ((n0 >> 5) & 1) + 32 * ((n0 >> 6) & 3); }

DI void transpose_item(const float* W, int N, int k0, int n0, bf16_t* WT, int ldt, int row0, LAS float* scr, int lane) {
#pragma unroll 8
    for (int i = 0; i < 32; ++i) { const int kk = 2 * i + (lane >> 5); scr[kk * 33 + (lane & 31)] = W[(size_t)(k0 + kk) * N + n0 + (lane & 31)]; }
    asm volatile("s_waitcnt lgkmcnt(0)" ::: "memory");
    const int c = lane & 7;
#pragma unroll
    for (int j = 0; j < 4; ++j) { const int n = (lane >> 3) + 8 * j; const LAS float* s = scr + (8 * c) * 33 + n;
        u32x4 o; o.x = pk2(s[0 * 33], s[1 * 33]); o.y = pk2(s[2 * 33], s[3 * 33]); o.z = pk2(s[4 * 33], s[5 * 33]); o.w = pk2(s[6 * 33], s[7 * 33]);
        *(u32x4*)(WT + (size_t)(row0 + n) * ldt + k0 + 8 * c) = o; }
    asm volatile("s_waitcnt lgkmcnt(0)" ::: "memory");
}
DI void transpose_matrix(const float* W, int K, int N, bf16_t* WT, LAS float* scr, int gw, int NGW, int lane) {
    const int nblk = N / 32, nitems = (K / 64) * nblk;
    for (int it = gw; it < nitems; it += NGW) { const int kb = it / nblk, nb = it % nblk; transpose_item(W, N, kb * 64, nb * 32, WT, K, perm_row32(nb * 32), scr, lane); }
}

DI void norm_phase(const float* xa, const float* xb, bf16_t* XB, const float* gain, const float* sh, const float* sc, bf16_t* H, int hp, int gw, int NGW, int lane, const float* P = nullptr) {
    for (int m0 = gw; m0 < NTOK; m0 += 2 * NGW) {
        const int m1 = m0 + NGW; const bool has1 = m1 < NTOK; const int m1c = has1 ? m1 : m0;
        f32x4 v0[4], v1[4];
        if (XB) {
#pragma unroll
            for (int j = 0; j < 4; ++j) {
                const u32x2 w0 = *(const u32x2*)(XB + (size_t)m0 * XBP + 4 * lane + 256 * j), w1 = *(const u32x2*)(XB + (size_t)m1c * XBP + 4 * lane + 256 * j);
                v0[j] = (f32x4){bflo(w0.x), bfhi(w0.x), bflo(w0.y), bfhi(w0.y)}; v1[j] = (f32x4){bflo(w1.x), bfhi(w1.x), bflo(w1.y), bfhi(w1.y)};
            }
        } else {
            const float* xr0 = (m0 < NPR) ? xa + (size_t)m0 * DM : xb + (size_t)(m0 - NPR) * DM;
            const float* xr1 = (m1c < NPR) ? xa + (size_t)m1c * DM : xb + (size_t)(m1c - NPR) * DM;
#pragma unroll
            for (int j = 0; j < 4; ++j) { v0[j] = *(const f32x4*)(xr0 + 4 * lane + 256 * j); v1[j] = *(const f32x4*)(xr1 + 4 * lane + 256 * j); }
        }
        if (P) {
#pragma unroll
            for (int j = 0; j < 4; ++j) {
                if (m0 >= 16384) { v0[j] = v0[j] + *(const f32x4*)(P + (size_t)(m0 - 16384) * DM + 4 * lane + 256 * j);
                    u32x2 o; o.x = pk2(v0[j].x, v0[j].y); o.y = pk2(v0[j].z, v0[j].w); *(u32x2*)(XB + (size_t)m0 * XBP + 4 * lane + 256 * j) = o; }
                if (has1 && m1 >= 16384) { v1[j] = v1[j] + *(const f32x4*)(P + (size_t)(m1 - 16384) * DM + 4 * lane + 256 * j);
                    u32x2 o; o.x = pk2(v1[j].x, v1[j].y); o.y = pk2(v1[j].z, v1[j].w); *(u32x2*)(XB + (size_t)m1 * XBP + 4 * lane + 256 * j) = o; }
            }
        }
        float s0 = 0.f, s1 = 0.f;
#pragma unroll
        for (int j = 0; j < 4; ++j) { s0 += (v0[j].x * v0[j].x + v0[j].y * v0[j].y) + (v0[j].z * v0[j].z + v0[j].w * v0[j].w); s1 += (v1[j].x * v1[j].x + v1[j].y * v1[j].y) + (v1[j].z * v1[j].z + v1[j].w * v1[j].w); }
        const float r0 = __builtin_amdgcn_rsqf(wave_sum(s0) * (1.0f / DM) + 1e-6f), r1 = __builtin_amdgcn_rsqf(wave_sum(s1) * (1.0f / DM) + 1e-6f);
        const int mr0 = (m0 < NPR) ? 0 : 1 + ((m0 - NPR) >> 11), mr1 = (m1c < NPR) ? 0 : 1 + ((m1c - NPR) >> 11);
#pragma unroll
        for (int j = 0; j < 4; ++j) {
            const int c = 4 * lane + 256 * j;
            const f32x4 g = *(const f32x4*)(gain + c);
            { const f32x4 a = *(const f32x4*)(sc + mr0 * MODW + c), b = *(const f32x4*)(sh + mr0 * MODW + c);
              const f32x4 o = v0[j] * r0 * g * (a + 1.0f) + b; u32x2 w; w.x = pk2(o.x, o.y); w.y = pk2(o.z, o.w); *(u32x2*)(H + (size_t)m0 * hp + c) = w; }
            if (has1) { const f32x4 a = *(const f32x4*)(sc + mr1 * MODW + c), b = *(const f32x4*)(sh + mr1 * MODW + c);
              const f32x4 o = v1[j] * r1 * g * (a + 1.0f) + b; u32x2 w; w.x = pk2(o.x, o.y); w.y = pk2(o.z, o.w); *(u32x2*)(H + (size_t)m1 * hp + c) = w; }
        }
    }
}

#define MFMA32(a, b, c) __builtin_amdgcn_mfma_f32_32x32x16_bf16((a), (b), (c), 0, 0, 0)
template <int NH, bool NA>
DI void attn_unit(const bf16_t* Qrow, const bf16_t* Kp, const bf16_t* VTp, int vstride,
                  int seg0_start, int seg0_tiles, int seg1_start, int seg1_tiles,
                  const LAS float* biasH, int qr, int c0, float shift, bf16_t* Orow, int lane) {
    const int r = lane & 31, hh = lane >> 5;
    bf16x8 Qf[NH][4];
#pragma unroll
    for (int h = 0; h < NH; ++h)
#pragma unroll
        for (int s = 0; s < 4; ++s) Qf[h][s] = *(const bf16x8*)(Qrow + (size_t)r * 1024 + 64 * h + 16 * s + 8 * hh);
    f32x16 O[NH][2]; float mrun[NH], lrun[NH];
#pragma unroll
    for (int h = 0; h < NH; ++h) { mrun[h] = -1e30f; lrun[h] = 0.f;
#pragma unroll
        for (int b = 0; b < 2; ++b)
#pragma unroll
            for (int i = 0; i < 16; ++i) O[h][b][i] = 0.f; }
    const float SC = 0.125f * 1.4426950408889634f;
    const int ntiles = seg0_tiles + seg1_tiles;
    bf16x8 Kn[4]; s16x4 Vln[2][2], Vhn[2][2];
    {
        const int k0 = seg0_tiles > 0 ? seg0_start : seg1_start;
        const bf16_t* kt = Kp + (size_t)(k0 >> 5) * 2048; const bf16_t* vt = VTp + (size_t)(k0 >> 5) * 2048;
#pragma unroll
        for (int s = 0; s < 4; ++s) Kn[s] = *(const bf16x8*)(kt + (s * 64 + lane) * 8);
#pragma unroll
        for (int b = 0; b < 2; ++b)
#pragma unroll
            for (int s = 0; s < 2; ++s) { Vln[b][s] = *(const s16x4*)(vt + (((b * 2 + s) * 2 + 0) * 64 + lane) * 4); Vhn[b][s] = *(const s16x4*)(vt + (((b * 2 + s) * 2 + 1) * 64 + lane) * 4); }
    }
    for (int ti = 0; ti < ntiles; ++ti) {
        const bool loc = ti < seg0_tiles;
        const int k0 = loc ? seg0_start + 32 * ti : seg1_start + 32 * (ti - seg0_tiles);
        bf16x8 Kf[4]; s16x4 Vlo[2][2], Vhi[2][2];
#pragma unroll
        for (int s = 0; s < 4; ++s) Kf[s] = Kn[s];
#pragma unroll
        for (int b = 0; b < 2; ++b)
#pragma unroll
            for (int s = 0; s < 2; ++s) { Vlo[b][s] = Vln[b][s]; Vhi[b][s] = Vhn[b][s]; }
        {
            const int tn = min(ti + 1, ntiles - 1);
            const int k1 = (tn < seg0_tiles) ? seg0_start + 32 * tn : seg1_start + 32 * (tn - seg0_tiles);
            const bf16_t* kt = Kp + (size_t)(k1 >> 5) * 2048; const bf16_t* vt = VTp + (size_t)(k1 >> 5) * 2048;
#pragma unroll
            for (int s = 0; s < 4; ++s) Kn[s] = *(const bf16x8*)(kt + (s * 64 + lane) * 8);
#pragma unroll
            for (int b = 0; b < 2; ++b)
#pragma unroll
                for (int s = 0; s < 2; ++s) { Vln[b][s] = *(const s16x4*)(vt + (((b * 2 + s) * 2 + 0) * 64 + lane) * 4); Vhn[b][s] = *(const s16x4*)(vt + (((b * 2 + s) * 2 + 1) * 64 + lane) * 4); }
        }
#pragma unroll
        for (int h = 0; h < NH; ++h) {
            f32x16 st;
#pragma unroll
            for (int i = 0; i < 16; ++i) st[i] = 0.f;
#pragma unroll
            for (int s = 0; s < 4; ++s) st = MFMA32(Kf[s], Qf[h][s], st);
            float ps = 0.f;
            if (NA && loc) {
                const int c = c0 + r, cs = min(max(c - 8, 0), 48);
                const int d0 = (k0 & 63) + 4 * hh - cs;
                const int b0 = ((k0 >> 6) - qr + 7) * 31 + (cs - c + 15);
#pragma unroll
                for (int i = 0; i < 16; ++i) {
                    const int d = d0 + (i & 3) + 8 * (i >> 2);
                    const bool valid = (unsigned)d < 16u;
                    const float bv = biasH[valid ? b0 + d : 0];
                    const float x = valid ? st[i] * SC - shift + bv * 1.4426950408889634f : -1e30f;
                    const float p = __builtin_amdgcn_exp2f(x); st[i] = p; ps += p;
                }
            } else {
#pragma unroll
                for (int i = 0; i < 16; ++i) { const float p = __builtin_amdgcn_exp2f(st[i] * SC - shift); st[i] = p; ps += p; }
            }
            lrun[h] += ps;
#pragma unroll
            for (int s = 0; s < 2; ++s) {
                u32x4 pw; pw.x = pk2(st[8 * s + 0], st[8 * s + 1]); pw.y = pk2(st[8 * s + 2], st[8 * s + 3]); pw.z = pk2(st[8 * s + 4], st[8 * s + 5]); pw.w = pk2(st[8 * s + 6], st[8 * s + 7]);
                const bf16x8 Pf = __builtin_bit_cast(bf16x8, pw);
#pragma unroll
                for (int b = 0; b < 2; ++b) {
                    const bf16x8 Vf = __builtin_shufflevector(Vlo[b][s], Vhi[b][s], 0, 1, 2, 3, 4, 5, 6, 7);
                    O[h][b] = MFMA32(Vf, Pf, O[h][b]);
                }
            }
        }
    }
#pragma unroll
    for (int h = 0; h < NH; ++h) {
        const float lt = lrun[h] + __shfl_xor(lrun[h], 32);
        const float inv = 1.0f / lt;
#pragma unroll
        for (int b = 0; b < 2; ++b)
#pragma unroll
            for (int g = 0; g < 4; ++g) {
                u32x2 w; w.x = pk2(O[h][b][4 * g] * inv, O[h][b][4 * g + 1] * inv); w.y = pk2(O[h][b][4 * g + 2] * inv, O[h][b][4 * g + 3] * inv);
                *(u32x2*)(Orow + (size_t)r * 1024 + 64 * h + 32 * b + 8 * g + 4 * hh) = w;
            }
    }
}

DI float wave_max(float v) {
#pragma unroll
    for (int o = 1; o < 64; o <<= 1) v = fmaxf(v, __shfl_xor(v, o));
    return v;
}
DI void attention_phase(const bf16_t* Q, const bf16_t* KS, const bf16_t* VTS, const bf16_t* KP, const bf16_t* VTP, const LAS float* rel_bias, const float* qna, const float* kna, const float* qnb, const float* knb,
                        bf16_t* AO, int gw, int NGW, int lane) {
    const float L2E = 1.4426950408889634f;
    const float shiftA = 8.0f * wave_max(fabsf(qna[lane])) * wave_max(fabsf(kna[lane])) * L2E;
    const float boundB = 8.0f * wave_max(fabsf(qnb[lane])) * wave_max(fabsf(knb[lane]));
    float bm = 0.f;
    for (int i = lane; i < 3720; i += 64) bm = fmaxf(bm, fabsf(rel_bias[i]));
    const float shiftB = boundB * L2E, shiftN = (boundB + wave_max(bm)) * L2E;
    for (int U = gw; U < 9216; U += NGW) {
        if (U < 2048) {
            const int u = U, b = u >> 8, kv = (u >> 7) & 1, gp = (u >> 6) & 1, qt = u & 63;
            const int m0 = NPR + b * 2048 + qt * 32, qc = (kv * 4 + gp * 2) * 64;
            attn_unit<2, false>(Q + (size_t)m0 * 1024 + qc, KS + (size_t)(b * 10 + kv) * 72 * 2048, VTS + (size_t)(b * 10 + kv) * 72 * 2048, 2304, 0, 72, 0, 0, nullptr, 0, 0, shiftA, AO + (size_t)m0 * 1024 + qc, lane);
        } else if (U < 6144) {
            const int u = U - 2048, b = u >> 9, h = (u >> 6) & 7, qt = u & 63, qr = qt >> 1, c0 = (qt & 1) * 32;
            const int m0 = NPR + b * 2048 + qt * 32, qc = 512 + h * 64;
            const int rs = min(max(qr - 4, 0), 24);
            attn_unit<1, true>(Q + (size_t)m0 * 1024 + qc, KS + (size_t)(b * 10 + 2 + h) * 72 * 2048, VTS + (size_t)(b * 10 + 2 + h) * 72 * 2048, 2304, rs * 64, 16, 2048, 8, rel_bias + h * 465, qr, c0, shiftN, AO + (size_t)m0 * 1024 + qc, lane);
        } else if (U < 7168) {
            const int u = U - 6144, b = u >> 5, kv = (u >> 4) & 1, gp = (u >> 3) & 1, qt = u & 7;
            const int m0 = b * 256 + qt * 32, qc = (kv * 4 + gp * 2) * 64;
            attn_unit<2, false>(Q + (size_t)m0 * 1024 + qc, KP + (size_t)(b * 10 + kv) * 8 * 2048, VTP + (size_t)(b * 10 + kv) * 8 * 2048, 256, 0, 8, 0, 0, nullptr, 0, 0, shiftA, AO + (size_t)m0 * 1024 + qc, lane);
        } else {
            const int u = U - 7168, b = u >> 6, h = (u >> 3) & 7, qt = u & 7;
            const int m0 = b * 256 + qt * 32, qc = 512 + h * 64;
            attn_unit<1, false>(Q + (size_t)m0 * 1024 + qc, KP + (size_t)(b * 10 + 2 + h) * 8 * 2048, VTP + (size_t)(b * 10 + 2 + h) * 8 * 2048, 256, 0, 8, 0, 0, nullptr, 0, 0, shiftB, AO + (size_t)m0 * 1024 + qc, lane);
        }
    }
}

DI float quad_sum(float x) {
    x += __builtin_bit_cast(float, __builtin_amdgcn_mov_dpp(__builtin_bit_cast(int, x), 0xB1, 0xF, 0xF, true));
    x += __builtin_bit_cast(float, __builtin_amdgcn_mov_dpp(__builtin_bit_cast(int, x), 0x4E, 0xF, 0xF, true));
    return x;
}
DI void delta_unit(LAS unsigned char* lds, const bf16_t* QKV, const float* AB, const float* conv_w, float Aexp, float dtb,
                   int m0, int T, int h, int dir, const float* s0  , float* sfin  , bf16_t* OUT) {
    const int tid = opq(threadIdx.x), wid = tid >> 6, lane = tid & 63, kq = lane & 3, vl = lane >> 2, v = 16 * wid + vl;
    LAS float* sQ = (LAS float*)lds; LAS float* sK = sQ + 32 * 128; LAS float* sV = sK + 32 * 128; LAS float* sA = sV + 32 * 128; LAS float* sB = sA + 32;
    float S[32];
#pragma unroll
    for (int i = 0; i < 32; ++i) S[i] = s0 ? s0[(size_t)(kq * 32 + i) * 128 + v] : 0.f;
    const int nblk = T / 32;
    for (int blk = 0; blk < nblk; ++blk) {
        const int t0 = (dir ? nblk - 1 - blk : blk) * 32;
        {
            const int tl = tid >> 4, cg = tid & 15, t = t0 + tl;
#pragma unroll
            for (int part = 0; part < 3; ++part) {
                const int col = part * 1024 + h * 128 + cg * 8;
                const bf16_t* base = QKV + (size_t)(m0 + t) * 3072 + col;
                u32x4 xm = {0u, 0u, 0u, 0u}, xp = {0u, 0u, 0u, 0u};
                const u32x4 x0 = *(const u32x4*)base;
                if (t > 0) xm = *(const u32x4*)(base - 3072);
                if (t < T - 1) xp = *(const u32x4*)(base + 3072);
                float o[8];
#pragma unroll
                for (int e = 0; e < 4; ++e) {
                    const f32x2 w0 = *(const f32x2*)(conv_w + col + 2 * e), w1 = *(const f32x2*)(conv_w + 3072 + col + 2 * e), w2 = *(const f32x2*)(conv_w + 6144 + col + 2 * e);
                    const float a0 = w0.x * bflo(xm[e]) + w1.x * bflo(x0[e]) + w2.x * bflo(xp[e]);
                    const float a1 = w0.y * bfhi(xm[e]) + w1.y * bfhi(x0[e]) + w2.y * bfhi(xp[e]);
                    o[2 * e] = siluf_(a0); o[2 * e + 1] = siluf_(a1);
                }
                LAS float* dst = (part == 0 ? sQ : (part == 1 ? sK : sV)) + tl * 128 + cg * 8;
                *(LAS f32x4*)dst = (f32x4){o[0], o[1], o[2], o[3]}; *(LAS f32x4*)(dst + 4) = (f32x4){o[4], o[5], o[6], o[7]};
            }
        }
        __syncthreads();
        {
            const int row = tid >> 3, sub = tid & 7;
            LAS float* p = (row < 32 ? sQ + row * 128 : sK + (row - 32) * 128) + sub * 16;
            f32x4 x[4]; float ss = 0.f;
#pragma unroll
            for (int i = 0; i < 4; ++i) { x[i] = *(LAS f32x4*)(p + 4 * i); ss += (x[i].x * x[i].x + x[i].y * x[i].y) + (x[i].z * x[i].z + x[i].w * x[i].w); }
            ss += __shfl_xor(ss, 1); ss += __shfl_xor(ss, 2); ss += __shfl_xor(ss, 4);
            const float sc = __builtin_amdgcn_rsqf(ss + 1e-6f) * (row < 32 ? 0.08838834764831845f : 1.0f);
#pragma unroll
            for (int i = 0; i < 4; ++i) *(LAS f32x4*)(p + 4 * i) = x[i] * sc;
            if (tid < 32) {
                const float* ab = AB + (size_t)(m0 + t0 + tid) * 32 + dir * 8 + h;
                const float xa = ab[0] + dtb, xb = ab[16];
                const float sp = xa > 20.f ? xa : log1pf(__expf(xa));
                sA[tid] = __expf(-Aexp * sp); sB[tid] = sigmoidf_(xb);
            }
        }
        __syncthreads();
        for (int i = 0; i < 32; ++i) {
            const int tl = dir ? 31 - i : i;
            const LAS float* kp = sK + tl * 128 + kq * 32; const LAS float* qp = sQ + tl * 128 + kq * 32;
            const float a = sA[tl], b = sB[tl], vt = sV[tl * 128 + v];
            f32x4 kk[8];
#pragma unroll
            for (int j = 0; j < 8; ++j) kk[j] = *(const LAS f32x4*)(kp + 4 * j);
            float ks = 0.f;
#pragma unroll
            for (int j = 0; j < 8; ++j) ks += (kk[j].x * S[4 * j] + kk[j].y * S[4 * j + 1]) + (kk[j].z * S[4 * j + 2] + kk[j].w * S[4 * j + 3]);
            ks = quad_sum(ks);
            const float d = b * (vt - a * ks);
            f32x4 qq[8];
#pragma unroll
            for (int j = 0; j < 8; ++j) qq[j] = *(const LAS f32x4*)(qp + 4 * j);
            float os = 0.f;
#pragma unroll
            for (int j = 0; j < 8; ++j) {
                S[4 * j] = a * S[4 * j] + kk[j].x * d; S[4 * j + 1] = a * S[4 * j + 1] + kk[j].y * d; S[4 * j + 2] = a * S[4 * j + 2] + kk[j].z * d; S[4 * j + 3] = a * S[4 * j + 3] + kk[j].w * d;
                os += (qq[j].x * S[4 * j] + qq[j].y * S[4 * j + 1]) + (qq[j].z * S[4 * j + 2] + qq[j].w * S[4 * j + 3]);
            }
            os = quad_sum(os);
            if (kq == 0) OUT[(size_t)(m0 + t0 + tl) * 1024 + h * 128 + v] = (bf16_t)(pk2(os, 0.f) & 0xffffu);
        }
        __syncthreads();
    }
    if (sfin) {
#pragma unroll
        for (int i = 0; i < 32; ++i) sfin[(size_t)(kq * 32 + i) * 128 + v] = S[i];
    }
}


constexpr int DP128 = 136, DP64 = 72;
constexpr int DL_QN = 0, DL_KN = 17408, DL_KNT = 34816, DL_VT = 53248, DL_ST = 71680, DL_ATT = 106496, DL_TM = 115712, DL_RT = 124928, DL_GATE = 143360;
constexpr int DL_AL1 = DL_KNT, DL_AL2 = DL_KNT + 9216, DL_TDT = DL_VT, DL_P1T = DL_VT + 9216, DL_T1 = DL_ST, DL_T1T = DL_ST + 9216, DL_AD = DL_ST + 18432;
constexpr int DL_VNT = DL_QN, DL_VNST = DL_VT, DL_CW = DL_GATE + 2048;
static_assert(DL_CW + 4608 <= LDS_BYTES, "delta LDS map");

DI int crow_(int i, int hh) { return (i & 3) + 8 * (i >> 2) + 4 * hh; }
DI bf16x8 ldfrag(const LAS bf16_t* base, int row, int pitch, int koff) { return *(const LAS bf16x8*)(base + row * pitch + koff); }
DI void store_tileT(LAS bf16_t* XT, int pitch, int col, int row0, int hh, const f32x16& a, float sc) {
#pragma unroll
    for (int g = 0; g < 4; ++g) { u32x2 w; w.x = pk2(a[4 * g] * sc, a[4 * g + 1] * sc); w.y = pk2(a[4 * g + 2] * sc, a[4 * g + 3] * sc);
        *(LAS u32x2*)(XT + col * pitch + row0 + 8 * g + 4 * hh) = w; }
}
DI void store_tileR(LAS bf16_t* X, int pitch, int col, int row0, int hh, const f32x16& a) {
#pragma unroll
    for (int i = 0; i < 16; ++i) X[(row0 + crow_(i, hh)) * pitch + col] = (bf16_t)(pk2(a[i], 0.f) & 0xffffu);
}
DI f32x16 mm64_tile(const LAS bf16_t* A, const LAS bf16_t* BT, int ib, int jb, int r, int hh, f32x16 acc) {
#pragma unroll
    for (int s = 0; s < 4; ++s) acc = MFMA32(ldfrag(A, 32 * ib + r, DP64, 16 * s + 8 * hh), ldfrag(BT, 32 * jb + r, DP64, 16 * s + 8 * hh), acc);
    return acc;
}

#ifdef PROBE_D1
#define REP_D1 _Pragma("unroll 1") for (int rep_ = 0; rep_ < 2; ++rep_)
#else
#define REP_D1
#endif
#ifdef PROBE_D3
#define REP_D3 _Pragma("unroll 1") for (int rep_ = 0; rep_ < 2; ++rep_)
#else
#define REP_D3
#endif
#ifdef PROBE_D6
#define REP_D6 _Pragma("unroll 1") for (int rep_ = 0; rep_ < 2; ++rep_)
#else
#define REP_D6
#endif
DI void delta_unit_chunked(LAS unsigned char* lds, const bf16_t* QKV, const float* AB, const float* conv_w, float Aexp, float dtb,
                           int m0, int T, int h, int dir, const float* s0, float* sfin, bf16_t* OUT) {
    const int tid0 = opq(threadIdx.x), w0 = __builtin_amdgcn_readfirstlane(tid0 >> 6);
    LAS bf16_t* QN = (LAS bf16_t*)(lds + DL_QN); LAS bf16_t* KN = (LAS bf16_t*)(lds + DL_KN); LAS bf16_t* KNT = (LAS bf16_t*)(lds + DL_KNT); LAS bf16_t* VT = (LAS bf16_t*)(lds + DL_VT);
    LAS bf16_t* ST = (LAS bf16_t*)(lds + DL_ST); LAS bf16_t* ATT = (LAS bf16_t*)(lds + DL_ATT); LAS bf16_t* TM = (LAS bf16_t*)(lds + DL_TM); LAS bf16_t* RT = (LAS bf16_t*)(lds + DL_RT);
    LAS float* GT = (LAS float*)(lds + DL_GATE);
    LAS bf16_t* AL1 = (LAS bf16_t*)(lds + DL_AL1); LAS bf16_t* AL2 = (LAS bf16_t*)(lds + DL_AL2); LAS bf16_t* TDT = (LAS bf16_t*)(lds + DL_TDT); LAS bf16_t* P1T = (LAS bf16_t*)(lds + DL_P1T);
    LAS bf16_t* T1 = (LAS bf16_t*)(lds + DL_T1); LAS bf16_t* T1T = (LAS bf16_t*)(lds + DL_T1T); LAS float* AD = (LAS float*)(lds + DL_AD);
    LAS bf16_t* VNT = (LAS bf16_t*)(lds + DL_VNT); LAS bf16_t* VNST = (LAS bf16_t*)(lds + DL_VNST);
    f32x16 Sacc[2];
    {
        const int lane = tid0 & 63, r = lane & 31, hh = lane >> 5, kb = w0 >> 1, vb0 = 2 * (w0 & 1);
#pragma unroll
        for (int e = 0; e < 2; ++e)
#pragma unroll
            for (int i = 0; i < 16; ++i) Sacc[e][i] = s0 ? s0[(size_t)(32 * kb + crow_(i, hh)) * 128 + 32 * (vb0 + e) + r] : 0.f;
    }
    LAS float* CW = (LAS float*)(lds + DL_CW);
    for (int i = tid0; i < 3 * 384; i += 512) { const int tap = i / 384, pc = i % 384; CW[i] = conv_w[tap * 3072 + (pc >> 7) * 1024 + h * 128 + (pc & 127)]; }
    __syncthreads();
    const int nch = T / 64;
    u32x4 xraw[3][4];
#define DELTA_LOAD_RAW(T0) do { const int tlo_ = (T0) + 2 * (tid0 >> 4), cg_ = tid0 & 15; \
        _Pragma("unroll") for (int part = 0; part < 3; ++part) _Pragma("unroll") for (int k = 0; k < 4; ++k) { \
            const int tt = tlo_ - 1 + k; const bool ok = (tt >= 0) && (tt < T); const int tc = min(max(tt, 0), T - 1); \
            u32x4 v_ = *(const u32x4*)(QKV + (size_t)(m0 + tc) * 3072 + part * 1024 + h * 128 + cg_ * 8); \
            if (!ok) v_ = (u32x4){0u, 0u, 0u, 0u}; xraw[part][k] = v_; } } while (0)
#ifdef DELTA_PREFETCH
    DELTA_LOAD_RAW((dir ? nch - 1 : 0) * 64);
#endif
#pragma unroll 1
    for (int ci = 0; ci < nch; ++ci) {
        const int tid = opq(threadIdx.x), w = __builtin_amdgcn_readfirstlane(tid >> 6), lane = tid & 63, r = lane & 31, hh = lane >> 5;
        const int kb = w >> 1, vb0 = 2 * (w & 1);
        const int t0 = (dir ? nch - 1 - ci : ci) * 64;
        u32x4 kpk[2], vpk[2];
        const int tlo = t0 + 2 * (tid >> 4);
#ifndef DELTA_PREFETCH
        DELTA_LOAD_RAW(t0);
#endif
        REP_D1 {
        {
            const int cg = tid & 15;
#pragma unroll
            for (int pass = 0; pass < 2; ++pass) {
                const int t = tlo + pass, i = dir ? t0 + 63 - t : t - t0;
                u32x4 pk[3];
#pragma unroll
                for (int part = 0; part < 3; ++part) {
                    const u32x4 xm = xraw[part][pass], x0 = xraw[part][pass + 1], xp = xraw[part][pass + 2];
                    float o[8]; float ss = 0.f;
#pragma unroll
                    for (int e = 0; e < 4; ++e) {
                        const f32x2 w0 = *(const LAS f32x2*)(CW + part * 128 + cg * 8 + 2 * e), w1 = *(const LAS f32x2*)(CW + 384 + part * 128 + cg * 8 + 2 * e), w2 = *(const LAS f32x2*)(CW + 768 + part * 128 + cg * 8 + 2 * e);
                        const float a0 = w0.x * bflo(xm[e]) + w1.x * bflo(x0[e]) + w2.x * bflo(xp[e]);
                        const float a1 = w0.y * bfhi(xm[e]) + w1.y * bfhi(x0[e]) + w2.y * bfhi(xp[e]);
                        o[2 * e] = siluf_(a0); o[2 * e + 1] = siluf_(a1);
                        ss += o[2 * e] * o[2 * e] + o[2 * e + 1] * o[2 * e + 1];
                    }
                    float sc = 1.0f;
                    if (part < 2) {
                        ss += __shfl_xor(ss, 1); ss += __shfl_xor(ss, 2); ss += __shfl_xor(ss, 4); ss += __shfl_xor(ss, 8);
                        sc = __builtin_amdgcn_rsqf(ss + 1e-6f) * (part == 0 ? 0.08838834764831845f : 1.0f);
                    }
                    pk[part].x = pk2(o[0] * sc, o[1] * sc); pk[part].y = pk2(o[2] * sc, o[3] * sc); pk[part].z = pk2(o[4] * sc, o[5] * sc); pk[part].w = pk2(o[6] * sc, o[7] * sc);
                }
                *(LAS u32x4*)(QN + i * DP128 + cg * 8) = pk[0];
                *(LAS u32x4*)(KN + i * DP128 + cg * 8) = pk[1];
                kpk[pass] = pk[1]; vpk[pass] = pk[2];
            }
        }
#ifdef DELTA_PREFETCH
        if (ci + 1 < nch) DELTA_LOAD_RAW((dir ? nch - 2 - ci : ci + 1) * 64);
#endif
        if (w == 0) {
            const int t = dir ? t0 + 63 - lane : t0 + lane;
            const float* ab = AB + (size_t)(m0 + t) * 32 + dir * 8 + h;
            const float xa = ab[0] + dtb, xb = ab[16];
            const float sp = xa > 20.f ? xa : log1pf(__expf(xa));
            float g = -Aexp * sp;
#pragma unroll
            for (int off = 1; off < 64; off <<= 1) { const float tmp = __shfl_up(g, off); if (lane >= off) g += tmp; }
            const float gl = __shfl(g, 63);
            GT[lane] = g; GT[64 + lane] = sigmoidf_(xb); GT[128 + lane] = __expf(g); GT[192 + lane] = __expf(gl - g);
            if (lane == 0) GT[256] = __expf(gl);
        }
        for (int i = tid; i < 64 * DP64 / 2; i += 512) { ((LAS unsigned*)TM)[i] = 0u; ((LAS unsigned*)TDT)[i] = 0u; }
        __syncthreads();
        }
        REP_D3 {
        {
            const int mat = w >> 2, ib = (w >> 1) & 1, jb = w & 1;
            f32x16 acc;
#pragma unroll
            for (int i = 0; i < 16; ++i) acc[i] = 0.f;
            if (ib >= jb) {
                const LAS bf16_t* X = mat ? QN : KN;
#pragma unroll
                for (int s = 0; s < 8; ++s) acc = MFMA32(ldfrag(X, 32 * ib + r, DP128, 16 * s + 8 * hh), ldfrag(KN, 32 * jb + r, DP128, 16 * s + 8 * hh), acc);
            }
            const int col = 32 * jb + r; const float gc = GT[col];
#pragma unroll
            for (int i = 0; i < 16; ++i) {
                const int row = 32 * ib + crow_(i, hh);
                const float dg = (row >= col) ? __expf(GT[row] - gc) : 0.f;
                if (mat == 0) {
                    const float a = (row > col) ? GT[64 + row] * acc[i] * dg : 0.f;
                    const bool same16 = (row >> 4) == (col >> 4), same32 = (row >> 5) == (col >> 5);
                    if (same16) AD[((row >> 4) * 16 + (row & 15)) * 20 + (col & 15)] = a;
                    AL1[row * DP64 + col] = (bf16_t)(pk2((same32 && !same16) ? a : 0.f, 0.f) & 0xffffu);
                    AL2[row * DP64 + col] = (bf16_t)(pk2(!same32 ? a : 0.f, 0.f) & 0xffffu);
                } else {
                    ATT[row * DP64 + col] = (bf16_t)(pk2((row >= col) ? acc[i] * dg : 0.f, 0.f) & 0xffffu);
                }
            }
        }
        __syncthreads();
        if (w == 0) {
            const int b = lane >> 4, c = lane & 15;
            const LAS float* ad = AD + b * 16 * 20;
            float X[16];
#pragma unroll
            for (int i = 0; i < 16; ++i) {
                float x = (i == c) ? 1.f : 0.f;
#pragma unroll
                for (int j4 = 0; j4 < (i + 3) / 4; ++j4) {
                    const f32x4 a = *(const LAS f32x4*)(ad + i * 20 + 4 * j4);
                    if (4 * j4 + 0 < i) x -= a.x * X[4 * j4 + 0];
                    if (4 * j4 + 1 < i) x -= a.y * X[4 * j4 + 1];
                    if (4 * j4 + 2 < i) x -= a.z * X[4 * j4 + 2];
                    if (4 * j4 + 3 < i) x -= a.w * X[4 * j4 + 3];
                }
                X[i] = x;
            }
#pragma unroll
            for (int i = 0; i < 16; ++i) TM[(16 * b + i) * DP64 + 16 * b + c] = (bf16_t)(pk2(X[i], 0.f) & 0xffffu);
#pragma unroll
            for (int g = 0; g < 4; ++g) { u32x2 wv; wv.x = pk2(X[4 * g], X[4 * g + 1]); wv.y = pk2(X[4 * g + 2], X[4 * g + 3]);
                *(LAS u32x2*)(TDT + (16 * b + c) * DP64 + 16 * b + 4 * g) = wv; }
        }
        __syncthreads();
        }
        const int ib5 = (w >> 1) & 1, jb5 = w & 1;
        f32x16 zero16;
#pragma unroll
        for (int i = 0; i < 16; ++i) zero16[i] = 0.f;
        if (w < 4) { const f32x16 p1 = mm64_tile(AL1, TDT, ib5, jb5, r, hh, zero16); store_tileT(P1T, DP64, 32 * jb5 + r, 32 * ib5, hh, p1, -1.0f); }
        __syncthreads();
        if (w < 4) {
            f32x16 c0;
#pragma unroll
            for (int i = 0; i < 16; ++i) c0[i] = bf2f(TM[(32 * ib5 + crow_(i, hh)) * DP64 + 32 * jb5 + r]);
            const f32x16 t1 = mm64_tile(TM, P1T, ib5, jb5, r, hh, c0);
            store_tileR(T1, DP64, 32 * jb5 + r, 32 * ib5, hh, t1); store_tileT(T1T, DP64, 32 * jb5 + r, 32 * ib5, hh, t1, 1.0f);
        }
        __syncthreads();
        if (w < 4) { const f32x16 p3 = mm64_tile(AL2, T1T, ib5, jb5, r, hh, zero16); store_tileT(P1T, DP64, 32 * jb5 + r, 32 * ib5, hh, p3, -1.0f); }
        __syncthreads();
        if (w < 4) {
            f32x16 c0;
#pragma unroll
            for (int i = 0; i < 16; ++i) c0[i] = bf2f(T1[(32 * ib5 + crow_(i, hh)) * DP64 + 32 * jb5 + r]);
            const f32x16 tt = mm64_tile(T1, P1T, ib5, jb5, r, hh, c0);
            store_tileR(TM, DP64, 32 * jb5 + r, 32 * ib5, hh, tt);
        }
        __syncthreads();
        const int cb = w >> 2, vb = w & 3;
        f32x16 O0;
        REP_D6 {
        {
            const int cg = tid & 15;
#pragma unroll
            for (int pass = 0; pass < 2; ++pass) {
                const int t = tlo + pass, i = dir ? t0 + 63 - t : t - t0;
#pragma unroll
                for (int e = 0; e < 4; ++e) {
                    const int ci_ = (((i >> 3) ^ (cg & 7)) << 3) + (i & 7);
                    KNT[(cg * 8 + 2 * e) * DP64 + ci_] = (bf16_t)(kpk[pass][e] & 0xffffu); KNT[(cg * 8 + 2 * e + 1) * DP64 + ci_] = (bf16_t)(kpk[pass][e] >> 16);
                    VT[(cg * 8 + 2 * e) * DP64 + ci_] = (bf16_t)(vpk[pass][e] & 0xffffu); VT[(cg * 8 + 2 * e + 1) * DP64 + ci_] = (bf16_t)(vpk[pass][e] >> 16);
                }
            }
#pragma unroll
            for (int e = 0; e < 2; ++e) store_tileT(ST, DP128, 32 * (vb0 + e) + r, 32 * kb, hh, Sacc[e], 1.0f);
        }
        __syncthreads();
        {
            f32x16 ks = zero16, qs = zero16;
#pragma unroll
            for (int s = 0; s < 8; ++s) {
                const bf16x8 sf = ldfrag(ST, 32 * vb + r, DP128, 16 * s + 8 * hh);
                ks = MFMA32(ldfrag(KN, 32 * cb + r, DP128, 16 * s + 8 * hh), sf, ks);
                qs = MFMA32(ldfrag(QN, 32 * cb + r, DP128, 16 * s + 8 * hh), sf, qs);
            }
            f32x16 rr;
#pragma unroll
            for (int g = 0; g < 4; ++g) {
                const u32x2 vv = *(const LAS u32x2*)(VT + (32 * vb + r) * DP64 + (((4 * cb + g) ^ ((r >> 3) & 3) ^ ((vb & 1) << 2)) << 3) + 4 * hh);
                const float v4[4] = {bflo(vv.x), bfhi(vv.x), bflo(vv.y), bfhi(vv.y)};
#pragma unroll
                for (int j = 0; j < 4; ++j) {
                    const int c = 32 * cb + 8 * g + 4 * hh + j; const float eg = GT[128 + c];
                    rr[4 * g + j] = GT[64 + c] * (v4[j] - eg * ks[4 * g + j]);
                    O0[4 * g + j] = eg * qs[4 * g + j];
                }
            }
            store_tileT(RT, DP64, 32 * vb + r, 32 * cb, hh, rr, 1.0f);
        }
        __syncthreads();
        }
        {
            const f32x16 vn = mm64_tile(TM, RT, cb, vb, r, hh, zero16);
            f32x16 vs;
#pragma unroll
            for (int i = 0; i < 16; ++i) vs[i] = vn[i] * GT[192 + 32 * cb + crow_(i, hh)];
            store_tileT(VNT, DP64, 32 * vb + r, 32 * cb, hh, vn, 1.0f);
            store_tileT(VNST, DP64, 32 * vb + r, 32 * cb, hh, vs, 1.0f);
        }
        __syncthreads();
        {
            const f32x16 o = mm64_tile(ATT, VNT, cb, vb, r, hh, O0);
#pragma unroll
            for (int i = 0; i < 16; ++i) {
                const int c = 32 * cb + crow_(i, hh), t = dir ? t0 + 63 - c : t0 + c;
                OUT[(size_t)(m0 + t) * 1024 + h * 128 + 32 * vb + r] = (bf16_t)(pk2(o[i], 0.f) & 0xffffu);
            }
            const float egl = GT[256];
#pragma unroll
            for (int e = 0; e < 2; ++e) {
                f32x16 a = Sacc[e] * egl;
#pragma unroll
                for (int s2 = 0; s2 < 4; ++s2) {
                    const int row = 32 * kb + r, blk = (2 * s2 + hh) ^ ((row >> 3) & 7);
                    a = MFMA32(ldfrag(KNT, row, DP64, 8 * blk), ldfrag(VNST, 32 * (vb0 + e) + r, DP64, 16 * s2 + 8 * hh), a);
                }
                Sacc[e] = a;
            }
        }
        __syncthreads();
    }
    if (sfin) {
        const int lane = tid0 & 63, r = lane & 31, hh = lane >> 5, kb = w0 >> 1, vb0 = 2 * (w0 & 1);
#pragma unroll
        for (int e = 0; e < 2; ++e)
#pragma unroll
            for (int i = 0; i < 16; ++i) sfin[(size_t)(32 * kb + crow_(i, hh)) * 128 + 32 * (vb0 + e) + r] = Sacc[e][i];
    }
}
DI void delta_dispatch(LAS unsigned char* lds, int U, const bf16_t* QKV, const float* AB, const float* conv_w, const float* a_log, const float* dt_bias,
                       const float* state, float* news, bf16_t* OF, bf16_t* OB) {
    int b, h, dir, m0, T; const float* s0 = nullptr; float* sf = nullptr;
    if (U < 128) { b = U >> 4; h = (U >> 1) & 7; dir = U & 1; m0 = NPR + b * 2048; T = 2048; s0 = state + (size_t)((b * 2 + dir) * 8 + h) * 16384; }
    else { const int u = U - 128; b = u >> 4; h = (u >> 1) & 7; dir = u & 1; m0 = b * 256; T = 256; sf = news + (size_t)((b * 2 + dir) * 8 + h) * 16384; }
    const float Aexp = __expf(a_log[dir * 8 + h]), dtb = dt_bias[dir * 8 + h];
#ifdef DELTA_SEQ
    delta_unit(lds, QKV, AB, conv_w, Aexp, dtb, m0, T, h, dir, s0, sf, dir ? OB : OF);
#else
    delta_unit_chunked(lds, QKV, AB, conv_w, Aexp, dtb, m0, T, h, dir, s0, sf, dir ? OB : OF);
#endif
}

DI void y_phase(bf16_t* OF, const bf16_t* OB, const bf16_t* Z, const float* out_norm, int gw, int NGW, int lane) {
    for (int m = gw; m < NTOK; m += NGW) {
        const size_t off = (size_t)m * 1024 + 16 * lane;
        const u32x4 f0 = *(const u32x4*)(OF + off), f1 = *(const u32x4*)(OF + off + 8);
        const u32x4 b0 = *(const u32x4*)(OB + off), b1 = *(const u32x4*)(OB + off + 8);
        const u32x4 z0 = *(const u32x4*)(Z + off), z1 = *(const u32x4*)(Z + off + 8);
        float o[16], z[16]; float ss = 0.f;
#pragma unroll
        for (int e = 0; e < 4; ++e) {
            o[2 * e] = bflo(f0[e]) + bflo(b0[e]); o[2 * e + 1] = bfhi(f0[e]) + bfhi(b0[e]);
            o[8 + 2 * e] = bflo(f1[e]) + bflo(b1[e]); o[8 + 2 * e + 1] = bfhi(f1[e]) + bfhi(b1[e]);
            z[2 * e] = bflo(z0[e]); z[2 * e + 1] = bfhi(z0[e]); z[8 + 2 * e] = bflo(z1[e]); z[8 + 2 * e + 1] = bfhi(z1[e]);
        }
#pragma unroll
        for (int e = 0; e < 16; ++e) ss += o[e] * o[e];
        ss += __shfl_xor(ss, 1); ss += __shfl_xor(ss, 2); ss += __shfl_xor(ss, 4);
        const float rstd = __builtin_amdgcn_rsqf(ss * (1.0f / 128.0f) + 1e-6f);
        const float* gn = out_norm + ((16 * lane) & 127);
        float y[16];
#pragma unroll
        for (int e = 0; e < 16; ++e) y[e] = o[e] * rstd * gn[e] * siluf_(z[e]);
        u32x4 w0, w1;
        w0.x = pk2(y[0], y[1]); w0.y = pk2(y[2], y[3]); w0.z = pk2(y[4], y[5]); w0.w = pk2(y[6], y[7]);
        w1.x = pk2(y[8], y[9]); w1.y = pk2(y[10], y[11]); w1.z = pk2(y[12], y[13]); w1.w = pk2(y[14], y[15]);
        *(u32x4*)(OF + off) = w0; *(u32x4*)(OF + off + 8) = w1;
    }
}

__global__ void __launch_bounds__(512, 2) fwd_megakernel(Params p) {
    extern __shared__ __attribute__((aligned(16))) unsigned char lds_raw[];
    LAS unsigned char* lds = (LAS unsigned char*)lds_raw;
    cg::grid_group grid = cg::this_grid();
    const int G = gridDim.x, bid = blockIdx.x, NGW = G * 8;
#define IDS() const int tid = opq(threadIdx.x), lane = tid & 63, wave = __builtin_amdgcn_readfirstlane(tid >> 6), gw = bid * 8 + wave; (void)gw; (void)lane; (void)tid
    unsigned char* ws = p.ws;
    float* mod = (float*)(ws + WS_MOD);
    float* Y = p.out + OUT_Y;
    bf16_t* XB = (bf16_t*)(p.out + OUT_Y) + 1024;
    bf16_t* WQKV1 = (bf16_t*)(ws + WS_WQKV1); bf16_t* WZ1 = (bf16_t*)(ws + WS_WZ1); bf16_t* WOUT1 = (bf16_t*)(ws + WS_WOUT1);
    bf16_t* WIN0 = (bf16_t*)(ws + B_WIN0); bf16_t* WOUT0 = (bf16_t*)(ws + B_WOUT0); bf16_t* W1_0 = (bf16_t*)(ws + B_W1_0); bf16_t* W2_0 = (bf16_t*)(ws + B_W2_0);
    bf16_t* H0 = (bf16_t*)(ws + B_H0); bf16_t* Qb = (bf16_t*)(ws + B_Q); bf16_t* KS = (bf16_t*)(ws + B_KS); bf16_t* VTS = (bf16_t*)(ws + B_VTS);
    bf16_t* KP = (bf16_t*)(ws + B_KP); bf16_t* VTP = (bf16_t*)(ws + B_VTP); bf16_t* FF0 = (bf16_t*)(ws + B_FF0);
    bf16_t* QKV1 = (bf16_t*)(ws + B_QKV1); float* AB = (float*)(ws + B_AB); bf16_t* OF = (bf16_t*)(ws + B_OF); bf16_t* OB = (bf16_t*)(ws + B_OB);
    bf16_t* H1 = (bf16_t*)(ws + B_H1); bf16_t* W1_1 = (bf16_t*)(ws + B_W1_1); bf16_t* W2_1 = (bf16_t*)(ws + B_W2_1); bf16_t* H1B = (bf16_t*)(ws + B_H1B);
    bf16_t* Zb = (bf16_t*)(ws + B_Z); bf16_t* FF1 = (bf16_t*)(ws + B_FF1);
    float* Pside = (float*)(ws + B_PS);
    bf16_t* HL = (bf16_t*)(p.out + OUT_Y);
    bf16_t* FFL0 = (bf16_t*)(ws + B_FFL0); bf16_t* FFL1 = (bf16_t*)(ws + B_FFL1);

    unsigned* barw = (unsigned*)(ws + 524288);
    volatile LAS unsigned* bar_st = (volatile LAS unsigned*)(lds + LDS_BYTES - 512);
    if (threadIdx.x < 2) bar_st[threadIdx.x] = 0u;
    if (p.ws == nullptr) grid.sync();
    __syncthreads();
    const XcdBarrier xbar = xcd_barrier_post(barw, bar_st);
#define GSYNC() xcd_barrier(xbar)
#define W2_GEMM(FFb, W2b, modl) do { \
        pg8::Gemm g{FFb, W2b, 4096, 4096, NTOK, 1024, 4096}; \
        EpiRes E{nullptr, nullptr, XB, modl + 5120, Pside, 0}; \
        if (G == 256) { pg8::W2Order S; S.c = bid; S.ntf = 64; pg8::gemm_phase(lds, g, S, E); } \
        else { pg8::StaticOrder S; S.init(NTOK, 1024, G, bid); pg8::gemm_phase(lds, g, S, E); } } while (0)
    {
        IDS();
        LAS float* scr = (LAS float*)(lds + wave * 8704);
        transpose_matrix(p.in[10], 1024, 2304, WIN0, scr, gw, NGW, lane);
        const bool later = (G == 256);
        if (!later) {
        transpose_matrix(p.in[16], 1024, 1024, WOUT0, scr, gw, NGW, lane);
        transpose_matrix(p.in[18], 1024, 4096, W1_0, scr, gw, NGW, lane);
        transpose_matrix(p.in[19], 4096, 1024, W2_0, scr, gw, NGW, lane);
        transpose_matrix(p.in[28], 1024, 1024, WOUT1, scr, gw, NGW, lane);
        }
        if (!later) {
            const float* W = p.in[23]; const int nblk = 129, nitems = 16 * nblk;
            for (int it = gw; it < nitems; it += NGW) { const int kb = it / nblk, nb = it % nblk, n0 = nb * 32;
                if (n0 < 3072) transpose_item(W, 4128, kb * 64, n0, WQKV1, 1024, perm_row32(n0), scr, lane);
                else if (n0 < 4096) transpose_item(W, 4128, kb * 64, n0, WZ1, 1024, perm_row32(n0 - 3072), scr, lane);
                else transpose_item(W, 4128, kb * 64, n0, WQKV1, 1024, 3072, scr, lane); }
            u32x4* zp = (u32x4*)(WQKV1 + (size_t)3104 * 1024); const int nz = 224 * 1024 * 2 / 16;
            for (int i = bid * 512 + tid; i < nz; i += G * 512) zp[i] = (u32x4){0u, 0u, 0u, 0u};
        }
        {
            const float* ck = p.in[3]; const float* cv = p.in[4];
            for (int e = bid * 512 + tid; e < 8 * 256 * 640; e += G * 512) {
                const int b = e / (256 * 640), rem = e % (256 * 640), pp = rem / 640, hd = rem % 640, head = hd >> 6, d = hd & 63, kk = pp & 31;
                const size_t tbase = ((size_t)(b * 10 + head) * 72 + 64 + (pp >> 5)) * 2048;
                KS[tbase + ((d >> 3) * 32 + kk) * 8 + (d & 7)] = (bf16_t)(pk2(ck[e], 0.f) & 0xffffu);
                VTS[tbase + ((((((d >> 5) * 2 + (kk >> 4)) * 2 + ((kk >> 3) & 1)) * 2 + ((kk >> 2) & 1)) * 32 + (d & 31)) << 2) + (kk & 3)] = (bf16_t)(pk2(cv[e], 0.f) & 0xffffu);
            }
        }
        __syncthreads();
        LAS float* sv = (LAS float*)lds;
        LAS float* red = sv + 1024 * 12;
        bool sv_ready = false;
        for (int U = bid; U < 192; U += G) {
            if (!sv_ready) {
                for (int i = tid; i < 9 * 1024; i += 512) { const int r = i >> 10, k = i & 1023; const float x = (r == 0) ? p.in[6][k] : p.in[2][(r - 1) * 1024 + k]; sv[k * 12 + r] = siluf_(x); }
                sv_ready = true; __syncthreads();
            }
            const int l = U / 96, j0 = (U % 96) * 64;
            const float* W = p.in[l ? 20 : 7]; const float* bias = p.in[l ? 21 : 8];
            float a[9];
#pragma unroll
            for (int r = 0; r < 9; ++r) a[r] = 0.f;
            const int kbeg = wave * 128;
#pragma unroll 16
            for (int k = kbeg; k < kbeg + 128; ++k) {
                const float w = W[(size_t)k * MODW + j0 + lane];
                const f32x4 s0 = *(const LAS f32x4*)(sv + k * 12), s1 = *(const LAS f32x4*)(sv + k * 12 + 4); const float s8 = sv[k * 12 + 8];
                a[0] += w * s0.x; a[1] += w * s0.y; a[2] += w * s0.z; a[3] += w * s0.w; a[4] += w * s1.x; a[5] += w * s1.y; a[6] += w * s1.z; a[7] += w * s1.w; a[8] += w * s8;
            }
#pragma unroll
            for (int r = 0; r < 9; ++r) red[(wave * 9 + r) * 64 + lane] = a[r];
            __syncthreads();
            for (int i = tid; i < 576; i += 512) { const int r = i >> 6, c = i & 63; float s = bias[j0 + c];
#pragma unroll
                for (int w = 0; w < 8; ++w) s += red[(w * 9 + r) * 64 + c];
                mod[(size_t)(l * 9 + r) * MODW + j0 + c] = s; }
            __syncthreads();
        }
    }
    GSYNC();

    const float* mod0 = mod; const float* mod1 = mod + 9 * MODW;
    { IDS(); norm_phase(p.in[0], p.in[1], nullptr, p.in[9], mod0 + 0, mod0 + 1024, H0, DM, gw, NGW, lane); }
    GSYNC();
    {
        pg8::Gemm g{H0, WIN0, 1024, 1024, NTOK, 2304, 1024}; pg8::StaticOrder S; S.init(NTOK, 2304, G, bid);
        EpiQKV0 E{Qb, KS, VTS, KP, VTP, p.out + OUT_NEWK, p.out + OUT_NEWV, p.in[11], p.in[12], p.in[13], p.in[14]};
        pg8::gemm_phase(lds, g, S, E);
        if (G == 256 && bid >= 96) {
            IDS();
            LAS float* scr = (LAS float*)(lds + wave * 8704);
            const int gw2 = (bid - 96) * 8 + wave, NGW2 = 160 * 8;
            transpose_matrix(p.in[16], 1024, 1024, WOUT0, scr, gw2, NGW2, lane);
            transpose_matrix(p.in[18], 1024, 4096, W1_0, scr, gw2, NGW2, lane);
            transpose_matrix(p.in[19], 4096, 1024, W2_0, scr, gw2, NGW2, lane);
            transpose_matrix(p.in[28], 1024, 1024, WOUT1, scr, gw2, NGW2, lane);
            const float* W = p.in[23]; const int nblk = 129, nitems = 16 * nblk;
            for (int it = gw2; it < nitems; it += NGW2) { const int kb = it / nblk, nb = it % nblk, n0 = nb * 32;
                if (n0 < 3072) transpose_item(W, 4128, kb * 64, n0, WQKV1, 1024, perm_row32(n0), scr, lane);
                else if (n0 < 4096) transpose_item(W, 4128, kb * 64, n0, WZ1, 1024, perm_row32(n0 - 3072), scr, lane);
                else transpose_item(W, 4128, kb * 64, n0, WQKV1, 1024, 3072, scr, lane); }
            u32x4* zp = (u32x4*)(WQKV1 + (size_t)3104 * 1024); const int nz = 224 * 1024 * 2 / 16;
            for (int i = (bid - 96) * 512 + tid; i < nz; i += 160 * 512) zp[i] = (u32x4){0u, 0u, 0u, 0u};
        }
    }
    GSYNC();
    { IDS();
      LAS float* sbias = (LAS float*)lds;
      for (int i = tid; i < 3720; i += 512) sbias[i] = p.in[15][i];
      __syncthreads();
      attention_phase(Qb, KS, VTS, KP, VTP, sbias, p.in[11], p.in[12], p.in[13], p.in[14], H0, gw, NGW, lane); }
#ifdef PROBE_ATTN
    GSYNC();
    { IDS(); attention_phase(Qb, KS, VTS, KP, VTP, (const LAS float*)lds, p.in[11], p.in[12], p.in[13], p.in[14], H0, gw, NGW, lane); }
#endif
    GSYNC();
    {
        pg8::Gemm g{H0, WOUT0, 1024, 1024, NTOK, 1024, 1024}; pg8::StaticOrder S; S.init(NTOK, 1024, G, bid);
        EpiRes E{p.in[0], p.in[1], XB, mod0 + 2048, nullptr, 0};
        pg8::gemm_phase(lds, g, S, E);
    }
    GSYNC();
    { IDS(); norm_phase(nullptr, nullptr, XB, p.in[17], mod0 + 3072, mod0 + 4096, HL, XBP, gw, NGW, lane); }
    GSYNC();
    {
        pg8::Gemm g{HL, W1_0, XBP, 1024, NTOK, 4096, 1024}; pg8::StaticOrder S; S.init(NTOK, 4096, G, bid);
        EpiBf16<1> E{FFL0, 4096};
        pg8::gemm_phase(lds, g, S, E);
    }
    GSYNC();
    W2_GEMM(FFL0, W2_0, mod0);
    GSYNC();
    { IDS(); norm_phase(nullptr, nullptr, XB, p.in[22], mod1 + 0, mod1 + 1024, HL, XBP, gw, NGW, lane, (G == 256) ? Pside : nullptr); }
    GSYNC();
    {
        pg8::Gemm g{HL, WQKV1, XBP, 1024, NTOK, 3328, 1024}; pg8::StaticOrder S; S.init(NTOK, 3328, G, bid);
        EpiQKV1 E{QKV1, AB};
        pg8::gemm_phase(lds, g, S, E);
    }
    GSYNC();
#ifdef PROBE_DELTA
    for (int rep = 0; rep < 2; ++rep)
#endif
    {
        float* news = p.out + OUT_NEWS;
#ifdef PROBE_DELTA
        if (rep) GSYNC();
#endif
        const bool bal = (G == 256);
        const int nun = bal ? (bid < 128 ? 1 : 4) : (640 - bid + G - 1) / G;
#pragma unroll 1
        for (int i = 0; i < nun; ++i) {
            const int U = bal ? (bid < 128 ? bid : 128 + (bid - 128) * 4 + i) : bid + i * G;
            delta_dispatch(lds, U, QKV1, AB, p.in[24], p.in[25], p.in[26], p.in[5], news, OF, OB);
        }
    }
    GSYNC();
    if (G != 256) {
        IDS();
        LAS float* scr = (LAS float*)(lds + wave * 8704);
        transpose_matrix(p.in[30], 1024, 4096, W1_1, scr, gw, NGW, lane);
        transpose_matrix(p.in[31], 4096, 1024, W2_1, scr, gw, NGW, lane);
    }
    {
        pg8::Gemm g{HL, WZ1, XBP, 1024, NTOK, 1024, 1024}; pg8::StaticOrder S; S.init(NTOK, 1024, G, bid);
        EpiZY E{OF, OB, p.in[27], (LAS float*)(lds + 131072)};
        pg8::gemm_phase(lds, g, S, E);
        if (G == 256 && bid >= 128) {
            IDS();
            LAS float* scr = (LAS float*)(lds + wave * 8704);
            const int gw2 = (bid - 128) * 8 + wave, NGW2 = 128 * 8;
            transpose_matrix(p.in[30], 1024, 4096, W1_1, scr, gw2, NGW2, lane);
            transpose_matrix(p.in[31], 4096, 1024, W2_1, scr, gw2, NGW2, lane);
        }
    }
    GSYNC();
    {
        pg8::Gemm g{OF, WOUT1, 1024, 1024, NTOK, 1024, 1024}; pg8::StaticOrder S; S.init(NTOK, 1024, G, bid);
        EpiRes E{nullptr, nullptr, XB, mod1 + 2048, nullptr, 0};
        pg8::gemm_phase(lds, g, S, E);
    }
    GSYNC();
    { IDS(); norm_phase(nullptr, nullptr, XB, p.in[29], mod1 + 3072, mod1 + 4096, HL, XBP, gw, NGW, lane); }
    GSYNC();
    {
        pg8::Gemm g{HL, W1_1, XBP, 1024, NTOK, 4096, 1024}; pg8::StaticOrder S; S.init(NTOK, 4096, G, bid);
        EpiBf16<1> E{FFL1, 4096};
        pg8::gemm_phase(lds, g, S, E);
    }
    GSYNC();
    W2_GEMM(FFL1, W2_1, mod1);
    {
        GSYNC();
        IDS();
        const bool fold = (G == 256);
        for (int m = gw; m < NTOK; m += NGW) {
            const bf16_t* xr = XB + (size_t)m * XBP + 16 * lane;
            const u32x4 w0 = *(const u32x4*)xr, w1 = *(const u32x4*)(xr + 8);
            f32x4 o[4] = {(f32x4){bflo(w0.x), bfhi(w0.x), bflo(w0.y), bfhi(w0.y)}, (f32x4){bflo(w0.z), bfhi(w0.z), bflo(w0.w), bfhi(w0.w)},
                          (f32x4){bflo(w1.x), bfhi(w1.x), bflo(w1.y), bfhi(w1.y)}, (f32x4){bflo(w1.z), bfhi(w1.z), bflo(w1.w), bfhi(w1.w)}};
            if (fold && m >= 16384) {
#pragma unroll
                for (int j = 0; j < 4; ++j) o[j] = o[j] + *(const f32x4*)(Pside + (size_t)(m - 16384) * DM + 16 * lane + 4 * j);
            }
            asm volatile("s_waitcnt vmcnt(0)" ::: "memory");
#pragma unroll
            for (int j = 0; j < 4; ++j) *(f32x4*)(Y + (size_t)m * DM + 16 * lane + 4 * j) = o[j];
        }
    }
}

extern "C" void kernel_launch(void* const* d_in, const int* in_sizes, int n_in, void* d_out, int out_size, void* d_ws, size_t ws_size, hipStream_t stream) {
    static int grid_blocks = 0;
    if (!grid_blocks) {
        if (n_in != 32 || ws_size < WS_NEED) { fprintf(stderr, "kernel_launch: unexpected n_in %d / ws_size %zu (need %zu)\n", n_in, ws_size, (size_t)WS_NEED); grid_blocks = -1; return; }
        int dev = 0, cus = 0, per_cu = 0;
        hipGetDevice(&dev);
        hipDeviceGetAttribute(&cus, hipDeviceAttributeMultiprocessorCount, dev);
        hipFuncSetAttribute((const void*)fwd_megakernel, hipFuncAttributeMaxDynamicSharedMemorySize, LDS_BYTES);
        hipOccupancyMaxActiveBlocksPerMultiprocessor(&per_cu, (const void*)fwd_megakernel, 512, LDS_BYTES);
        if (per_cu < 1) { fprintf(stderr, "kernel_launch: occupancy query returned %d\n", per_cu); per_cu = 1; }
        grid_blocks = cus * per_cu;
    }
    if (grid_blocks < 0) return;
    Params p{};
    for (int i = 0; i < 32; ++i) p.in[i] = (const float*)d_in[i];
    p.out = (float*)d_out; p.ws = (unsigned char*)d_ws;
    if (hipMemsetAsync((char*)d_ws + 524288, 0, XCD_BAR_WORDS * 4, stream) != hipSuccess) { fprintf(stderr, "kernel_launch: memset of barrier words failed\n"); return; }
    void* args[] = {&p};
    hipError_t e = hipLaunchCooperativeKernel((const void*)fwd_megakernel, dim3(grid_blocks), dim3(512), args, LDS_BYTES, stream);
    if (e != hipSuccess) fprintf(stderr, "cooperative launch failed: %s (grid %d)\n", hipGetErrorString(e), grid_blocks);
}
```

```cpp
#include <hip/hip_runtime.h>
#include <hip/hip_cooperative_groups.h>
#include <cstdio>
namespace cg = cooperative_groups;

#define LAS __attribute__((address_space(3)))
#define DI __device__ __forceinline__
typedef unsigned short bf16_t;
typedef short bf16x8 __attribute__((ext_vector_type(8)));
typedef short s16x4 __attribute__((ext_vector_type(4)));
typedef float f32x2 __attribute__((ext_vector_type(2)));
typedef float f32x4 __attribute__((ext_vector_type(4)));
typedef float f32x16 __attribute__((ext_vector_type(16)));
typedef unsigned u32x2 __attribute__((ext_vector_type(2)));
typedef unsigned u32x4 __attribute__((ext_vector_type(4)));
typedef __bf16 nbf16x2 __attribute__((ext_vector_type(2)));

DI unsigned pk2(float a, float b) { f32x2 v = {a, b}; nbf16x2 r = __builtin_convertvector(v, nbf16x2); return __builtin_bit_cast(unsigned, r); }
DI float bf2f(unsigned short h) { return __builtin_bit_cast(float, (unsigned)h << 16); }
DI float bflo(unsigned w) { return __builtin_bit_cast(float, w << 16); }
DI float bfhi(unsigned w) { return __builtin_bit_cast(float, w & 0xffff0000u); }
DI float sigmoidf_(float x) { return __builtin_amdgcn_rcpf(1.0f + __expf(-x)); }
DI float siluf_(float x) { return x * __builtin_amdgcn_rcpf(1.0f + __expf(-x)); }
DI int opq(int x) { asm volatile("" : "+v"(x)); return x; }

constexpr int NTOK = 24576, NPR = 8192, DM = 1024;
constexpr int MODW = 6144;
constexpr size_t OUT_Y = 0, OUT_NEWK = 25165824, OUT_NEWV = OUT_NEWK + 5242880, OUT_NEWS = OUT_NEWV + 5242880;
constexpr size_t WS_MOD = 0;
constexpr size_t WS_WQKV1 = 1048576;
constexpr size_t WS_WZ1 = WS_WQKV1 + 3328ull * 1024 * 2;
constexpr size_t WS_WOUT1 = WS_WZ1 + 1024ull * 1024 * 2;
constexpr size_t WS_BIG = WS_WOUT1 + 1024ull * 1024 * 2;
constexpr size_t B_WIN0 = WS_BIG, B_WOUT0 = B_WIN0 + 2304ull * 1024 * 2, B_W1_0 = B_WOUT0 + 1024ull * 1024 * 2, B_W2_0 = B_W1_0 + 4096ull * 1024 * 2;
constexpr size_t B_H0 = B_W2_0 + 4096ull * 1024 * 2;
constexpr size_t B_Q = B_H0 + (size_t)NTOK * 1024 * 2;
constexpr size_t B_KS = B_Q + (size_t)NTOK * 1024 * 2;
constexpr size_t B_VTS = B_KS + 8ull * 2304 * 640 * 2;
constexpr size_t B_KP = B_VTS + 8ull * 2304 * 640 * 2;
constexpr size_t B_VTP = B_KP + 8192ull * 640 * 2;
constexpr size_t B_FF0 = B_Q;
constexpr size_t B_QKV1 = WS_BIG;
constexpr size_t B_AB = B_QKV1 + (size_t)NTOK * 3072 * 2;
constexpr size_t B_OF = B_AB + (size_t)NTOK * 32 * 4;
constexpr size_t B_OB = B_OF + (size_t)NTOK * 1024 * 2;
constexpr size_t B_H1 = B_OF;
constexpr size_t B_W1_1 = WS_BIG, B_W2_1 = B_W1_1 + 4096ull * 1024 * 2;
constexpr size_t B_H1B = B_W2_1 + 4096ull * 1024 * 2;
constexpr size_t B_Z = B_H1B + (size_t)NTOK * 1024 * 2;
constexpr size_t B_FF1 = B_Z;
constexpr size_t B_FFL0 = B_H0, B_FFL1 = B_H1B;
constexpr size_t B_PS = B_FFL0 + (size_t)NTOK * 4096 * 2;
constexpr size_t WS_NEED = B_PS + 8192ull * 1024 * 4;
static_assert(B_FFL1 + (size_t)NTOK * 4096 * 2 <= B_PS && B_OB + (size_t)NTOK * 1024 * 2 <= WS_NEED, "ws map (mlp)");
static_assert(B_VTP + 8192ull * 640 * 2 <= WS_NEED && B_FF0 + (size_t)NTOK * 2048 * 2 <= WS_NEED && B_FF1 + (size_t)NTOK * 2048 * 2 <= WS_NEED, "ws map");
static_assert(B_Z + (size_t)NTOK * 1024 * 2 <= B_AB, "z inside dead qkv region");
static_assert(WS_NEED <= 271868064ull, "ws budget");

constexpr int LDS_BYTES = 151552;

struct Params { const float* in[32]; float* out; unsigned char* ws; };

namespace pg8 {
constexpr int BM = 256, BK = 64, HALF = 128, HTB = HALF * BK * 2, STAGE_BYTES = 8 * HTB, NXCD = 8, WGM = 8;
DI int lds_byte(int r, int c) { const int st = (r >> 4) * 2 + (c >> 5), rr = r & 15, cc = c & 31, ob = rr * 64 + cc * 2; return st * 1024 + (ob ^ (((ob >> 9) & 1) << 5)); }
DI void stage_rc(int b, int& R, int& C) { const int st = b / 1024, sb = b % 1024, swz = sb ^ (((sb >> 9) & 1) << 5); R = (st >> 1) * 16 + swz / 64; C = (st & 1) * 32 + (swz % 64) / 2; }
struct Unit { int pm, pn, kofs, nt, mode; };
struct Gemm { const bf16_t* A; const bf16_t* Bt; int lda, ldb, M, N, K; };
struct StaticOrder {
    int nM, nN, nwg, G, c;
    DI void init(int M, int N, int G_, int c_) { nM = M / BM; nN = N / BM; nwg = nM * nN; G = G_; c = c_; }
    DI bool next(int i, Unit& u) const {
        const long L = (long)i * G + c; if (L >= nwg) return false;
        int wgid = (int)L; { const int q = nwg / NXCD, r = nwg % NXCD, xcd = wgid % NXCD, off = wgid / NXCD; wgid = (xcd < r ? xcd * (q + 1) : r * (q + 1) + (xcd - r) * q) + off; }
        const int nig = WGM * nN, gid = wgid / nig, fm = gid * WGM, gsz = (nM - fm) < WGM ? (nM - fm) : WGM;
        u.pm = fm + ((wgid % nig) % gsz); u.pn = (wgid % nig) / gsz; u.kofs = 0; u.nt = 0; u.mode = 0; return true;
    }
};

struct W2Order { int c, ntf;
    DI bool next(int i, Unit& u) const {
        const int x = c & 7, j = c >> 3;
        if (i == 0) { u.pm = 8 * x + (j >> 2); u.pn = j & 3; u.kofs = 0; u.nt = ntf; u.mode = 0; return true; }
        if (i == 1) { const int st = j >> 1; u.pm = 64 + 4 * x + (st >> 2); u.pn = st & 3; u.kofs = (j & 1) * (ntf * 32); u.nt = ntf / 2; u.mode = j & 1; return true; }
        return false; } };

template <class Epi, class Sched>
DI void gemm_phase(LAS unsigned char* lds, const Gemm g, const Sched& S, const Epi& E) {
    const int tid = opq(threadIdx.x), wid = __builtin_amdgcn_readfirstlane(tid >> 6), lane = tid & 63, wr = wid >> 2, wc = wid & 3, fr = lane & 15, fq = lane >> 4;
    const int K = g.K;
    unsigned voffA[2], voffB[2];
#pragma unroll
    for (int i = 0; i < 2; ++i) { int R, C; stage_rc(tid * 16 + i * 8192, R, C);
        voffA[i] = (unsigned)(R * g.lda + C) * 2u; voffB[i] = (unsigned)(R * g.ldb + C) * 2u; }
    const size_t kstep = (size_t)(BK * 2);
    const size_t hstepA = (size_t)HALF * g.lda * 2, hstepB = (size_t)HALF * g.ldb * 2;
    const size_t tstepA = 2 * hstepA, tstepB = 2 * hstepB;
    const unsigned ldsw = (unsigned)wid * 1024u;
    const int aoff = lds_byte(wr * 64 + fr, fq * 8), boff = lds_byte(wc * 32 + fr, fq * 8);
#define PG8_SA(b, h) (((b) * 2 + (h)) * HTB)
#define PG8_SB(b, h) ((4 + (b) * 2 + (h)) * HTB)
#define PG8_STAGE(bufoff, gbase, voff) do { _Pragma("unroll") for (int _i = 0; _i < 2; ++_i) \
        __builtin_amdgcn_global_load_lds((const unsigned*)((const char*)(gbase) + (voff)[_i]), (LAS unsigned*)(lds + (bufoff) + ldsw + _i * 8192), 16, 0, 0); } while (0)
#define PG8_LDA(dst, b, h) do { _Pragma("unroll") for (int m = 0; m < 4; ++m) _Pragma("unroll") for (int k = 0; k < 2; ++k) dst[m][k] = *(const LAS bf16x8*)(lds + PG8_SA(b, h) + aoff + m * 2048 + k * 1024); } while (0)
#define PG8_LDB(dst, b, h) do { _Pragma("unroll") for (int n = 0; n < 2; ++n) _Pragma("unroll") for (int k = 0; k < 2; ++k) dst[n][k] = *(const LAS bf16x8*)(lds + PG8_SB(b, h) + boff + n * 2048 + k * 1024); } while (0)
#define PG8_MMA(ai, bj, At, Bt) do { __builtin_amdgcn_s_setprio(1); _Pragma("unroll") for (int m = 0; m < 4; ++m) _Pragma("unroll") for (int n = 0; n < 2; ++n) _Pragma("unroll") for (int k = 0; k < 2; ++k) \
        acc[ai][bj][m][n] = __builtin_amdgcn_mfma_f32_16x16x32_bf16(Bt[n][k], At[m][k], acc[ai][bj][m][n], 0, 0, 0); __builtin_amdgcn_s_setprio(0); } while (0)
#define PG8_WAIT_V(n) asm volatile("s_waitcnt vmcnt(" #n ")" ::: "memory")
#define PG8_WAIT_L(n) asm volatile("s_waitcnt lgkmcnt(" #n ")" ::: "memory")
#define PG8_BAR __builtin_amdgcn_s_barrier()
#define PG8_SCHED __builtin_amdgcn_sched_barrier(0)
    Unit cur, nxt; int ui = 0;
    if (!S.next(0, cur)) return;
    if (cur.nt == 0) cur.nt = K / BK;
    f32x4 acc[2][2][4][2];
#pragma unroll
    for (int a = 0; a < 2; ++a)
#pragma unroll
        for (int b = 0; b < 2; ++b)
#pragma unroll
            for (int m = 0; m < 4; ++m)
#pragma unroll
                for (int n = 0; n < 2; ++n) acc[a][b][m][n] = (f32x4){0.f, 0.f, 0.f, 0.f};
    bf16x8 At[4][2], B0[2][2], B1[2][2];
    const char* cA = (const char*)g.A + (size_t)cur.pm * tstepA + (size_t)cur.kofs * 2; const char* cB = (const char*)g.Bt + (size_t)cur.pn * tstepB + (size_t)cur.kofs * 2;
    PG8_STAGE(PG8_SB(0, 0), cB, voffB); PG8_STAGE(PG8_SB(0, 1), cB + hstepB, voffB); PG8_STAGE(PG8_SA(0, 0), cA, voffA); PG8_STAGE(PG8_SA(0, 1), cA + hstepA, voffA);
    if (wr == 1) PG8_BAR;
    PG8_WAIT_V(2); PG8_BAR;
    PG8_STAGE(PG8_SB(1, 0), cB + kstep, voffB); PG8_STAGE(PG8_SA(1, 0), cA + kstep, voffA); PG8_STAGE(PG8_SB(1, 1), cB + hstepB + kstep, voffB);
    PG8_WAIT_V(6); PG8_BAR;
    for (;;) {
        const bool has_next = S.next(ui + 1, nxt);
        if (has_next && nxt.nt == 0) nxt.nt = K / BK;
        const char* nA = has_next ? (const char*)g.A + (size_t)nxt.pm * tstepA + (size_t)nxt.kofs * 2 : cA; const char* nB = has_next ? (const char*)g.Bt + (size_t)nxt.pn * tstepB + (size_t)nxt.kofs * 2 : cB;
        const int nt = cur.nt;
        for (int t = 0; t < nt; t += 2) {
            const bool last = (t == nt - 2);
            const char* a1 = cA + (size_t)(t + 1) * kstep;
            const char* a2 = last ? nA : cA + (size_t)(t + 2) * kstep; const char* b2 = last ? nB : cB + (size_t)(t + 2) * kstep;
            const char* a3 = a2 + kstep; const char* b3 = b2 + kstep;
            PG8_LDB(B0, 0, 0); PG8_LDB(B1, 0, 1); PG8_SCHED; PG8_LDA(At, 0, 0); PG8_STAGE(PG8_SA(1, 1), a1 + hstepA, voffA);
            PG8_WAIT_V(8); PG8_WAIT_L(0); PG8_BAR; PG8_MMA(0, 0, At, B0); PG8_MMA(0, 1, At, B1); PG8_BAR; PG8_SCHED;
            PG8_LDA(At, 0, 1); PG8_STAGE(PG8_SB(0, 0), b2, voffB); PG8_STAGE(PG8_SB(0, 1), b2 + hstepB, voffB); PG8_STAGE(PG8_SA(0, 0), a2, voffA);
            PG8_WAIT_V(8); PG8_WAIT_L(0); PG8_BAR; PG8_MMA(1, 0, At, B0); PG8_MMA(1, 1, At, B1); PG8_BAR; PG8_SCHED;
            PG8_LDB(B0, 1, 0); PG8_LDB(B1, 1, 1); PG8_SCHED; PG8_LDA(At, 1, 0); PG8_STAGE(PG8_SA(0, 1), a2 + hstepA, voffA);
            PG8_WAIT_V(8); PG8_WAIT_L(0); PG8_BAR; PG8_MMA(0, 0, At, B0); PG8_MMA(0, 1, At, B1); PG8_BAR; PG8_SCHED;
            PG8_LDA(At, 1, 1); PG8_STAGE(PG8_SB(1, 0), b3, voffB); PG8_STAGE(PG8_SB(1, 1), b3 + hstepB, voffB); PG8_STAGE(PG8_SA(1, 0), a3, voffA);
            PG8_WAIT_V(8); PG8_WAIT_L(0); PG8_BAR; PG8_MMA(1, 0, At, B0); PG8_MMA(1, 1, At, B1); PG8_BAR; PG8_SCHED;
        }
        if (wr == 0) PG8_BAR;
        E(acc, cur, wr, wc, fr, fq);
        if (!has_next) break;
#pragma unroll
        for (int a = 0; a < 2; ++a)
#pragma unroll
            for (int b = 0; b < 2; ++b)
#pragma unroll
                for (int m = 0; m < 4; ++m)
#pragma unroll
                    for (int n = 0; n < 2; ++n) acc[a][b][m][n] = (f32x4){0.f, 0.f, 0.f, 0.f};
        cur = nxt; cA = nA; cB = nB; ++ui;
        if (wr == 1) PG8_BAR;
    }
    PG8_WAIT_V(0);
    PG8_BAR;
#undef PG8_SA
#undef PG8_SB
#undef PG8_STAGE
#undef PG8_LDA
#undef PG8_LDB
#undef PG8_MMA
#undef PG8_WAIT_V
#undef PG8_WAIT_L
#undef PG8_BAR
#undef PG8_SCHED
}
}
using pg8::Unit;

#define XB_TMO      128
#define XB_XCNT(j)  (256  + 64 * (j))
#define XB_XSUB(j)  (1280 + 64 * (j))
#define XB_XGEN(j)  (2304 + 64 * (j))
#define XB_TOP      3328
#define XB_TOPGEN   3392
#define XCD_BAR_WORDS 3456
#define XB_SPIN_CAP (1u << 18)

__device__ __forceinline__ unsigned xb_ld(unsigned* p)              { return __hip_atomic_load(p, __ATOMIC_RELAXED, __HIP_MEMORY_SCOPE_AGENT); }
__device__ __forceinline__ unsigned xb_add(unsigned* p, unsigned v) { return __hip_atomic_fetch_add(p, v, __ATOMIC_RELAXED, __HIP_MEMORY_SCOPE_AGENT); }
__device__ __forceinline__ unsigned xb_xcc_id() { return (unsigned)__builtin_amdgcn_s_getreg((3 << 11) | 20) & 0xFu; }
#define XB_SPIN(cond, bar) do { unsigned _sp = 0; while (cond) { __builtin_amdgcn_s_sleep(1); \
    if ((++_sp & 255u) == 0u) { if (xb_ld(&(bar)[XB_TMO])) break; if (_sp > XB_SPIN_CAP) { atomicAdd(&(bar)[XB_TMO], 1u); break; } } } } while (0)

struct XcdBarrier {
    unsigned* bar; unsigned x;
    volatile LAS unsigned* st;
};

__device__ __forceinline__ XcdBarrier xcd_barrier_post(unsigned* bar, volatile LAS unsigned* st) {
    XcdBarrier b; b.bar = bar; b.x = xb_xcc_id(); b.st = st;
    if (threadIdx.x == 0) (void)xb_add(&bar[XB_XCNT(b.x)], 1u);
    return b;
}
__device__ __forceinline__ void xcd_barrier_complete(unsigned* bar, unsigned x, unsigned& nloc, unsigned& nx) {
    const unsigned G = gridDim.x * gridDim.y * gridDim.z;
    unsigned sum, cnt, mine, sp = 0u;
    for (;;) {
        sum = 0u; cnt = 0u; mine = 0u;
#pragma unroll
        for (unsigned j = 0; j < 16; ++j) { const unsigned c = xb_ld(&bar[XB_XCNT(j)]); sum += c; cnt += (c > 0u) ? 1u : 0u; mine = (j == x) ? c : mine; }
        if (sum == G) break;
        __builtin_amdgcn_s_sleep(1);
        if ((++sp & 255u) == 0u) { if (xb_ld(&bar[XB_TMO])) break; if (sp > XB_SPIN_CAP) { atomicAdd(&bar[XB_TMO], 1u); break; } }
    }
    nloc = mine > 0u ? mine : 1u; nx = cnt > 0u ? cnt : 1u;
}

__device__ __forceinline__ void xcd_barrier(const XcdBarrier& b) {
    asm volatile("s_waitcnt vmcnt(0)" ::: "memory");
    __syncthreads();
    if (threadIdx.x == 0) {
        unsigned* bar = b.bar;
        __builtin_amdgcn_s_waitcnt(0);
        unsigned nloc = b.st[0], nx = b.st[1];
        if (nloc == 0u) { xcd_barrier_complete(bar, b.x, nloc, nx); b.st[0] = nloc; b.st[1] = nx; }
        const unsigned old = xb_add(&bar[XB_XSUB(b.x)], 1u);
        const unsigned gen = old / nloc;
        if (old + 1u == (gen + 1u) * nloc) {
            __builtin_amdgcn_fence(__ATOMIC_RELEASE, "agent");
            asm volatile("s_waitcnt vmcnt(0)" ::: "memory");
            const unsigned og = xb_add(&bar[XB_TOP], 1u);
            const unsigned tg = og / nx;
            if (og + 1u == (tg + 1u) * nx) xb_add(&bar[XB_TOPGEN], 1u);
            else XB_SPIN(xb_ld(&bar[XB_TOPGEN]) == tg, bar);
            __builtin_amdgcn_fence(__ATOMIC_ACQUIRE, "agent");
            xb_add(&bar[XB_XGEN(b.x)], 1u);
            asm volatile("s_waitcnt vmcnt(0)" ::: "memory");
        } else {
            XB_SPIN(xb_ld(&bar[XB_XGEN(b.x)]) == gen, bar);
            __builtin_amdgcn_fence(__ATOMIC_ACQUIRE, "agent");
            asm volatile("s_waitcnt vmcnt(0)" ::: "memory");
        }
    }
    __syncthreads();
}


DI int mod_row(int pm) { return pm < 32 ? 0 : 1 + ((pm - 32) >> 3); }

constexpr int XBP = 2048;
struct EpiRes {
    const float* inA; const float* inB; bf16_t* XB; const float* gate;
    float* P; int accum;
    DI void operator()(const f32x4 (&acc)[2][2][4][2], const Unit& u, int wr, int wc, int fr, int fq) const {
        const int col0 = u.pn * 256 + wc * 64 + 4 * fq;
        const float* gp = gate + mod_row(u.pm) * MODW + col0;
        f32x4 gv[2][2];
#pragma unroll
        for (int bj = 0; bj < 2; ++bj)
#pragma unroll
            for (int n = 0; n < 2; ++n) gv[bj][n] = *(const f32x4*)(gp + 32 * bj + 16 * n);
        const int row0 = u.pm * 256 + wr * 64 + fr;
        const float* xin = inA ? ((u.pm < 32) ? inA + (size_t)row0 * DM : inB + (size_t)(row0 - NPR) * DM) : nullptr;
#pragma unroll
        for (int ai = 0; ai < 2; ++ai)
#pragma unroll
            for (int m = 0; m < 4; ++m) {
                const size_t ro = (size_t)(ai * 128 + m * 16) * DM + col0;
                bf16_t* xp = XB + (size_t)(row0 + ai * 128 + m * 16) * XBP + col0;
#pragma unroll
                for (int bj = 0; bj < 2; ++bj)
#pragma unroll
                    for (int n = 0; n < 2; ++n) {
                        if (u.mode == 0) {
                            f32x4 x;
                            if (xin) x = *(const f32x4*)(xin + ro + 32 * bj + 16 * n);
                            else { const u32x2 w = *(const u32x2*)(xp + 32 * bj + 16 * n); x = (f32x4){bflo(w.x), bfhi(w.x), bflo(w.y), bfhi(w.y)}; }
                            x = x + gv[bj][n] * acc[ai][bj][m][n];
                            u32x2 o; o.x = pk2(x.x, x.y); o.y = pk2(x.z, x.w);
                            *(u32x2*)(xp + 32 * bj + 16 * n) = o;
                        } else {
                            f32x4* pp = (f32x4*)(P + (size_t)(row0 - 16384) * DM + ro + 32 * bj + 16 * n);
                            f32x4 v = gv[bj][n] * acc[ai][bj][m][n];
                            if (accum) v = v + *pp;
                            *pp = v;
                        }
                    }
            }
    }
};

template <int ACT> struct EpiBf16 {
    bf16_t* O; int ldc;
    DI void operator()(const f32x4 (&acc)[2][2][4][2], const Unit& u, int wr, int wc, int fr, int fq) const {
        const int col0 = u.pn * 256 + wc * 64 + 4 * fq;
        const int row0 = u.pm * 256 + wr * 64 + fr;
#pragma unroll
        for (int ai = 0; ai < 2; ++ai)
#pragma unroll
            for (int m = 0; m < 4; ++m) {
                bf16_t* op = O + (size_t)(row0 + ai * 128 + m * 16) * ldc + col0;
#pragma unroll
                for (int bj = 0; bj < 2; ++bj)
#pragma unroll
                    for (int n = 0; n < 2; ++n) {
                        f32x4 v = acc[ai][bj][m][n];
                        if (ACT == 1) { v.x = fmaxf(v.x, 0.f); v.y = fmaxf(v.y, 0.f); v.z = fmaxf(v.z, 0.f); v.w = fmaxf(v.w, 0.f); v = v * v; }
                        u32x2 w; w.x = pk2(v.x, v.y); w.y = pk2(v.z, v.w);
                        *(u32x2*)(op + 32 * bj + 16 * n) = w;
                    }
            }
    }
};

struct EpiQKV1 {
    bf16_t* QKV; float* AB; bf16_t* ZL; int zp;
    DI void operator()(const f32x4 (&acc)[2][2][4][2], const Unit& u, int wr, int wc, int fr, int fq) const {
        const int row0 = u.pm * 256 + wr * 64 + fr;
        if (u.pn < 12) {
            const int col0 = u.pn * 256 + wc * 64 + 4 * fq;
#pragma unroll
            for (int ai = 0; ai < 2; ++ai)
#pragma unroll
                for (int m = 0; m < 4; ++m) {
                    bf16_t* op = QKV + (size_t)(row0 + ai * 128 + m * 16) * 3072 + col0;
#pragma unroll
                    for (int bj = 0; bj < 2; ++bj)
#pragma unroll
                        for (int n = 0; n < 2; ++n) {
                            const f32x4 v = acc[ai][bj][m][n];
                            u32x2 w; w.x = pk2(v.x, v.y); w.y = pk2(v.z, v.w);
                            *(u32x2*)(op + 32 * bj + 16 * n) = w;
                        }
                }
        } else if (u.pn > 12) {
            const int col0 = (u.pn - 13) * 256 + wc * 64 + 4 * fq;
#pragma unroll
            for (int ai = 0; ai < 2; ++ai)
#pragma unroll
                for (int m = 0; m < 4; ++m) {
                    bf16_t* op = ZL + (size_t)(row0 + ai * 128 + m * 16) * zp + col0;
#pragma unroll
                    for (int bj = 0; bj < 2; ++bj)
#pragma unroll
                        for (int n = 0; n < 2; ++n) {
                            const f32x4 v = acc[ai][bj][m][n];
                            u32x2 w; w.x = pk2(v.x, v.y); w.y = pk2(v.z, v.w);
                            *(u32x2*)(op + 32 * bj + 16 * n) = w;
                        }
                }
        } else if (wc == 0) {
#pragma unroll
            for (int ai = 0; ai < 2; ++ai)
#pragma unroll
                for (int m = 0; m < 4; ++m) {
                    float* op = AB + (size_t)(row0 + ai * 128 + m * 16) * 32 + 4 * fq;
#pragma unroll
                    for (int n = 0; n < 2; ++n) *(f32x4*)(op + 16 * n) = acc[ai][0][m][n];
                }
        }
    }
};

struct EpiQKV0 {
    bf16_t *Q, *KS, *VTS, *KP, *VTP; float *newk, *newv;
    const float *qna, *kna, *qnb, *knb;
    DI void operator()(const f32x4 (&acc)[2][2][4][2], const Unit& u, int wr, int wc, int fr, int fq) const {
        asm volatile("" : "+v"(fr), "+v"(fq));
        const int pn = u.pn; const bool prompt = u.pm < 32;
        int type, head; const float* gain = qna; bool rope = false;
        if (pn < 2) { type = 0; head = 4 * pn + wc; gain = qna; rope = true; }
        else if (pn == 2) { if (wc < 2) { type = 1; head = wc; gain = kna; rope = true; } else { type = 2; head = wc - 2; } }
        else if (pn < 5) { type = 0; head = 8 + 4 * (pn - 3) + wc; gain = qnb; }
        else if (pn < 7) { type = 1; head = 2 + 4 * (pn - 5) + wc; gain = knb; }
        else { type = 2; head = 2 + 4 * (pn - 7) + wc; }
        rope = rope && !prompt;
        float invf[4];
#pragma unroll
        for (int j = 0; j < 4; ++j) invf[j] = __builtin_amdgcn_exp2f(-(float)(4 * fq + j) * 0.83048202372184059f);
        const int row0 = u.pm * 256 + wr * 64 + fr;
#pragma unroll
        for (int ai = 0; ai < 2; ++ai)
#pragma unroll
            for (int m = 0; m < 4; ++m) {
                const int mg = row0 + ai * 128 + m * 16;
                f32x4 v[2][2];
#pragma unroll
                for (int bj = 0; bj < 2; ++bj)
#pragma unroll
                    for (int n = 0; n < 2; ++n) v[bj][n] = acc[ai][bj][m][n];
                if (type != 2) {
                    float ss = 0.f;
#pragma unroll
                    for (int bj = 0; bj < 2; ++bj)
#pragma unroll
                        for (int n = 0; n < 2; ++n) { const f32x4 x = v[bj][n]; ss += (x.x * x.x + x.y * x.y) + (x.z * x.z + x.w * x.w); }
                    ss += __shfl_xor(ss, 16); ss += __shfl_xor(ss, 32);
                    const float rinv = __builtin_amdgcn_rsqf(ss * (1.0f / 64.0f) + 1e-6f);
#pragma unroll
                    for (int bj = 0; bj < 2; ++bj)
#pragma unroll
                        for (int n = 0; n < 2; ++n) v[bj][n] = v[bj][n] * rinv * *(const f32x4*)(gain + 32 * bj + 16 * n + 4 * fq);
                    if (rope) {
                        const int t = (mg - NPR) & 2047;
                        const float pos[2] = {(float)(t >> 6), (float)(t & 63)};
#pragma unroll
                        for (int bj = 0; bj < 2; ++bj)
#pragma unroll
                            for (int j = 0; j < 4; ++j) {
                                const float ang = pos[bj] * invf[j];
                                const float cs = __cosf(ang), sn = __sinf(ang);
                                const float x1 = v[bj][0][j], x2 = v[bj][1][j];
                                v[bj][0][j] = x1 * cs - x2 * sn; v[bj][1][j] = x2 * cs + x1 * sn;
                            }
                    }
                }
                int b, t, ntile; bf16_t* kbase; bf16_t* vbase;
                if (prompt) { b = mg >> 8; t = mg & 255; ntile = 8; kbase = KP; vbase = VTP; }
                else { b = (mg - NPR) >> 11; t = (mg - NPR) & 2047; ntile = 72; kbase = KS; vbase = VTS; }
                const size_t tbase = ((size_t)(b * 10 + head) * ntile + (t >> 5)) * 2048; const int kk = t & 31;
#pragma unroll
                for (int bj = 0; bj < 2; ++bj)
#pragma unroll
                    for (int n = 0; n < 2; ++n) {
                        const int d0 = 32 * bj + 16 * n + 4 * fq;
                        const f32x4 x = v[bj][n];
                        if (type == 0) { u32x2 w; w.x = pk2(x.x, x.y); w.y = pk2(x.z, x.w); *(u32x2*)(Q + (size_t)mg * 1024 + head * 64 + d0) = w; }
                        else if (type == 1) {
                            u32x2 w; w.x = pk2(x.x, x.y); w.y = pk2(x.z, x.w); *(u32x2*)(kbase + tbase + ((d0 >> 3) * 32 + kk) * 8 + (d0 & 7)) = w;
                            if (prompt) *(f32x4*)(newk + (size_t)mg * 640 + head * 64 + d0) = x;
                        } else {
                            bf16_t* vp = vbase + tbase + ((((((d0 >> 5) * 2 + (kk >> 4)) * 2 + ((kk >> 3) & 1)) * 2 + ((kk >> 2) & 1)) * 32 + (d0 & 31)) << 2) + (kk & 3);
                            const unsigned w0 = pk2(x.x, x.y), w1 = pk2(x.z, x.w);
                            vp[0] = (bf16_t)(w0 & 0xffffu); vp[4] = (bf16_t)(w0 >> 16); vp[8] = (bf16_t)(w1 & 0xffffu); vp[12] = (bf16_t)(w1 >> 16);
                            if (prompt) *(f32x4*)(newv + (size_t)mg * 640 + head * 64 + d0) = x;
                        }
                    }
                asm volatile("" ::: "memory");
            }
    }
};

DI float wave_sum(float v) {
#pragma unroll
    for (int o = 1; o < 64; o <<= 1) v += __shfl_xor(v, o);
    return v;
}
DI int perm_row32(int n0) { return (n0 & ~255) + 128 * ((n0 >> 5) & 1) + 32 * ((n0 >> 6) & 3); }

DI void transpose_item(const float* W, int N, int k0, int n0, bf16_t* WT, int ldt, int row0, LAS float* scr, int lane) {
#pragma unroll 8
    for (int i = 0; i < 32; ++i) { const int kk = 2 * i + (lane >> 5); scr[kk * 33 + (lane & 31)] = W[(size_t)(k0 + kk) * N + n0 + (lane & 31)]; }
    asm volatile("s_waitcnt lgkmcnt(0)" ::: "memory");
    const int c = lane & 7;
#pragma unroll
    for (int j = 0; j < 4; ++j) { const int n = (lane >> 3) + 8 * j; const LAS float* s = scr + (8 * c) * 33 + n;
        u32x4 o; o.x = pk2(s[0 * 33], s[1 * 33]); o.y = pk2(s[2 * 33], s[3 * 33]); o.z = pk2(s[4 * 33], s[5 * 33]); o.w = pk2(s[6 * 33], s[7 * 33]);
        *(u32x4*)(WT + (size_t)(row0 + n) * ldt + k0 + 8 * c) = o; }
    asm volatile("s_waitcnt lgkmcnt(0)" ::: "memory");
}
DI void transpose_matrix(const float* W, int K, int N, bf16_t* WT, LAS float* scr, int gw, int NGW, int lane) {
    const int nblk = N / 32, nitems = (K / 64) * nblk;
    for (int it = gw; it < nitems; it += NGW) { const int kb = it / nblk, nb = it % nblk; transpose_item(W, N, kb * 64, nb * 32, WT, K, perm_row32(nb * 32), scr, lane); }
}

DI void norm_phase(const float* xa, const float* xb, bf16_t* XB, const float* gain, const float* sh, const float* sc, bf16_t* H, int hp, int gw, int NGW, int lane, const float* P = nullptr) {
    for (int m0 = gw; m0 < NTOK; m0 += 2 * NGW) {
        const int m1 = m0 + NGW; const bool has1 = m1 < NTOK; const int m1c = has1 ? m1 : m0;
        f32x4 v0[4], v1[4];
        if (XB) {
#pragma unroll
            for (int j = 0; j < 4; ++j) {
                const u32x2 w0 = *(const u32x2*)(XB + (size_t)m0 * XBP + 4 * lane + 256 * j), w1 = *(const u32x2*)(XB + (size_t)m1c * XBP + 4 * lane + 256 * j);
                v0[j] = (f32x4){bflo(w0.x), bfhi(w0.x), bflo(w0.y), bfhi(w0.y)}; v1[j] = (f32x4){bflo(w1.x), bfhi(w1.x), bflo(w1.y), bfhi(w1.y)};
            }
        } else {
            const float* xr0 = (m0 < NPR) ? xa + (size_t)m0 * DM : xb + (size_t)(m0 - NPR) * DM;
            const float* xr1 = (m1c < NPR) ? xa + (size_t)m1c * DM : xb + (size_t)(m1c - NPR) * DM;
#pragma unroll
            for (int j = 0; j < 4; ++j) { v0[j] = *(const f32x4*)(xr0 + 4 * lane + 256 * j); v1[j] = *(const f32x4*)(xr1 + 4 * lane + 256 * j); }
        }
        if (P) {
#pragma unroll
            for (int j = 0; j < 4; ++j) {
                if (m0 >= 16384) { v0[j] = v0[j] + *(const f32x4*)(P + (size_t)(m0 - 16384) * DM + 4 * lane + 256 * j);
                    u32x2 o; o.x = pk2(v0[j].x, v0[j].y); o.y = pk2(v0[j].z, v0[j].w); *(u32x2*)(XB + (size_t)m0 * XBP + 4 * lane + 256 * j) = o; }
                if (has1 && m1 >= 16384) { v1[j] = v1[j] + *(const f32x4*)(P + (size_t)(m1 - 16384) * DM + 4 * lane + 256 * j);
                    u32x2 o; o.x = pk2(v1[j].x, v1[j].y); o.y = pk2(v1[j].z, v1[j].w); *(u32x2*)(XB + (size_t)m1 * XBP + 4 * lane + 256 * j) = o; }
            }
        }
        float s0 = 0.f, s1 = 0.f;
#pragma unroll
        for (int j = 0; j < 4; ++j) { s0 += (v0[j].x * v0[j].x + v0[j].y * v0[j].y) + (v0[j].z * v0[j].z + v0[j].w * v0[j].w); s1 += (v1[j].x * v1[j].x + v1[j].y * v1[j].y) + (v1[j].z * v1[j].z + v1[j].w * v1[j].w); }
        const float r0 = __builtin_amdgcn_rsqf(wave_sum(s0) * (1.0f / DM) + 1e-6f), r1 = __builtin_amdgcn_rsqf(wave_sum(s1) * (1.0f / DM) + 1e-6f);
        const int mr0 = (m0 < NPR) ? 0 : 1 + ((m0 - NPR) >> 11), mr1 = (m1c < NPR) ? 0 : 1 + ((m1c - NPR) >> 11);
#pragma unroll
        for (int j = 0; j < 4; ++j) {
            const int c = 4 * lane + 256 * j;
            const f32x4 g = *(const f32x4*)(gain + c);
            { const f32x4 a = *(const f32x4*)(sc + mr0 * MODW + c), b = *(const f32x4*)(sh + mr0 * MODW + c);
              const f32x4 o = v0[j] * r0 * g * (a + 1.0f) + b; u32x2 w; w.x = pk2(o.x, o.y); w.y = pk2(o.z, o.w); *(u32x2*)(H + (size_t)m0 * hp + c) = w; }
            if (has1) { const f32x4 a = *(const f32x4*)(sc + mr1 * MODW + c), b = *(const f32x4*)(sh + mr1 * MODW + c);
              const f32x4 o = v1[j] * r1 * g * (a + 1.0f) + b; u32x2 w; w.x = pk2(o.x, o.y); w.y = pk2(o.z, o.w); *(u32x2*)(H + (size_t)m1 * hp + c) = w; }
        }
    }
}

#define MFMA32(a, b, c) __builtin_amdgcn_mfma_f32_32x32x16_bf16((a), (b), (c), 0, 0, 0)
template <int NH, bool NA>
DI void attn_unit(const bf16_t* Qrow, const bf16_t* Kp, const bf16_t* VTp, int vstride,
                  int seg0_start, int seg0_tiles, int seg1_start, int seg1_tiles,
                  const LAS float* biasH, int qr, int c0, float shift, bf16_t* Orow, int lane) {
    const int r = lane & 31, hh = lane >> 5;
    bf16x8 Qf[NH][4];
#pragma unroll
    for (int h = 0; h < NH; ++h)
#pragma unroll
        for (int s = 0; s < 4; ++s) Qf[h][s] = *(const bf16x8*)(Qrow + (size_t)r * 1024 + 64 * h + 16 * s + 8 * hh);
    f32x16 O[NH][2]; float mrun[NH], lrun[NH];
#pragma unroll
    for (int h = 0; h < NH; ++h) { mrun[h] = -1e30f; lrun[h] = 0.f;
#pragma unroll
        for (int b = 0; b < 2; ++b)
#pragma unroll
            for (int i = 0; i < 16; ++i) O[h][b][i] = 0.f; }
    const float SC = 0.125f * 1.4426950408889634f;
    const int ntiles = seg0_tiles + seg1_tiles;
    bf16x8 Kn[4]; s16x4 Vln[2][2], Vhn[2][2];
    {
        const int k0 = seg0_tiles > 0 ? seg0_start : seg1_start;
        const bf16_t* kt = Kp + (size_t)(k0 >> 5) * 2048; const bf16_t* vt = VTp + (size_t)(k0 >> 5) * 2048;
#pragma unroll
        for (int s = 0; s < 4; ++s) Kn[s] = *(const bf16x8*)(kt + (s * 64 + lane) * 8);
#pragma unroll
        for (int b = 0; b < 2; ++b)
#pragma unroll
            for (int s = 0; s < 2; ++s) { Vln[b][s] = *(const s16x4*)(vt + (((b * 2 + s) * 2 + 0) * 64 + lane) * 4); Vhn[b][s] = *(const s16x4*)(vt + (((b * 2 + s) * 2 + 1) * 64 + lane) * 4); }
    }
    for (int ti = 0; ti < ntiles; ++ti) {
        const bool loc = ti < seg0_tiles;
        const int k0 = loc ? seg0_start + 32 * ti : seg1_start + 32 * (ti - seg0_tiles);
        bf16x8 Kf[4]; s16x4 Vlo[2][2], Vhi[2][2];
#pragma unroll
        for (int s = 0; s < 4; ++s) Kf[s] = Kn[s];
#pragma unroll
        for (int b = 0; b < 2; ++b)
#pragma unroll
            for (int s = 0; s < 2; ++s) { Vlo[b][s] = Vln[b][s]; Vhi[b][s] = Vhn[b][s]; }
        {
            const int tn = min(ti + 1, ntiles - 1);
            const int k1 = (tn < seg0_tiles) ? seg0_start + 32 * tn : seg1_start + 32 * (tn - seg0_tiles);
            const bf16_t* kt = Kp + (size_t)(k1 >> 5) * 2048; const bf16_t* vt = VTp + (size_t)(k1 >> 5) * 2048;
#pragma unroll
            for (int s = 0; s < 4; ++s) Kn[s] = *(const bf16x8*)(kt + (s * 64 + lane) * 8);
#pragma unroll
            for (int b = 0; b < 2; ++b)
#pragma unroll
                for (int s = 0; s < 2; ++s) { Vln[b][s] = *(const s16x4*)(vt + (((b * 2 + s) * 2 + 0) * 64 + lane) * 4); Vhn[b][s] = *(const s16x4*)(vt + (((b * 2 + s) * 2 + 1) * 64 + lane) * 4); }
        }
#pragma unroll
        for (int h = 0; h < NH; ++h) {
            f32x16 st;
#pragma unroll
            for (int i = 0; i < 16; ++i) st[i] = 0.f;
#pragma unroll
            for (int s = 0; s < 4; ++s) st = MFMA32(Kf[s], Qf[h][s], st);
            float ps = 0.f;
            if (NA && loc) {
                const int c = c0 + r, cs = min(max(c - 8, 0), 48);
                const int d0 = (k0 & 63) + 4 * hh - cs;
                const int b0 = ((k0 >> 6) - qr + 7) * 31 + (cs - c + 15);
#pragma unroll
                for (int i = 0; i < 16; ++i) {
                    const int d = d0 + (i & 3) + 8 * (i >> 2);
                    const bool valid = (unsigned)d < 16u;
                    const float bv = biasH[valid ? b0 + d : 0];
                    const float x = valid ? st[i] * SC - shift + bv * 1.4426950408889634f : -1e30f;
                    const float p = __builtin_amdgcn_exp2f(x); st[i] = p; ps += p;
                }
            } else {
#pragma unroll
                for (int i = 0; i < 16; ++i) { const float p = __builtin_amdgcn_exp2f(st[i] * SC - shift); st[i] = p; ps += p; }
            }
            lrun[h] += ps;
#pragma unroll
            for (int s = 0; s < 2; ++s) {
                u32x4 pw; pw.x = pk2(st[8 * s + 0], st[8 * s + 1]); pw.y = pk2(st[8 * s + 2], st[8 * s + 3]); pw.z = pk2(st[8 * s + 4], st[8 * s + 5]); pw.w = pk2(st[8 * s + 6], st[8 * s + 7]);
                const bf16x8 Pf = __builtin_bit_cast(bf16x8, pw);
#pragma unroll
                for (int b = 0; b < 2; ++b) {
                    const bf16x8 Vf = __builtin_shufflevector(Vlo[b][s], Vhi[b][s], 0, 1, 2, 3, 4, 5, 6, 7);
                    O[h][b] = MFMA32(Vf, Pf, O[h][b]);
                }
            }
        }
    }
#pragma unroll
    for (int h = 0; h < NH; ++h) {
        const float lt = lrun[h] + __shfl_xor(lrun[h], 32);
        const float inv = 1.0f / lt;
#pragma unroll
        for (int b = 0; b < 2; ++b)
#pragma unroll
            for (int g = 0; g < 4; ++g) {
                u32x2 w; w.x = pk2(O[h][b][4 * g] * inv, O[h][b][4 * g + 1] * inv); w.y = pk2(O[h][b][4 * g + 2] * inv, O[h][b][4 * g + 3] * inv);
                *(u32x2*)(Orow + (size_t)r * 1024 + 64 * h + 32 * b + 8 * g + 4 * hh) = w;
            }
    }
}

DI float wave_max(float v) {
#pragma unroll
    for (int o = 1; o < 64; o <<= 1) v = fmaxf(v, __shfl_xor(v, o));
    return v;
}
DI void attention_phase(const bf16_t* Q, const bf16_t* KS, const bf16_t* VTS, const bf16_t* KP, const bf16_t* VTP, const LAS float* rel_bias, const float* qna, const float* kna, const float* qnb, const float* knb,
                        bf16_t* AO, int gw, int NGW, int lane) {
    const float L2E = 1.4426950408889634f;
    const float shiftA = 8.0f * wave_max(fabsf(qna[lane])) * wave_max(fabsf(kna[lane])) * L2E;
    const float boundB = 8.0f * wave_max(fabsf(qnb[lane])) * wave_max(fabsf(knb[lane]));
    float bm = 0.f;
    for (int i = lane; i < 3720; i += 64) bm = fmaxf(bm, fabsf(rel_bias[i]));
    const float shiftB = boundB * L2E, shiftN = (boundB + wave_max(bm)) * L2E;
    for (int U = gw; U < 9216; U += NGW) {
        if (U < 2048) {
            const int u = U, b = u >> 8, kv = (u >> 7) & 1, gp = (u >> 6) & 1, qt = u & 63;
            const int m0 = NPR + b * 2048 + qt * 32, qc = (kv * 4 + gp * 2) * 64;
            attn_unit<2, false>(Q + (size_t)m0 * 1024 + qc, KS + (size_t)(b * 10 + kv) * 72 * 2048, VTS + (size_t)(b * 10 + kv) * 72 * 2048, 2304, 0, 72, 0, 0, nullptr, 0, 0, shiftA, AO + (size_t)m0 * 1024 + qc, lane);
        } else if (U < 6144) {
            const int u = U - 2048, b = u >> 9, h = (u >> 6) & 7, qt = u & 63, qr = qt >> 1, c0 = (qt & 1) * 32;
            const int m0 = NPR + b * 2048 + qt * 32, qc = 512 + h * 64;
            const int rs = min(max(qr - 4, 0), 24);
            attn_unit<1, true>(Q + (size_t)m0 * 1024 + qc, KS + (size_t)(b * 10 + 2 + h) * 72 * 2048, VTS + (size_t)(b * 10 + 2 + h) * 72 * 2048, 2304, rs * 64, 16, 2048, 8, rel_bias + h * 465, qr, c0, shiftN, AO + (size_t)m0 * 1024 + qc, lane);
        } else if (U < 7168) {
            const int u = U - 6144, b = u >> 5, kv = (u >> 4) & 1, gp = (u >> 3) & 1, qt = u & 7;
            const int m0 = b * 256 + qt * 32, qc = (kv * 4 + gp * 2) * 64;
            attn_unit<2, false>(Q + (size_t)m0 * 1024 + qc, KP + (size_t)(b * 10 + kv) * 8 * 2048, VTP + (size_t)(b * 10 + kv) * 8 * 2048, 256, 0, 8, 0, 0, nullptr, 0, 0, shiftA, AO + (size_t)m0 * 1024 + qc, lane);
        } else {
            const int u = U - 7168, b = u >> 6, h = (u >> 3) & 7, qt = u & 7;
            const int m0 = b * 256 + qt * 32, qc = 512 + h * 64;
            attn_unit<1, false>(Q + (size_t)m0 * 1024 + qc, KP + (size_t)(b * 10 + 2 + h) * 8 * 2048, VTP + (size_t)(b * 10 + 2 + h) * 8 * 2048, 256, 0, 8, 0, 0, nullptr, 0, 0, shiftB, AO + (size_t)m0 * 1024 + qc, lane);
        }
    }
}

DI float quad_sum(float x) {
    x += __builtin_bit_cast(float, __builtin_amdgcn_mov_dpp(__builtin_bit_cast(int, x), 0xB1, 0xF, 0xF, true));
    x += __builtin_bit_cast(float, __builtin_amdgcn_mov_dpp(__builtin_bit_cast(int, x), 0x4E, 0xF, 0xF, true));
    return x;
}
DI void delta_unit(LAS unsigned char* lds, const bf16_t* QKV, const float* AB, const float* conv_w, float Aexp, float dtb,
                   int m0, int T, int h, int dir, const float* s0  , float* sfin  , bf16_t* OUT) {
    const int tid = opq(threadIdx.x), wid = tid >> 6, lane = tid & 63, kq = lane & 3, vl = lane >> 2, v = 16 * wid + vl;
    LAS float* sQ = (LAS float*)lds; LAS float* sK = sQ + 32 * 128; LAS float* sV = sK + 32 * 128; LAS float* sA = sV + 32 * 128; LAS float* sB = sA + 32;
    float S[32];
#pragma unroll
    for (int i = 0; i < 32; ++i) S[i] = s0 ? s0[(size_t)(kq * 32 + i) * 128 + v] : 0.f;
    const int nblk = T / 32;
    for (int blk = 0; blk < nblk; ++blk) {
        const int t0 = (dir ? nblk - 1 - blk : blk) * 32;
        {
            const int tl = tid >> 4, cg = tid & 15, t = t0 + tl;
#pragma unroll
            for (int part = 0; part < 3; ++part) {
                const int col = part * 1024 + h * 128 + cg * 8;
                const bf16_t* base = QKV + (size_t)(m0 + t) * 3072 + col;
                u32x4 xm = {0u, 0u, 0u, 0u}, xp = {0u, 0u, 0u, 0u};
                const u32x4 x0 = *(const u32x4*)base;
                if (t > 0) xm = *(const u32x4*)(base - 3072);
                if (t < T - 1) xp = *(const u32x4*)(base + 3072);
                float o[8];
#pragma unroll
                for (int e = 0; e < 4; ++e) {
                    const f32x2 w0 = *(const f32x2*)(conv_w + col + 2 * e), w1 = *(const f32x2*)(conv_w + 3072 + col + 2 * e), w2 = *(const f32x2*)(conv_w + 6144 + col + 2 * e);
                    const float a0 = w0.x * bflo(xm[e]) + w1.x * bflo(x0[e]) + w2.x * bflo(xp[e]);
                    const float a1 = w0.y * bfhi(xm[e]) + w1.y * bfhi(x0[e]) + w2.y * bfhi(xp[e]);
                    o[2 * e] = siluf_(a0); o[2 * e + 1] = siluf_(a1);
                }
                LAS float* dst = (part == 0 ? sQ : (part == 1 ? sK : sV)) + tl * 128 + cg * 8;
                *(LAS f32x4*)dst = (f32x4){o[0], o[1], o[2], o[3]}; *(LAS f32x4*)(dst + 4) = (f32x4){o[4], o[5], o[6], o[7]};
            }
        }
        __syncthreads();
        {
            const int row = tid >> 3, sub = tid & 7;
            LAS float* p = (row < 32 ? sQ + row * 128 : sK + (row - 32) * 128) + sub * 16;
            f32x4 x[4]; float ss = 0.f;
#pragma unroll
            for (int i = 0; i < 4; ++i) { x[i] = *(LAS f32x4*)(p + 4 * i); ss += (x[i].x * x[i].x + x[i].y * x[i].y) + (x[i].z * x[i].z + x[i].w * x[i].w); }
            ss += __shfl_xor(ss, 1); ss += __shfl_xor(ss, 2); ss += __shfl_xor(ss, 4);
            const float sc = __builtin_amdgcn_rsqf(ss + 1e-6f) * (row < 32 ? 0.08838834764831845f : 1.0f);
#pragma unroll
            for (int i = 0; i < 4; ++i) *(LAS f32x4*)(p + 4 * i) = x[i] * sc;
            if (tid < 32) {
                const float* ab = AB + (size_t)(m0 + t0 + tid) * 32 + dir * 8 + h;
                const float xa = ab[0] + dtb, xb = ab[16];
                const float sp = xa > 20.f ? xa : log1pf(__expf(xa));
                sA[tid] = __expf(-Aexp * sp); sB[tid] = sigmoidf_(xb);
            }
        }
        __syncthreads();
        for (int i = 0; i < 32; ++i) {
            const int tl = dir ? 31 - i : i;
            const LAS float* kp = sK + tl * 128 + kq * 32; const LAS float* qp = sQ + tl * 128 + kq * 32;
            const float a = sA[tl], b = sB[tl], vt = sV[tl * 128 + v];
            f32x4 kk[8];
#pragma unroll
            for (int j = 0; j < 8; ++j) kk[j] = *(const LAS f32x4*)(kp + 4 * j);
            float ks = 0.f;
#pragma unroll
            for (int j = 0; j < 8; ++j) ks += (kk[j].x * S[4 * j] + kk[j].y * S[4 * j + 1]) + (kk[j].z * S[4 * j + 2] + kk[j].w * S[4 * j + 3]);
            ks = quad_sum(ks);
            const float d = b * (vt - a * ks);
            f32x4 qq[8];
#pragma unroll
            for (int j = 0; j < 8; ++j) qq[j] = *(const LAS f32x4*)(qp + 4 * j);
            float os = 0.f;
#pragma unroll
            for (int j = 0; j < 8; ++j) {
                S[4 * j] = a * S[4 * j] + kk[j].x * d; S[4 * j + 1] = a * S[4 * j + 1] + kk[j].y * d; S[4 * j + 2] = a * S[4 * j + 2] + kk[j].z * d; S[4 * j + 3] = a * S[4 * j + 3] + kk[j].w * d;
                os += (qq[j].x * S[4 * j] + qq[j].y * S[4 * j + 1]) + (qq[j].z * S[4 * j + 2] + qq[j].w * S[4 * j + 3]);
            }
            os = quad_sum(os);
            if (kq == 0) OUT[(size_t)(m0 + t0 + tl) * 1024 + h * 128 + v] = (bf16_t)(pk2(os, 0.f) & 0xffffu);
        }
        __syncthreads();
    }
    if (sfin) {
#pragma unroll
        for (int i = 0; i < 32; ++i) sfin[(size_t)(kq * 32 + i) * 128 + v] = S[i];
    }
}


constexpr int DP128 = 136, DP64 = 72;
constexpr int DL_QN = 0, DL_KN = 17408, DL_KNT = 34816, DL_VT = 53248, DL_ST = 71680, DL_ATT = 106496, DL_TM = 115712, DL_RT = 124928, DL_GATE = 143360;
constexpr int DL_AL1 = DL_KNT, DL_AL2 = DL_KNT + 9216, DL_TDT = DL_VT, DL_P1T = DL_VT + 9216, DL_T1 = DL_ST, DL_T1T = DL_ST + 9216, DL_AD = DL_ST + 18432;
constexpr int DL_VNT = DL_QN, DL_VNST = DL_VT, DL_CW = DL_GATE + 2048;
static_assert(DL_CW + 4608 <= LDS_BYTES, "delta LDS map");

DI int crow_(int i, int hh) { return (i & 3) + 8 * (i >> 2) + 4 * hh; }
DI bf16x8 ldfrag(const LAS bf16_t* base, int row, int pitch, int koff) { return *(const LAS bf16x8*)(base + row * pitch + koff); }
DI void store_tileT(LAS bf16_t* XT, int pitch, int col, int row0, int hh, const f32x16& a, float sc) {
#pragma unroll
    for (int g = 0; g < 4; ++g) { u32x2 w; w.x = pk2(a[4 * g] * sc, a[4 * g + 1] * sc); w.y = pk2(a[4 * g + 2] * sc, a[4 * g + 3] * sc);
        *(LAS u32x2*)(XT + col * pitch + row0 + 8 * g + 4 * hh) = w; }
}
DI void store_tileR(LAS bf16_t* X, int pitch, int col, int row0, int hh, const f32x16& a) {
#pragma unroll
    for (int i = 0; i < 16; ++i) X[(row0 + crow_(i, hh)) * pitch + col] = (bf16_t)(pk2(a[i], 0.f) & 0xffffu);
}
DI f32x16 mm64_tile(const LAS bf16_t* A, const LAS bf16_t* BT, int ib, int jb, int r, int hh, f32x16 acc) {
#pragma unroll
    for (int s = 0; s < 4; ++s) acc = MFMA32(ldfrag(A, 32 * ib + r, DP64, 16 * s + 8 * hh), ldfrag(BT, 32 * jb + r, DP64, 16 * s + 8 * hh), acc);
    return acc;
}

#ifdef PROBE_D1
#define REP_D1 _Pragma("unroll 1") for (int rep_ = 0; rep_ < 2; ++rep_)
#else
#define REP_D1
#endif
#ifdef PROBE_D3
#define REP_D3 _Pragma("unroll 1") for (int rep_ = 0; rep_ < 2; ++rep_)
#else
#define REP_D3
#endif
#ifdef PROBE_D6
#define REP_D6 _Pragma("unroll 1") for (int rep_ = 0; rep_ < 2; ++rep_)
#else
#define REP_D6
#endif
DI void delta_unit_chunked(LAS unsigned char* lds, const bf16_t* QKV, const float* AB, const float* conv_w, float Aexp, float dtb,
                           int m0, int T, int h, int dir, const float* s0, float* sfin, bf16_t* OUT) {
    const int tid0 = opq(threadIdx.x), w0 = __builtin_amdgcn_readfirstlane(tid0 >> 6);
    LAS bf16_t* QN = (LAS bf16_t*)(lds + DL_QN); LAS bf16_t* KN = (LAS bf16_t*)(lds + DL_KN); LAS bf16_t* KNT = (LAS bf16_t*)(lds + DL_KNT); LAS bf16_t* VT = (LAS bf16_t*)(lds + DL_VT);
    LAS bf16_t* ST = (LAS bf16_t*)(lds + DL_ST); LAS bf16_t* ATT = (LAS bf16_t*)(lds + DL_ATT); LAS bf16_t* TM = (LAS bf16_t*)(lds + DL_TM); LAS bf16_t* RT = (LAS bf16_t*)(lds + DL_RT);
    LAS float* GT = (LAS float*)(lds + DL_GATE);
    LAS bf16_t* AL1 = (LAS bf16_t*)(lds + DL_AL1); LAS bf16_t* AL2 = (LAS bf16_t*)(lds + DL_AL2); LAS bf16_t* TDT = (LAS bf16_t*)(lds + DL_TDT); LAS bf16_t* P1T = (LAS bf16_t*)(lds + DL_P1T);
    LAS bf16_t* T1 = (LAS bf16_t*)(lds + DL_T1); LAS bf16_t* T1T = (LAS bf16_t*)(lds + DL_T1T); LAS float* AD = (LAS float*)(lds + DL_AD);
    LAS bf16_t* VNT = (LAS bf16_t*)(lds + DL_VNT); LAS bf16_t* VNST = (LAS bf16_t*)(lds + DL_VNST);
    f32x16 Sacc[2];
    {
        const int lane = tid0 & 63, r = lane & 31, hh = lane >> 5, kb = w0 >> 1, vb0 = 2 * (w0 & 1);
#pragma unroll
        for (int e = 0; e < 2; ++e)
#pragma unroll
            for (int i = 0; i < 16; ++i) Sacc[e][i] = s0 ? s0[(size_t)(32 * kb + crow_(i, hh)) * 128 + 32 * (vb0 + e) + r] : 0.f;
    }
    LAS float* CW = (LAS float*)(lds + DL_CW);
    for (int i = tid0; i < 3 * 384; i += 512) { const int tap = i / 384, pc = i % 384; CW[i] = conv_w[tap * 3072 + (pc >> 7) * 1024 + h * 128 + (pc & 127)]; }
    __syncthreads();
    const int nch = T / 64;
    u32x4 xraw[3][4];
#define DELTA_LOAD_RAW(T0) do { const int tlo_ = (T0) + 2 * (tid0 >> 4), cg_ = tid0 & 15; \
        _Pragma("unroll") for (int part = 0; part < 3; ++part) _Pragma("unroll") for (int k = 0; k < 4; ++k) { \
            const int tt = tlo_ - 1 + k; const bool ok = (tt >= 0) && (tt < T); const int tc = min(max(tt, 0), T - 1); \
            u32x4 v_ = *(const u32x4*)(QKV + (size_t)(m0 + tc) * 3072 + part * 1024 + h * 128 + cg_ * 8); \
            if (!ok) v_ = (u32x4){0u, 0u, 0u, 0u}; xraw[part][k] = v_; } } while (0)
#ifdef DELTA_PREFETCH
    DELTA_LOAD_RAW((dir ? nch - 1 : 0) * 64);
#endif
#pragma unroll 1
    for (int ci = 0; ci < nch; ++ci) {
        const int tid = opq(threadIdx.x), w = __builtin_amdgcn_readfirstlane(tid >> 6), lane = tid & 63, r = lane & 31, hh = lane >> 5;
        const int kb = w >> 1, vb0 = 2 * (w & 1);
        const int t0 = (dir ? nch - 1 - ci : ci) * 64;
        u32x4 kpk[2], vpk[2];
        const int tlo = t0 + 2 * (tid >> 4);
#ifndef DELTA_PREFETCH
        DELTA_LOAD_RAW(t0);
#endif
        REP_D1 {
        {
            const int cg = tid & 15;
#pragma unroll
            for (int pass = 0; pass < 2; ++pass) {
                const int t = tlo + pass, i = dir ? t0 + 63 - t : t - t0;
                u32x4 pk[3];
#pragma unroll
                for (int part = 0; part < 3; ++part) {
                    const u32x4 xm = xraw[part][pass], x0 = xraw[part][pass + 1], xp = xraw[part][pass + 2];
                    float o[8]; float ss = 0.f;
#pragma unroll
                    for (int e = 0; e < 4; ++e) {
                        const f32x2 w0 = *(const LAS f32x2*)(CW + part * 128 + cg * 8 + 2 * e), w1 = *(const LAS f32x2*)(CW + 384 + part * 128 + cg * 8 + 2 * e), w2 = *(const LAS f32x2*)(CW + 768 + part * 128 + cg * 8 + 2 * e);
                        const float a0 = w0.x * bflo(xm[e]) + w1.x * bflo(x0[e]) + w2.x * bflo(xp[e]);
                        const float a1 = w0.y * bfhi(xm[e]) + w1.y * bfhi(x0[e]) + w2.y * bfhi(xp[e]);
                        o[2 * e] = siluf_(a0); o[2 * e + 1] = siluf_(a1);
                        ss += o[2 * e] * o[2 * e] + o[2 * e + 1] * o[2 * e + 1];
                    }
                    float sc = 1.0f;
                    if (part < 2) {
                        ss += __shfl_xor(ss, 1); ss += __shfl_xor(ss, 2); ss += __shfl_xor(ss, 4); ss += __shfl_xor(ss, 8);
                        sc = __builtin_amdgcn_rsqf(ss + 1e-6f) * (part == 0 ? 0.08838834764831845f : 1.0f);
                    }
                    pk[part].x = pk2(o[0] * sc, o[1] * sc); pk[part].y = pk2(o[2] * sc, o[3] * sc); pk[part].z = pk2(o[4] * sc, o[5] * sc); pk[part].w = pk2(o[6] * sc, o[7] * sc);
                }
                *(LAS u32x4*)(QN + i * DP128 + cg * 8) = pk[0];
                *(LAS u32x4*)(KN + i * DP128 + cg * 8) = pk[1];
                kpk[pass] = pk[1]; vpk[pass] = pk[2];
            }
        }
#ifdef DELTA_PREFETCH
        if (ci + 1 < nch) DELTA_LOAD_RAW((dir ? nch - 2 - ci : ci + 1) * 64);
#endif
        if (w == 0) {
            const int t = dir ? t0 + 63 - lane : t0 + lane;
            const float* ab = AB + (size_t)(m0 + t) * 32 + dir * 8 + h;
            const float xa = ab[0] + dtb, xb = ab[16];
            const float sp = xa > 20.f ? xa : log1pf(__expf(xa));
            float g = -Aexp * sp;
#pragma unroll
            for (int off = 1; off < 64; off <<= 1) { const float tmp = __shfl_up(g, off); if (lane >= off) g += tmp; }
            const float gl = __shfl(g, 63);
            GT[lane] = g; GT[64 + lane] = sigmoidf_(xb); GT[128 + lane] = __expf(g); GT[192 + lane] = __expf(gl - g);
            if (lane == 0) GT[256] = __expf(gl);
        }
        for (int i = tid; i < 64 * DP64 / 2; i += 512) { ((LAS unsigned*)TM)[i] = 0u; ((LAS unsigned*)TDT)[i] = 0u; }
        __syncthreads();
        }
        REP_D3 {
        {
            const int mat = w >> 2, ib = (w >> 1) & 1, jb = w & 1;
            f32x16 acc;
#pragma unroll
            for (int i = 0; i < 16; ++i) acc[i] = 0.f;
            if (ib >= jb) {
                const LAS bf16_t* X = mat ? QN : KN;
#pragma unroll
                for (int s = 0; s < 8; ++s) acc = MFMA32(ldfrag(X, 32 * ib + r, DP128, 16 * s + 8 * hh), ldfrag(KN, 32 * jb + r, DP128, 16 * s + 8 * hh), acc);
            }
            const int col = 32 * jb + r; const float gc = GT[col];
#pragma unroll
            for (int i = 0; i < 16; ++i) {
                const int row = 32 * ib + crow_(i, hh);
                const float dg = (row >= col) ? __expf(GT[row] - gc) : 0.f;
                if (mat == 0) {
                    const float a = (row > col) ? GT[64 + row] * acc[i] * dg : 0.f;
                    const bool same16 = (row >> 4) == (col >> 4), same32 = (row >> 5) == (col >> 5);
                    if (same16) AD[((row >> 4) * 16 + (row & 15)) * 20 + (col & 15)] = a;
                    AL1[row * DP64 + col] = (bf16_t)(pk2((same32 && !same16) ? a : 0.f, 0.f) & 0xffffu);
                    AL2[row * DP64 + col] = (bf16_t)(pk2(!same32 ? a : 0.f, 0.f) & 0xffffu);
                } else {
                    ATT[row * DP64 + col] = (bf16_t)(pk2((row >= col) ? acc[i] * dg : 0.f, 0.f) & 0xffffu);
                }
            }
        }
        __syncthreads();
        if (w == 0) {
            const int b = lane >> 4, c = lane & 15;
            const LAS float* ad = AD + b * 16 * 20;
            float X[16];
#pragma unroll
            for (int i = 0; i < 16; ++i) {
                float x = (i == c) ? 1.f : 0.f;
#pragma unroll
                for (int j4 = 0; j4 < (i + 3) / 4; ++j4) {
                    const f32x4 a = *(const LAS f32x4*)(ad + i * 20 + 4 * j4);
                    if (4 * j4 + 0 < i) x -= a.x * X[4 * j4 + 0];
                    if (4 * j4 + 1 < i) x -= a.y * X[4 * j4 + 1];
                    if (4 * j4 + 2 < i) x -= a.z * X[4 * j4 + 2];
                    if (4 * j4 + 3 < i) x -= a.w * X[4 * j4 + 3];
                }
                X[i] = x;
            }
#pragma unroll
            for (int i = 0; i < 16; ++i) TM[(16 * b + i) * DP64 + 16 * b + c] = (bf16_t)(pk2(X[i], 0.f) & 0xffffu);
#pragma unroll
            for (int g = 0; g < 4; ++g) { u32x2 wv; wv.x = pk2(X[4 * g], X[4 * g + 1]); wv.y = pk2(X[4 * g + 2], X[4 * g + 3]);
                *(LAS u32x2*)(TDT + (16 * b + c) * DP64 + 16 * b + 4 * g) = wv; }
        }
        __syncthreads();
        }
        const int ib5 = (w >> 1) & 1, jb5 = w & 1;
        f32x16 zero16;
#pragma unroll
        for (int i = 0; i < 16; ++i) zero16[i] = 0.f;
        if (w < 4) { const f32x16 p1 = mm64_tile(AL1, TDT, ib5, jb5, r, hh, zero16); store_tileT(P1T, DP64, 32 * jb5 + r, 32 * ib5, hh, p1, -1.0f); }
        __syncthreads();
        if (w < 4) {
            f32x16 c0;
#pragma unroll
            for (int i = 0; i < 16; ++i) c0[i] = bf2f(TM[(32 * ib5 + crow_(i, hh)) * DP64 + 32 * jb5 + r]);
            const f32x16 t1 = mm64_tile(TM, P1T, ib5, jb5, r, hh, c0);
            store_tileR(T1, DP64, 32 * jb5 + r, 32 * ib5, hh, t1); store_tileT(T1T, DP64, 32 * jb5 + r, 32 * ib5, hh, t1, 1.0f);
        }
        __syncthreads();
        if (w < 4) { const f32x16 p3 = mm64_tile(AL2, T1T, ib5, jb5, r, hh, zero16); store_tileT(P1T, DP64, 32 * jb5 + r, 32 * ib5, hh, p3, -1.0f); }
        __syncthreads();
        if (w < 4) {
            f32x16 c0;
#pragma unroll
            for (int i = 0; i < 16; ++i) c0[i] = bf2f(T1[(32 * ib5 + crow_(i, hh)) * DP64 + 32 * jb5 + r]);
            const f32x16 tt = mm64_tile(T1, P1T, ib5, jb5, r, hh, c0);
            store_tileR(TM, DP64, 32 * jb5 + r, 32 * ib5, hh, tt);
        }
        __syncthreads();
        const int cb = w >> 2, vb = w & 3;
        f32x16 O0;
        REP_D6 {
        {
            const int cg = tid & 15;
#pragma unroll
            for (int pass = 0; pass < 2; ++pass) {
                const int t = tlo + pass, i = dir ? t0 + 63 - t : t - t0;
#pragma unroll
                for (int e = 0; e < 4; ++e) {
                    const int ci_ = (((i >> 3) ^ (cg & 7)) << 3) + (i & 7);
                    KNT[(cg * 8 + 2 * e) * DP64 + ci_] = (bf16_t)(kpk[pass][e] & 0xffffu); KNT[(cg * 8 + 2 * e + 1) * DP64 + ci_] = (bf16_t)(kpk[pass][e] >> 16);
                    VT[(cg * 8 + 2 * e) * DP64 + ci_] = (bf16_t)(vpk[pass][e] & 0xffffu); VT[(cg * 8 + 2 * e + 1) * DP64 + ci_] = (bf16_t)(vpk[pass][e] >> 16);
                }
            }
#pragma unroll
            for (int e = 0; e < 2; ++e) store_tileT(ST, DP128, 32 * (vb0 + e) + r, 32 * kb, hh, Sacc[e], 1.0f);
        }
        __syncthreads();
        {
            f32x16 ks = zero16, qs = zero16;
#pragma unroll
            for (int s = 0; s < 8; ++s) {
                const bf16x8 sf = ldfrag(ST, 32 * vb + r, DP128, 16 * s + 8 * hh);
                ks = MFMA32(ldfrag(KN, 32 * cb + r, DP128, 16 * s + 8 * hh), sf, ks);
                qs = MFMA32(ldfrag(QN, 32 * cb + r, DP128, 16 * s + 8 * hh), sf, qs);
            }
            f32x16 rr;
#pragma unroll
            for (int g = 0; g < 4; ++g) {
                const u32x2 vv = *(const LAS u32x2*)(VT + (32 * vb + r) * DP64 + (((4 * cb + g) ^ ((r >> 3) & 3) ^ ((vb & 1) << 2)) << 3) + 4 * hh);
                const float v4[4] = {bflo(vv.x), bfhi(vv.x), bflo(vv.y), bfhi(vv.y)};
#pragma unroll
                for (int j = 0; j < 4; ++j) {
                    const int c = 32 * cb + 8 * g + 4 * hh + j; const float eg = GT[128 + c];
                    rr[4 * g + j] = GT[64 + c] * (v4[j] - eg * ks[4 * g + j]);
                    O0[4 * g + j] = eg * qs[4 * g + j];
                }
            }
            store_tileT(RT, DP64, 32 * vb + r, 32 * cb, hh, rr, 1.0f);
        }
        __syncthreads();
        }
        {
            const f32x16 vn = mm64_tile(TM, RT, cb, vb, r, hh, zero16);
            f32x16 vs;
#pragma unroll
            for (int i = 0; i < 16; ++i) vs[i] = vn[i] * GT[192 + 32 * cb + crow_(i, hh)];
            store_tileT(VNT, DP64, 32 * vb + r, 32 * cb, hh, vn, 1.0f);
            store_tileT(VNST, DP64, 32 * vb + r, 32 * cb, hh, vs, 1.0f);
        }
        __syncthreads();
        {
            const f32x16 o = mm64_tile(ATT, VNT, cb, vb, r, hh, O0);
#pragma unroll
            for (int i = 0; i < 16; ++i) {
                const int c = 32 * cb + crow_(i, hh), t = dir ? t0 + 63 - c : t0 + c;
                OUT[(size_t)(m0 + t) * 1024 + h * 128 + 32 * vb + r] = (bf16_t)(pk2(o[i], 0.f) & 0xffffu);
            }
            const float egl = GT[256];
#pragma unroll
            for (int e = 0; e < 2; ++e) {
                f32x16 a = Sacc[e] * egl;
#pragma unroll
                for (int s2 = 0; s2 < 4; ++s2) {
                    const int row = 32 * kb + r, blk = (2 * s2 + hh) ^ ((row >> 3) & 7);
                    a = MFMA32(ldfrag(KNT, row, DP64, 8 * blk), ldfrag(VNST, 32 * (vb0 + e) + r, DP64, 16 * s2 + 8 * hh), a);
                }
                Sacc[e] = a;
            }
        }
        __syncthreads();
    }
    if (sfin) {
        const int lane = tid0 & 63, r = lane & 31, hh = lane >> 5, kb = w0 >> 1, vb0 = 2 * (w0 & 1);
#pragma unroll
        for (int e = 0; e < 2; ++e)
#pragma unroll
            for (int i = 0; i < 16; ++i) sfin[(size_t)(32 * kb + crow_(i, hh)) * 128 + 32 * (vb0 + e) + r] = Sacc[e][i];
    }
}
DI void delta_dispatch(LAS unsigned char* lds, int U, const bf16_t* QKV, const float* AB, const float* conv_w, const float* a_log, const float* dt_bias,
                       const float* state, float* news, bf16_t* OF, bf16_t* OB) {
    int b, h, dir, m0, T; const float* s0 = nullptr; float* sf = nullptr;
    if (U < 128) { b = U >> 4; h = (U >> 1) & 7; dir = U & 1; m0 = NPR + b * 2048; T = 2048; s0 = state + (size_t)((b * 2 + dir) * 8 + h) * 16384; }
    else { const int u = U - 128; b = u >> 4; h = (u >> 1) & 7; dir = u & 1; m0 = b * 256; T = 256; sf = news + (size_t)((b * 2 + dir) * 8 + h) * 16384; }
    const float Aexp = __expf(a_log[dir * 8 + h]), dtb = dt_bias[dir * 8 + h];
#ifdef DELTA_SEQ
    delta_unit(lds, QKV, AB, conv_w, Aexp, dtb, m0, T, h, dir, s0, sf, dir ? OB : OF);
#else
    delta_unit_chunked(lds, QKV, AB, conv_w, Aexp, dtb, m0, T, h, dir, s0, sf, dir ? OB : OF);
#endif
}

DI void y_phase(bf16_t* OF, const bf16_t* OB, const bf16_t* Z, int zp, const float* out_norm, int gw, int NGW, int lane) {
    for (int m = gw; m < NTOK; m += NGW) {
        const size_t off = (size_t)m * 1024 + 16 * lane;
        const u32x4 f0 = *(const u32x4*)(OF + off), f1 = *(const u32x4*)(OF + off + 8);
        const u32x4 b0 = *(const u32x4*)(OB + off), b1 = *(const u32x4*)(OB + off + 8);
        const size_t zoff = (size_t)m * zp + 16 * lane;
        const u32x4 z0 = *(const u32x4*)(Z + zoff), z1 = *(const u32x4*)(Z + zoff + 8);
        float o[16], z[16]; float ss = 0.f;
#pragma unroll
        for (int e = 0; e < 4; ++e) {
            o[2 * e] = bflo(f0[e]) + bflo(b0[e]); o[2 * e + 1] = bfhi(f0[e]) + bfhi(b0[e]);
            o[8 + 2 * e] = bflo(f1[e]) + bflo(b1[e]); o[8 + 2 * e + 1] = bfhi(f1[e]) + bfhi(b1[e]);
            z[2 * e] = bflo(z0[e]); z[2 * e + 1] = bfhi(z0[e]); z[8 + 2 * e] = bflo(z1[e]); z[8 + 2 * e + 1] = bfhi(z1[e]);
        }
#pragma unroll
        for (int e = 0; e < 16; ++e) ss += o[e] * o[e];
        ss += __shfl_xor(ss, 1); ss += __shfl_xor(ss, 2); ss += __shfl_xor(ss, 4);
        const float rstd = __builtin_amdgcn_rsqf(ss * (1.0f / 128.0f) + 1e-6f);
        const float* gn = out_norm + ((16 * lane) & 127);
        float y[16];
#pragma unroll
        for (int e = 0; e < 16; ++e) y[e] = o[e] * rstd * gn[e] * siluf_(z[e]);
        u32x4 w0, w1;
        w0.x = pk2(y[0], y[1]); w0.y = pk2(y[2], y[3]); w0.z = pk2(y[4], y[5]); w0.w = pk2(y[6], y[7]);
        w1.x = pk2(y[8], y[9]); w1.y = pk2(y[10], y[11]); w1.z = pk2(y[12], y[13]); w1.w = pk2(y[14], y[15]);
        *(u32x4*)(OF + off) = w0; *(u32x4*)(OF + off + 8) = w1;
    }
}

__global__ void __launch_bounds__(512, 2) fwd_megakernel(Params p) {
    extern __shared__ __attribute__((aligned(16))) unsigned char lds_raw[];
    LAS unsigned char* lds = (LAS unsigned char*)lds_raw;
    cg::grid_group grid = cg::this_grid();
    const int G = gridDim.x, bid = blockIdx.x, NGW = G * 8;
#define IDS() const int tid = opq(threadIdx.x), lane = tid & 63, wave = __builtin_amdgcn_readfirstlane(tid >> 6), gw = bid * 8 + wave; (void)gw; (void)lane; (void)tid
    unsigned char* ws = p.ws;
    float* mod = (float*)(ws + WS_MOD);
    float* Y = p.out + OUT_Y;
    bf16_t* XB = (bf16_t*)(p.out + OUT_Y) + 1024;
    bf16_t* WQKV1 = (bf16_t*)(ws + WS_WQKV1); bf16_t* WZ1 = (bf16_t*)(ws + WS_WZ1); bf16_t* WOUT1 = (bf16_t*)(ws + WS_WOUT1);
    bf16_t* WIN0 = (bf16_t*)(ws + B_WIN0); bf16_t* WOUT0 = (bf16_t*)(ws + B_WOUT0); bf16_t* W1_0 = (bf16_t*)(ws + B_W1_0); bf16_t* W2_0 = (bf16_t*)(ws + B_W2_0);
    bf16_t* H0 = (bf16_t*)(ws + B_H0); bf16_t* Qb = (bf16_t*)(ws + B_Q); bf16_t* KS = (bf16_t*)(ws + B_KS); bf16_t* VTS = (bf16_t*)(ws + B_VTS);
    bf16_t* KP = (bf16_t*)(ws + B_KP); bf16_t* VTP = (bf16_t*)(ws + B_VTP); bf16_t* FF0 = (bf16_t*)(ws + B_FF0);
    bf16_t* QKV1 = (bf16_t*)(ws + B_QKV1); float* AB = (float*)(ws + B_AB); bf16_t* OF = (bf16_t*)(ws + B_OF); bf16_t* OB = (bf16_t*)(ws + B_OB);
    bf16_t* H1 = (bf16_t*)(ws + B_H1); bf16_t* W1_1 = (bf16_t*)(ws + B_W1_1); bf16_t* W2_1 = (bf16_t*)(ws + B_W2_1); bf16_t* H1B = (bf16_t*)(ws + B_H1B);
    bf16_t* Zb = (bf16_t*)(ws + B_Z); bf16_t* FF1 = (bf16_t*)(ws + B_FF1);
    float* Pside = (float*)(ws + B_PS);
    bf16_t* HL = (bf16_t*)(p.out + OUT_Y);
    bf16_t* FFL0 = (bf16_t*)(ws + B_FFL0); bf16_t* FFL1 = (bf16_t*)(ws + B_FFL1);

    unsigned* barw = (unsigned*)(ws + 524288);
    volatile LAS unsigned* bar_st = (volatile LAS unsigned*)(lds + LDS_BYTES - 512);
    if (threadIdx.x < 2) bar_st[threadIdx.x] = 0u;
    if (p.ws == nullptr) grid.sync();
    __syncthreads();
    const XcdBarrier xbar = xcd_barrier_post(barw, bar_st);
#define GSYNC() xcd_barrier(xbar)
#define W2_GEMM(FFb, W2b, modl) do { \
        pg8::Gemm g{FFb, W2b, 4096, 4096, NTOK, 1024, 4096}; \
        EpiRes E{nullptr, nullptr, XB, modl + 5120, Pside, 0}; \
        if (G == 256) { pg8::W2Order S; S.c = bid; S.ntf = 64; pg8::gemm_phase(lds, g, S, E); } \
        else { pg8::StaticOrder S; S.init(NTOK, 1024, G, bid); pg8::gemm_phase(lds, g, S, E); } } while (0)
    {
        IDS();
        LAS float* scr = (LAS float*)(lds + wave * 8704);
        transpose_matrix(p.in[10], 1024, 2304, WIN0, scr, gw, NGW, lane);
        const bool later = (G == 256);
        if (!later) {
        transpose_matrix(p.in[16], 1024, 1024, WOUT0, scr, gw, NGW, lane);
        transpose_matrix(p.in[18], 1024, 4096, W1_0, scr, gw, NGW, lane);
        transpose_matrix(p.in[19], 4096, 1024, W2_0, scr, gw, NGW, lane);
        transpose_matrix(p.in[28], 1024, 1024, WOUT1, scr, gw, NGW, lane);
        }
        if (!later) {
            const float* W = p.in[23]; const int nblk = 129, nitems = 16 * nblk;
            for (int it = gw; it < nitems; it += NGW) { const int kb = it / nblk, nb = it % nblk, n0 = nb * 32;
                if (n0 < 3072) transpose_item(W, 4128, kb * 64, n0, WQKV1, 1024, perm_row32(n0), scr, lane);
                else if (n0 < 4096) transpose_item(W, 4128, kb * 64, n0, WZ1, 1024, perm_row32(n0 - 3072), scr, lane);
                else transpose_item(W, 4128, kb * 64, n0, WQKV1, 1024, 3072, scr, lane); }
            u32x4* zp = (u32x4*)(WQKV1 + (size_t)3104 * 1024); const int nz = 224 * 1024 * 2 / 16;
            for (int i = bid * 512 + tid; i < nz; i += G * 512) zp[i] = (u32x4){0u, 0u, 0u, 0u};
        }
        {
            const float* ck = p.in[3]; const float* cv = p.in[4];
            for (int e = bid * 512 + tid; e < 8 * 256 * 640; e += G * 512) {
                const int b = e / (256 * 640), rem = e % (256 * 640), pp = rem / 640, hd = rem % 640, head = hd >> 6, d = hd & 63, kk = pp & 31;
                const size_t tbase = ((size_t)(b * 10 + head) * 72 + 64 + (pp >> 5)) * 2048;
                KS[tbase + ((d >> 3) * 32 + kk) * 8 + (d & 7)] = (bf16_t)(pk2(ck[e], 0.f) & 0xffffu);
                VTS[tbase + ((((((d >> 5) * 2 + (kk >> 4)) * 2 + ((kk >> 3) & 1)) * 2 + ((kk >> 2) & 1)) * 32 + (d & 31)) << 2) + (kk & 3)] = (bf16_t)(pk2(cv[e], 0.f) & 0xffffu);
            }
        }
        __syncthreads();
        LAS float* sv = (LAS float*)lds;
        LAS float* red = sv + 1024 * 12;
        bool sv_ready = false;
        for (int U = bid; U < 192; U += G) {
            if (!sv_ready) {
                for (int i = tid; i < 9 * 1024; i += 512) { const int r = i >> 10, k = i & 1023; const float x = (r == 0) ? p.in[6][k] : p.in[2][(r - 1) * 1024 + k]; sv[k * 12 + r] = siluf_(x); }
                sv_ready = true; __syncthreads();
            }
            const int l = U / 96, j0 = (U % 96) * 64;
            const float* W = p.in[l ? 20 : 7]; const float* bias = p.in[l ? 21 : 8];
            float a[9];
#pragma unroll
            for (int r = 0; r < 9; ++r) a[r] = 0.f;
            const int kbeg = wave * 128;
#pragma unroll 16
            for (int k = kbeg; k < kbeg + 128; ++k) {
                const float w = W[(size_t)k * MODW + j0 + lane];
                const f32x4 s0 = *(const LAS f32x4*)(sv + k * 12), s1 = *(const LAS f32x4*)(sv + k * 12 + 4); const float s8 = sv[k * 12 + 8];
                a[0] += w * s0.x; a[1] += w * s0.y; a[2] += w * s0.z; a[3] += w * s0.w; a[4] += w * s1.x; a[5] += w * s1.y; a[6] += w * s1.z; a[7] += w * s1.w; a[8] += w * s8;
            }
#pragma unroll
            for (int r = 0; r < 9; ++r) red[(wave * 9 + r) * 64 + lane] = a[r];
            __syncthreads();
            for (int i = tid; i < 576; i += 512) { const int r = i >> 6, c = i & 63; float s = bias[j0 + c];
#pragma unroll
                for (int w = 0; w < 8; ++w) s += red[(w * 9 + r) * 64 + c];
                mod[(size_t)(l * 9 + r) * MODW + j0 + c] = s; }
            __syncthreads();
        }
    }
    GSYNC();

    const float* mod0 = mod; const float* mod1 = mod + 9 * MODW;
    { IDS(); norm_phase(p.in[0], p.in[1], nullptr, p.in[9], mod0 + 0, mod0 + 1024, H0, DM, gw, NGW, lane); }
    GSYNC();
    {
        pg8::Gemm g{H0, WIN0, 1024, 1024, NTOK, 2304, 1024}; pg8::StaticOrder S; S.init(NTOK, 2304, G, bid);
        EpiQKV0 E{Qb, KS, VTS, KP, VTP, p.out + OUT_NEWK, p.out + OUT_NEWV, p.in[11], p.in[12], p.in[13], p.in[14]};
        pg8::gemm_phase(lds, g, S, E);
        if (G == 256 && bid >= 96) {
            IDS();
            LAS float* scr = (LAS float*)(lds + wave * 8704);
            const int gw2 = (bid - 96) * 8 + wave, NGW2 = 160 * 8;
            transpose_matrix(p.in[16], 1024, 1024, WOUT0, scr, gw2, NGW2, lane);
            transpose_matrix(p.in[18], 1024, 4096, W1_0, scr, gw2, NGW2, lane);
            transpose_matrix(p.in[19], 4096, 1024, W2_0, scr, gw2, NGW2, lane);
            transpose_matrix(p.in[28], 1024, 1024, WOUT1, scr, gw2, NGW2, lane);
            const float* W = p.in[23]; const int nblk = 129, nitems = 16 * nblk;
            for (int it = gw2; it < nitems; it += NGW2) { const int kb = it / nblk, nb = it % nblk, n0 = nb * 32;
                if (n0 < 3072) transpose_item(W, 4128, kb * 64, n0, WQKV1, 1024, perm_row32(n0), scr, lane);
                else if (n0 < 4096) transpose_item(W, 4128, kb * 64, n0, WZ1, 1024, perm_row32(n0 - 3072), scr, lane);
                else transpose_item(W, 4128, kb * 64, n0, WQKV1, 1024, 3072, scr, lane); }
            u32x4* zp = (u32x4*)(WQKV1 + (size_t)3104 * 1024); const int nz = 224 * 1024 * 2 / 16;
            for (int i = (bid - 96) * 512 + tid; i < nz; i += 160 * 512) zp[i] = (u32x4){0u, 0u, 0u, 0u};
        }
    }
    GSYNC();
    { IDS();
      LAS float* sbias = (LAS float*)lds;
      for (int i = tid; i < 3720; i += 512) sbias[i] = p.in[15][i];
      __syncthreads();
      attention_phase(Qb, KS, VTS, KP, VTP, sbias, p.in[11], p.in[12], p.in[13], p.in[14], H0, gw, NGW, lane); }
#ifdef PROBE_ATTN
    GSYNC();
    { IDS(); attention_phase(Qb, KS, VTS, KP, VTP, (const LAS float*)lds, p.in[11], p.in[12], p.in[13], p.in[14], H0, gw, NGW, lane); }
#endif
    GSYNC();
    {
        pg8::Gemm g{H0, WOUT0, 1024, 1024, NTOK, 1024, 1024}; pg8::StaticOrder S; S.init(NTOK, 1024, G, bid);
        EpiRes E{p.in[0], p.in[1], XB, mod0 + 2048, nullptr, 0};
        pg8::gemm_phase(lds, g, S, E);
    }
    GSYNC();
    { IDS(); norm_phase(nullptr, nullptr, XB, p.in[17], mod0 + 3072, mod0 + 4096, HL, XBP, gw, NGW, lane); }
    GSYNC();
    {
        pg8::Gemm g{HL, W1_0, XBP, 1024, NTOK, 4096, 1024}; pg8::StaticOrder S; S.init(NTOK, 4096, G, bid);
        EpiBf16<1> E{FFL0, 4096};
        pg8::gemm_phase(lds, g, S, E);
    }
    GSYNC();
    W2_GEMM(FFL0, W2_0, mod0);
    GSYNC();
    { IDS(); norm_phase(nullptr, nullptr, XB, p.in[22], mod1 + 0, mod1 + 1024, H1, DM, gw, NGW, lane, (G == 256) ? Pside : nullptr); }
    GSYNC();
    {
        pg8::Gemm g{H1, WQKV1, 1024, 1024, NTOK, 4352, 1024}; pg8::StaticOrder S; S.init(NTOK, 4352, G, bid);
        EpiQKV1 E{QKV1, AB, HL, XBP};
        pg8::gemm_phase(lds, g, S, E);
    }
    GSYNC();
#ifdef PROBE_DELTA
    for (int rep = 0; rep < 2; ++rep)
#endif
    {
        float* news = p.out + OUT_NEWS;
#ifdef PROBE_DELTA
        if (rep) GSYNC();
#endif
        const bool bal = (G == 256);
        const int nun = bal ? (bid < 128 ? 1 : 4) : (640 - bid + G - 1) / G;
#pragma unroll 1
        for (int i = 0; i < nun; ++i) {
            const int U = bal ? (bid < 128 ? bid : 128 + (bid - 128) * 4 + i) : bid + i * G;
            delta_dispatch(lds, U, QKV1, AB, p.in[24], p.in[25], p.in[26], p.in[5], news, OF, OB);
        }
    }
    GSYNC();
    if (G != 256) {
        IDS();
        LAS float* scr = (LAS float*)(lds + wave * 8704);
        transpose_matrix(p.in[30], 1024, 4096, W1_1, scr, gw, NGW, lane);
        transpose_matrix(p.in[31], 4096, 1024, W2_1, scr, gw, NGW, lane);
    }
    { IDS(); y_phase(OF, OB, HL, XBP, p.in[27], gw, NGW, lane); }
    GSYNC();
    {
        pg8::Gemm g{OF, WOUT1, 1024, 1024, NTOK, 1024, 1024}; pg8::StaticOrder S; S.init(NTOK, 1024, G, bid);
        EpiRes E{nullptr, nullptr, XB, mod1 + 2048, nullptr, 0};
        pg8::gemm_phase(lds, g, S, E);
        if (G == 256 && bid >= 128) {
            IDS();
            LAS float* scr = (LAS float*)(lds + wave * 8704);
            const int gw2 = (bid - 128) * 8 + wave, NGW2 = 128 * 8;
            transpose_matrix(p.in[30], 1024, 4096, W1_1, scr, gw2, NGW2, lane);
            transpose_matrix(p.in[31], 4096, 1024, W2_1, scr, gw2, NGW2, lane);
        }
    }
    GSYNC();
    { IDS(); norm_phase(nullptr, nullptr, XB, p.in[29], mod1 + 3072, mod1 + 4096, HL, XBP, gw, NGW, lane); }
    GSYNC();
    {
        pg8::Gemm g{HL, W1_1, XBP, 1024, NTOK, 4096, 1024}; pg8::StaticOrder S; S.init(NTOK, 4096, G, bid);
        EpiBf16<1> E{FFL1, 4096};
        pg8::gemm_phase(lds, g, S, E);
    }
    GSYNC();
    W2_GEMM(FFL1, W2_1, mod1);
    {
        GSYNC();
        IDS();
        const bool fold = (G == 256);
        for (int m = gw; m < NTOK; m += NGW) {
            const bf16_t* xr = XB + (size_t)m * XBP + 16 * lane;
            const u32x4 w0 = *(const u32x4*)xr, w1 = *(const u32x4*)(xr + 8);
            f32x4 o[4] = {(f32x4){bflo(w0.x), bfhi(w0.x), bflo(w0.y), bfhi(w0.y)}, (f32x4){bflo(w0.z), bfhi(w0.z), bflo(w0.w), bfhi(w0.w)},
                          (f32x4){bflo(w1.x), bfhi(w1.x), bflo(w1.y), bfhi(w1.y)}, (f32x4){bflo(w1.z), bfhi(w1.z), bflo(w1.w), bfhi(w1.w)}};
            if (fold && m >= 16384) {
#pragma unroll
                for (int j = 0; j < 4; ++j) o[j] = o[j] + *(const f32x4*)(Pside + (size_t)(m - 16384) * DM + 16 * lane + 4 * j);
            }
            asm volatile("s_waitcnt vmcnt(0)" ::: "memory");
#pragma unroll
            for (int j = 0; j < 4; ++j) *(f32x4*)(Y + (size_t)m * DM + 16 * lane + 4 * j) = o[j];
        }
    }
}

extern "C" void kernel_launch(void* const* d_in, const int* in_sizes, int n_in, void* d_out, int out_size, void* d_ws, size_t ws_size, hipStream_t stream) {
    static int grid_blocks = 0;
    if (!grid_blocks) {
        if (n_in != 32 || ws_size < WS_NEED) { fprintf(stderr, "kernel_launch: unexpected n_in %d / ws_size %zu (need %zu)\n", n_in, ws_size, (size_t)WS_NEED); grid_blocks = -1; return; }
        int dev = 0, cus = 0, per_cu = 0;
        hipGetDevice(&dev);
        hipDeviceGetAttribute(&cus, hipDeviceAttributeMultiprocessorCount, dev);
        hipFuncSetAttribute((const void*)fwd_megakernel, hipFuncAttributeMaxDynamicSharedMemorySize, LDS_BYTES);
        hipOccupancyMaxActiveBlocksPerMultiprocessor(&per_cu, (const void*)fwd_megakernel, 512, LDS_BYTES);
        if (per_cu < 1) { fprintf(stderr, "kernel_launch: occupancy query returned %d\n", per_cu); per_cu = 1; }
        grid_blocks = cus * per_cu;
    }
    if (grid_blocks < 0) return;
    Params p{};
    for (int i = 0; i < 32; ++i) p.in[i] = (const float*)d_in[i];
    p.out = (float*)d_out; p.ws = (unsigned char*)d_ws;
    if (hipMemsetAsync((char*)d_ws + 524288, 0, XCD_BAR_WORDS * 4, stream) != hipSuccess) { fprintf(stderr, "kernel_launch: memset of barrier words failed\n"); return; }
    void* args[] = {&p};
    hipError_t e = hipLaunchCooperativeKernel((const void*)fwd_megakernel, dim3(grid_blocks), dim3(512), args, LDS_BYTES, stream);
    if (e != hipSuccess) fprintf(stderr, "cooperative launch failed: %s (grid %d)\n", hipGetErrorString(e), grid_blocks);
}
```

```cpp
#include <hip/hip_runtime.h>
#include <hip/hip_cooperative_groups.h>
#include <cstdio>
namespace cg = cooperative_groups;

#define LAS __attribute__((address_space(3)))
#define DI __device__ __forceinline__
typedef unsigned short bf16_t;
typedef short bf16x8 __attribute__((ext_vector_type(8)));
typedef short s16x4 __attribute__((ext_vector_type(4)));
typedef float f32x2 __attribute__((ext_vector_type(2)));
typedef float f32x4 __attribute__((ext_vector_type(4)));
typedef float f32x16 __attribute__((ext_vector_type(16)));
typedef unsigned u32x2 __attribute__((ext_vector_type(2)));
typedef unsigned u32x4 __attribute__((ext_vector_type(4)));
typedef __bf16 nbf16x2 __attribute__((ext_vector_type(2)));

DI unsigned pk2(float a, float b) { f32x2 v = {a, b}; nbf16x2 r = __builtin_convertvector(v, nbf16x2); return __builtin_bit_cast(unsigned, r); }
DI float bf2f(unsigned short h) { return __builtin_bit_cast(float, (unsigned)h << 16); }
DI float bflo(unsigned w) { return __builtin_bit_cast(float, w << 16); }
DI float bfhi(unsigned w) { return __builtin_bit_cast(float, w & 0xffff0000u); }
DI float sigmoidf_(float x) { return __builtin_amdgcn_rcpf(1.0f + __expf(-x)); }
DI float siluf_(float x) { return x * __builtin_amdgcn_rcpf(1.0f + __expf(-x)); }
DI int opq(int x) { asm volatile("" : "+v"(x)); return x; }

constexpr int NTOK = 24576, NPR = 8192, DM = 1024;
constexpr int MODW = 6144;
constexpr size_t OUT_Y = 0, OUT_NEWK = 25165824, OUT_NEWV = OUT_NEWK + 5242880, OUT_NEWS = OUT_NEWV + 5242880;
constexpr size_t WS_MOD = 0;
constexpr size_t WS_WQKV1 = 1048576;
constexpr size_t WS_WZ1 = WS_WQKV1 + 3328ull * 1024 * 2;
constexpr size_t WS_WOUT1 = WS_WZ1 + 1024ull * 1024 * 2;
constexpr size_t WS_BIG = WS_WOUT1 + 1024ull * 1024 * 2;
constexpr size_t B_WIN0 = WS_BIG, B_WOUT0 = B_WIN0 + 2304ull * 1024 * 2, B_W1_0 = B_WOUT0 + 1024ull * 1024 * 2, B_W2_0 = B_W1_0 + 4096ull * 1024 * 2;
constexpr size_t B_H0 = B_W2_0 + 4096ull * 1024 * 2;
constexpr size_t B_Q = B_H0 + (size_t)NTOK * 1024 * 2;
constexpr size_t B_KS = B_Q + (size_t)NTOK * 1024 * 2;
constexpr size_t B_VTS = B_KS + 8ull * 2304 * 640 * 2;
constexpr size_t B_KP = B_VTS + 8ull * 2304 * 640 * 2;
constexpr size_t B_VTP = B_KP + 8192ull * 640 * 2;
constexpr size_t B_FF0 = B_Q;
constexpr size_t B_QKV1 = WS_BIG;
constexpr size_t B_AB = B_QKV1 + (size_t)NTOK * 3072 * 2;
constexpr size_t B_OF = B_AB + (size_t)NTOK * 32 * 4;
constexpr size_t B_OB = B_OF + (size_t)NTOK * 1024 * 2;
constexpr size_t B_H1 = B_OF;
constexpr size_t B_W1_1 = WS_BIG, B_W2_1 = B_W1_1 + 4096ull * 1024 * 2;
constexpr size_t B_H1B = B_W2_1 + 4096ull * 1024 * 2;
constexpr size_t B_Z = B_H1B + (size_t)NTOK * 1024 * 2;
constexpr size_t B_FF1 = B_Z;
constexpr size_t B_FFL0 = B_H0, B_FFL1 = B_H1B;
constexpr size_t B_PS = B_FFL0 + (size_t)NTOK * 4096 * 2;
constexpr size_t B_HALO = B_OB + (size_t)NTOK * 1024 * 2;
constexpr size_t WS_NEED = (B_PS + 8192ull * 1024 * 4 > B_HALO + 384ull * 2 * 3072 * 2) ? B_PS + 8192ull * 1024 * 4 : B_HALO + 384ull * 2 * 3072 * 2;
static_assert(WS_NEED <= 271868064ull, "ws budget (halo)");
static_assert(B_FFL1 + (size_t)NTOK * 4096 * 2 <= B_PS && B_OB + (size_t)NTOK * 1024 * 2 <= WS_NEED, "ws map (mlp)");
static_assert(B_VTP + 8192ull * 640 * 2 <= WS_NEED && B_FF0 + (size_t)NTOK * 2048 * 2 <= WS_NEED && B_FF1 + (size_t)NTOK * 2048 * 2 <= WS_NEED, "ws map");
static_assert(B_Z + (size_t)NTOK * 1024 * 2 <= B_AB, "z inside dead qkv region");
static_assert(WS_NEED <= 271868064ull, "ws budget");

constexpr int LDS_BYTES = 151552;

struct Params { const float* in[32]; float* out; unsigned char* ws; };

namespace pg8 {
constexpr int BM = 256, BK = 64, HALF = 128, HTB = HALF * BK * 2, STAGE_BYTES = 8 * HTB, NXCD = 8, WGM = 8;
DI int lds_byte(int r, int c) { const int st = (r >> 4) * 2 + (c >> 5), rr = r & 15, cc = c & 31, ob = rr * 64 + cc * 2; return st * 1024 + (ob ^ (((ob >> 9) & 1) << 5)); }
DI void stage_rc(int b, int& R, int& C) { const int st = b / 1024, sb = b % 1024, swz = sb ^ (((sb >> 9) & 1) << 5); R = (st >> 1) * 16 + swz / 64; C = (st & 1) * 32 + (swz % 64) / 2; }
struct Unit { int pm, pn, kofs, nt, mode; };
struct Gemm { const bf16_t* A; const bf16_t* Bt; int lda, ldb, M, N, K; };
struct StaticOrder {
    int nM, nN, nwg, G, c;
    DI void init(int M, int N, int G_, int c_) { nM = M / BM; nN = N / BM; nwg = nM * nN; G = G_; c = c_; }
    DI bool next(int i, Unit& u) const {
        const long L = (long)i * G + c; if (L >= nwg) return false;
        int wgid = (int)L; { const int q = nwg / NXCD, r = nwg % NXCD, xcd = wgid % NXCD, off = wgid / NXCD; wgid = (xcd < r ? xcd * (q + 1) : r * (q + 1) + (xcd - r) * q) + off; }
        const int nig = WGM * nN, gid = wgid / nig, fm = gid * WGM, gsz = (nM - fm) < WGM ? (nM - fm) : WGM;
        u.pm = fm + ((wgid % nig) % gsz); u.pn = (wgid % nig) / gsz; u.kofs = 0; u.nt = 0; u.mode = 0; return true;
    }
};

struct W2Order { int c, ntf;
    DI bool next(int i, Unit& u) const {
        const int x = c & 7, j = c >> 3;
        if (i == 0) { u.pm = 8 * x + (j >> 2); u.pn = j & 3; u.kofs = 0; u.nt = ntf; u.mode = 0; return true; }
        if (i == 1) { const int st = j >> 1; u.pm = 64 + 4 * x + (st >> 2); u.pn = st & 3; u.kofs = (j & 1) * (ntf * 32); u.nt = ntf / 2; u.mode = j & 1; return true; }
        return false; } };

template <class Epi, class Sched>
DI void gemm_phase(LAS unsigned char* lds, const Gemm g, const Sched& S, const Epi& E) {
    const int tid = opq(threadIdx.x), wid = __builtin_amdgcn_readfirstlane(tid >> 6), lane = tid & 63, wr = wid >> 2, wc = wid & 3, fr = lane & 15, fq = lane >> 4;
    const int K = g.K;
    unsigned voffA[2], voffB[2];
#pragma unroll
    for (int i = 0; i < 2; ++i) { int R, C; stage_rc(tid * 16 + i * 8192, R, C);
        voffA[i] = (unsigned)(R * g.lda + C) * 2u; voffB[i] = (unsigned)(R * g.ldb + C) * 2u; }
    const size_t kstep = (size_t)(BK * 2);
    const size_t hstepA = (size_t)HALF * g.lda * 2, hstepB = (size_t)HALF * g.ldb * 2;
    const size_t tstepA = 2 * hstepA, tstepB = 2 * hstepB;
    const unsigned ldsw = (unsigned)wid * 1024u;
    const int aoff = lds_byte(wr * 64 + fr, fq * 8), boff = lds_byte(wc * 32 + fr, fq * 8);
#define PG8_SA(b, h) (((b) * 2 + (h)) * HTB)
#define PG8_SB(b, h) ((4 + (b) * 2 + (h)) * HTB)
#define PG8_STAGE(bufoff, gbase, voff) do { _Pragma("unroll") for (int _i = 0; _i < 2; ++_i) \
        __builtin_amdgcn_global_load_lds((const unsigned*)((const char*)(gbase) + (voff)[_i]), (LAS unsigned*)(lds + (bufoff) + ldsw + _i * 8192), 16, 0, 0); } while (0)
#define PG8_LDA(dst, b, h) do { _Pragma("unroll") for (int m = 0; m < 4; ++m) _Pragma("unroll") for (int k = 0; k < 2; ++k) dst[m][k] = *(const LAS bf16x8*)(lds + PG8_SA(b, h) + aoff + m * 2048 + k * 1024); } while (0)
#define PG8_LDB(dst, b, h) do { _Pragma("unroll") for (int n = 0; n < 2; ++n) _Pragma("unroll") for (int k = 0; k < 2; ++k) dst[n][k] = *(const LAS bf16x8*)(lds + PG8_SB(b, h) + boff + n * 2048 + k * 1024); } while (0)
#define PG8_MMA(ai, bj, At, Bt) do { __builtin_amdgcn_s_setprio(1); _Pragma("unroll") for (int m = 0; m < 4; ++m) _Pragma("unroll") for (int n = 0; n < 2; ++n) _Pragma("unroll") for (int k = 0; k < 2; ++k) \
        acc[ai][bj][m][n] = __builtin_amdgcn_mfma_f32_16x16x32_bf16(Bt[n][k], At[m][k], acc[ai][bj][m][n], 0, 0, 0); __builtin_amdgcn_s_setprio(0); } while (0)
#define PG8_WAIT_V(n) asm volatile("s_waitcnt vmcnt(" #n ")" ::: "memory")
#define PG8_WAIT_L(n) asm volatile("s_waitcnt lgkmcnt(" #n ")" ::: "memory")
#define PG8_BAR __builtin_amdgcn_s_barrier()
#define PG8_SCHED __builtin_amdgcn_sched_barrier(0)
    Unit cur, nxt; int ui = 0;
    if (!S.next(0, cur)) return;
    if (cur.nt == 0) cur.nt = K / BK;
    f32x4 acc[2][2][4][2];
#pragma unroll
    for (int a = 0; a < 2; ++a)
#pragma unroll
        for (int b = 0; b < 2; ++b)
#pragma unroll
            for (int m = 0; m < 4; ++m)
#pragma unroll
                for (int n = 0; n < 2; ++n) acc[a][b][m][n] = (f32x4){0.f, 0.f, 0.f, 0.f};
    bf16x8 At[4][2], B0[2][2], B1[2][2];
    const char* cA = (const char*)g.A + (size_t)cur.pm * tstepA + (size_t)cur.kofs * 2; const char* cB = (const char*)g.Bt + (size_t)cur.pn * tstepB + (size_t)cur.kofs * 2;
    PG8_STAGE(PG8_SB(0, 0), cB, voffB); PG8_STAGE(PG8_SB(0, 1), cB + hstepB, voffB); PG8_STAGE(PG8_SA(0, 0), cA, voffA); PG8_STAGE(PG8_SA(0, 1), cA + hstepA, voffA);
    if (wr == 1) PG8_BAR;
    PG8_WAIT_V(2); PG8_BAR;
    PG8_STAGE(PG8_SB(1, 0), cB + kstep, voffB); PG8_STAGE(PG8_SA(1, 0), cA + kstep, voffA); PG8_STAGE(PG8_SB(1, 1), cB + hstepB + kstep, voffB);
    PG8_WAIT_V(6); PG8_BAR;
    for (;;) {
        const bool has_next = S.next(ui + 1, nxt);
        if (has_next && nxt.nt == 0) nxt.nt = K / BK;
        const char* nA = has_next ? (const char*)g.A + (size_t)nxt.pm * tstepA + (size_t)nxt.kofs * 2 : cA; const char* nB = has_next ? (const char*)g.Bt + (size_t)nxt.pn * tstepB + (size_t)nxt.kofs * 2 : cB;
        const int nt = cur.nt;
        for (int t = 0; t < nt; t += 2) {
            const bool last = (t == nt - 2);
            const char* a1 = cA + (size_t)(t + 1) * kstep;
            const char* a2 = last ? nA : cA + (size_t)(t + 2) * kstep; const char* b2 = last ? nB : cB + (size_t)(t + 2) * kstep;
            const char* a3 = a2 + kstep; const char* b3 = b2 + kstep;
            PG8_LDB(B0, 0, 0); PG8_LDB(B1, 0, 1); PG8_SCHED; PG8_LDA(At, 0, 0); PG8_STAGE(PG8_SA(1, 1), a1 + hstepA, voffA);
            PG8_WAIT_V(8); PG8_WAIT_L(0); PG8_BAR; PG8_MMA(0, 0, At, B0); PG8_MMA(0, 1, At, B1); PG8_BAR; PG8_SCHED;
            PG8_LDA(At, 0, 1); PG8_STAGE(PG8_SB(0, 0), b2, voffB); PG8_STAGE(PG8_SB(0, 1), b2 + hstepB, voffB); PG8_STAGE(PG8_SA(0, 0), a2, voffA);
            PG8_WAIT_V(8); PG8_WAIT_L(0); PG8_BAR; PG8_MMA(1, 0, At, B0); PG8_MMA(1, 1, At, B1); PG8_BAR; PG8_SCHED;
            PG8_LDB(B0, 1, 0); PG8_LDB(B1, 1, 1); PG8_SCHED; PG8_LDA(At, 1, 0); PG8_STAGE(PG8_SA(0, 1), a2 + hstepA, voffA);
            PG8_WAIT_V(8); PG8_WAIT_L(0); PG8_BAR; PG8_MMA(0, 0, At, B0); PG8_MMA(0, 1, At, B1); PG8_BAR; PG8_SCHED;
            PG8_LDA(At, 1, 1); PG8_STAGE(PG8_SB(1, 0), b3, voffB); PG8_STAGE(PG8_SB(1, 1), b3 + hstepB, voffB); PG8_STAGE(PG8_SA(1, 0), a3, voffA);
            PG8_WAIT_V(8); PG8_WAIT_L(0); PG8_BAR; PG8_MMA(1, 0, At, B0); PG8_MMA(1, 1, At, B1); PG8_BAR; PG8_SCHED;
        }
        if (wr == 0) PG8_BAR;
        E(acc, cur, wr, wc, fr, fq);
        if (!has_next) break;
#pragma unroll
        for (int a = 0; a < 2; ++a)
#pragma unroll
            for (int b = 0; b < 2; ++b)
#pragma unroll
                for (int m = 0; m < 4; ++m)
#pragma unroll
                    for (int n = 0; n < 2; ++n) acc[a][b][m][n] = (f32x4){0.f, 0.f, 0.f, 0.f};
        cur = nxt; cA = nA; cB = nB; ++ui;
        if (wr == 1) PG8_BAR;
    }
    PG8_WAIT_V(0);
    PG8_BAR;
#undef PG8_SA
#undef PG8_SB
#undef PG8_STAGE
#undef PG8_LDA
#undef PG8_LDB
#undef PG8_MMA
#undef PG8_WAIT_V
#undef PG8_WAIT_L
#undef PG8_BAR
#undef PG8_SCHED
}
}
using pg8::Unit;

#define XB_TMO      128
#define XB_XCNT(j)  (256  + 64 * (j))
#define XB_XSUB(j)  (1280 + 64 * (j))
#define XB_XGEN(j)  (2304 + 64 * (j))
#define XB_TOP      3328
#define XB_TOPGEN   3392
#define XCD_BAR_WORDS 3456
#define XB_SPIN_CAP (1u << 18)

__device__ __forceinline__ unsigned xb_ld(unsigned* p)              { return __hip_atomic_load(p, __ATOMIC_RELAXED, __HIP_MEMORY_SCOPE_AGENT); }
__device__ __forceinline__ unsigned xb_add(unsigned* p, unsigned v) { return __hip_atomic_fetch_add(p, v, __ATOMIC_RELAXED, __HIP_MEMORY_SCOPE_AGENT); }
__device__ __forceinline__ unsigned xb_xcc_id() { return (unsigned)__builtin_amdgcn_s_getreg((3 << 11) | 20) & 0xFu; }
#define XB_SPIN(cond, bar) do { unsigned _sp = 0; while (cond) { __builtin_amdgcn_s_sleep(1); \
    if ((++_sp & 255u) == 0u) { if (xb_ld(&(bar)[XB_TMO])) break; if (_sp > XB_SPIN_CAP) { atomicAdd(&(bar)[XB_TMO], 1u); break; } } } } while (0)

struct XcdBarrier {
    unsigned* bar; unsigned x;
    volatile LAS unsigned* st;
};

__device__ __forceinline__ XcdBarrier xcd_barrier_post(unsigned* bar, volatile LAS unsigned* st) {
    XcdBarrier b; b.bar = bar; b.x = xb_xcc_id(); b.st = st;
    if (threadIdx.x == 0) (void)xb_add(&bar[XB_XCNT(b.x)], 1u);
    return b;
}
__device__ __forceinline__ void xcd_barrier_complete(unsigned* bar, unsigned x, unsigned& nloc, unsigned& nx) {
    const unsigned G = gridDim.x * gridDim.y * gridDim.z;
    unsigned sum, cnt, mine, sp = 0u;
    for (;;) {
        sum = 0u; cnt = 0u; mine = 0u;
#pragma unroll
        for (unsigned j = 0; j < 16; ++j) { const unsigned c = xb_ld(&bar[XB_XCNT(j)]); sum += c; cnt += (c > 0u) ? 1u : 0u; mine = (j == x) ? c : mine; }
        if (sum == G) break;
        __builtin_amdgcn_s_sleep(1);
        if ((++sp & 255u) == 0u) { if (xb_ld(&bar[XB_TMO])) break; if (sp > XB_SPIN_CAP) { atomicAdd(&bar[XB_TMO], 1u); break; } }
    }
    nloc = mine > 0u ? mine : 1u; nx = cnt > 0u ? cnt : 1u;
}

__device__ __forceinline__ void xcd_barrier(const XcdBarrier& b) {
    asm volatile("s_waitcnt vmcnt(0)" ::: "memory");
    __syncthreads();
    if (threadIdx.x == 0) {
        unsigned* bar = b.bar;
        __builtin_amdgcn_s_waitcnt(0);
        unsigned nloc = b.st[0], nx = b.st[1];
        if (nloc == 0u) { xcd_barrier_complete(bar, b.x, nloc, nx); b.st[0] = nloc; b.st[1] = nx; }
        const unsigned old = xb_add(&bar[XB_XSUB(b.x)], 1u);
        const unsigned gen = old / nloc;
        if (old + 1u == (gen + 1u) * nloc) {
            __builtin_amdgcn_fence(__ATOMIC_RELEASE, "agent");
            asm volatile("s_waitcnt vmcnt(0)" ::: "memory");
            const unsigned og = xb_add(&bar[XB_TOP], 1u);
            const unsigned tg = og / nx;
            if (og + 1u == (tg + 1u) * nx) xb_add(&bar[XB_TOPGEN], 1u);
            else XB_SPIN(xb_ld(&bar[XB_TOPGEN]) == tg, bar);
            __builtin_amdgcn_fence(__ATOMIC_ACQUIRE, "agent");
            xb_add(&bar[XB_XGEN(b.x)], 1u);
            asm volatile("s_waitcnt vmcnt(0)" ::: "memory");
        } else {
            XB_SPIN(xb_ld(&bar[XB_XGEN(b.x)]) == gen, bar);
            __builtin_amdgcn_fence(__ATOMIC_ACQUIRE, "agent");
            asm volatile("s_waitcnt vmcnt(0)" ::: "memory");
        }
    }
    __syncthreads();
}


DI int mod_row(int pm) { return pm < 32 ? 0 : 1 + ((pm - 32) >> 3); }

constexpr int XBP = 2048;
struct EpiRes {
    const float* inA; const float* inB; bf16_t* XB; const float* gate;
    float* P; int accum;
    DI void operator()(const f32x4 (&acc)[2][2][4][2], const Unit& u, int wr, int wc, int fr, int fq) const {
        const int col0 = u.pn * 256 + wc * 64 + 4 * fq;
        const float* gp = gate + mod_row(u.pm) * MODW + col0;
        f32x4 gv[2][2];
#pragma unroll
        for (int bj = 0; bj < 2; ++bj)
#pragma unroll
            for (int n = 0; n < 2; ++n) gv[bj][n] = *(const f32x4*)(gp + 32 * bj + 16 * n);
        const int row0 = u.pm * 256 + wr * 64 + fr;
        const float* xin = inA ? ((u.pm < 32) ? inA + (size_t)row0 * DM : inB + (size_t)(row0 - NPR) * DM) : nullptr;
#pragma unroll
        for (int ai = 0; ai < 2; ++ai)
#pragma unroll
            for (int m = 0; m < 4; ++m) {
                const size_t ro = (size_t)(ai * 128 + m * 16) * DM + col0;
                bf16_t* xp = XB + (size_t)(row0 + ai * 128 + m * 16) * XBP + col0;
#pragma unroll
                for (int bj = 0; bj < 2; ++bj)
#pragma unroll
                    for (int n = 0; n < 2; ++n) {
                        if (u.mode == 0) {
                            f32x4 x;
                            if (xin) x = *(const f32x4*)(xin + ro + 32 * bj + 16 * n);
                            else { const u32x2 w = *(const u32x2*)(xp + 32 * bj + 16 * n); x = (f32x4){bflo(w.x), bfhi(w.x), bflo(w.y), bfhi(w.y)}; }
                            x = x + gv[bj][n] * acc[ai][bj][m][n];
                            u32x2 o; o.x = pk2(x.x, x.y); o.y = pk2(x.z, x.w);
                            *(u32x2*)(xp + 32 * bj + 16 * n) = o;
                        } else {
                            f32x4* pp = (f32x4*)(P + (size_t)(row0 - 16384) * DM + ro + 32 * bj + 16 * n);
                            f32x4 v = gv[bj][n] * acc[ai][bj][m][n];
                            if (accum) v = v + *pp;
                            *pp = v;
                        }
                    }
            }
    }
};

template <int ACT> struct EpiBf16 {
    bf16_t* O; int ldc;
    DI void operator()(const f32x4 (&acc)[2][2][4][2], const Unit& u, int wr, int wc, int fr, int fq) const {
        const int col0 = u.pn * 256 + wc * 64 + 4 * fq;
        const int row0 = u.pm * 256 + wr * 64 + fr;
#pragma unroll
        for (int ai = 0; ai < 2; ++ai)
#pragma unroll
            for (int m = 0; m < 4; ++m) {
                bf16_t* op = O + (size_t)(row0 + ai * 128 + m * 16) * ldc + col0;
#pragma unroll
                for (int bj = 0; bj < 2; ++bj)
#pragma unroll
                    for (int n = 0; n < 2; ++n) {
                        f32x4 v = acc[ai][bj][m][n];
                        if (ACT == 1) { v.x = fmaxf(v.x, 0.f); v.y = fmaxf(v.y, 0.f); v.z = fmaxf(v.z, 0.f); v.w = fmaxf(v.w, 0.f); v = v * v; }
                        u32x2 w; w.x = pk2(v.x, v.y); w.y = pk2(v.z, v.w);
                        *(u32x2*)(op + 32 * bj + 16 * n) = w;
                    }
            }
    }
};

struct EpiQKV1 {
    bf16_t* QKV; float* AB; bf16_t* ZL; int zp; bf16_t* HALO;
    DI void operator()(const f32x4 (&acc)[2][2][4][2], const Unit& u, int wr, int wc, int fr, int fq) const {
        asm volatile("" : "+v"(fr), "+v"(fq));
        const int row0 = u.pm * 256 + wr * 64 + fr;
        if (u.pn < 12) {
            const int col0 = u.pn * 256 + wc * 64 + 4 * fq;
#pragma unroll
            for (int ai = 0; ai < 2; ++ai)
#pragma unroll
                for (int m = 0; m < 4; ++m) {
                    bf16_t* op = QKV + (size_t)(row0 + ai * 128 + m * 16) * 3072 + col0;
#pragma unroll
                    for (int bj = 0; bj < 2; ++bj)
#pragma unroll
                        for (int n = 0; n < 2; ++n) {
                            const f32x4 v = acc[ai][bj][m][n];
                            u32x2 w; w.x = pk2(v.x, v.y); w.y = pk2(v.z, v.w);
                            *(u32x2*)(op + 32 * bj + 16 * n) = w;
                            if ((m == 0 && fr == 0) || (m == 3 && fr == 15))
                                *(u32x2*)(HALO + ((size_t)((row0 + ai * 128 + m * 16) >> 6) * 2 + (m == 3 ? 1 : 0)) * 3072 + col0 + 32 * bj + 16 * n) = w;
                        }
                }
        } else if (u.pn > 12) {
            const int col0 = (u.pn - 13) * 256 + wc * 64 + 4 * fq;
#pragma unroll
            for (int ai = 0; ai < 2; ++ai)
#pragma unroll
                for (int m = 0; m < 4; ++m) {
                    bf16_t* op = ZL + (size_t)(row0 + ai * 128 + m * 16) * zp + col0;
#pragma unroll
                    for (int bj = 0; bj < 2; ++bj)
#pragma unroll
                        for (int n = 0; n < 2; ++n) {
                            const f32x4 v = acc[ai][bj][m][n];
                            u32x2 w; w.x = pk2(v.x, v.y); w.y = pk2(v.z, v.w);
                            *(u32x2*)(op + 32 * bj + 16 * n) = w;
                        }
                }
        } else if (wc == 0) {
#pragma unroll
            for (int ai = 0; ai < 2; ++ai)
#pragma unroll
                for (int m = 0; m < 4; ++m) {
                    float* op = AB + (size_t)(row0 + ai * 128 + m * 16) * 32 + 4 * fq;
#pragma unroll
                    for (int n = 0; n < 2; ++n) *(f32x4*)(op + 16 * n) = acc[ai][0][m][n];
                }
        }
    }
};

struct EpiQKV0 {
    bf16_t *Q, *KS, *VTS, *KP, *VTP; float *newk, *newv;
    const float *qna, *kna, *qnb, *knb;
    DI void operator()(const f32x4 (&acc)[2][2][4][2], const Unit& u, int wr, int wc, int fr, int fq) const {
        asm volatile("" : "+v"(fr), "+v"(fq));
        const int pn = u.pn; const bool prompt = u.pm < 32;
        int type, head; const float* gain = qna; bool rope = false;
        if (pn < 2) { type = 0; head = 4 * pn + wc; gain = qna; rope = true; }
        else if (pn == 2) { if (wc < 2) { type = 1; head = wc; gain = kna; rope = true; } else { type = 2; head = wc - 2; } }
        else if (pn < 5) { type = 0; head = 8 + 4 * (pn - 3) + wc; gain = qnb; }
        else if (pn < 7) { type = 1; head = 2 + 4 * (pn - 5) + wc; gain = knb; }
        else { type = 2; head = 2 + 4 * (pn - 7) + wc; }
        rope = rope && !prompt;
        float invf[4];
#pragma unroll
        for (int j = 0; j < 4; ++j) invf[j] = __builtin_amdgcn_exp2f(-(float)(4 * fq + j) * 0.83048202372184059f);
        const int row0 = u.pm * 256 + wr * 64 + fr;
#pragma unroll
        for (int ai = 0; ai < 2; ++ai)
#pragma unroll
            for (int m = 0; m < 4; ++m) {
                const int mg = row0 + ai * 128 + m * 16;
                f32x4 v[2][2];
#pragma unroll
                for (int bj = 0; bj < 2; ++bj)
#pragma unroll
                    for (int n = 0; n < 2; ++n) v[bj][n] = acc[ai][bj][m][n];
                if (type != 2) {
                    float ss = 0.f;
#pragma unroll
                    for (int bj = 0; bj < 2; ++bj)
#pragma unroll
                        for (int n = 0; n < 2; ++n) { const f32x4 x = v[bj][n]; ss += (x.x * x.x + x.y * x.y) + (x.z * x.z + x.w * x.w); }
                    ss += __shfl_xor(ss, 16); ss += __shfl_xor(ss, 32);
                    const float rinv = __builtin_amdgcn_rsqf(ss * (1.0f / 64.0f) + 1e-6f);
#pragma unroll
                    for (int bj = 0; bj < 2; ++bj)
#pragma unroll
                        for (int n = 0; n < 2; ++n) v[bj][n] = v[bj][n] * rinv * *(const f32x4*)(gain + 32 * bj + 16 * n + 4 * fq);
                    if (rope) {
                        const int t = (mg - NPR) & 2047;
                        const float pos[2] = {(float)(t >> 6), (float)(t & 63)};
#pragma unroll
                        for (int bj = 0; bj < 2; ++bj)
#pragma unroll
                            for (int j = 0; j < 4; ++j) {
                                const float ang = pos[bj] * invf[j];
                                const float cs = __cosf(ang), sn = __sinf(ang);
                                const float x1 = v[bj][0][j], x2 = v[bj][1][j];
                                v[bj][0][j] = x1 * cs - x2 * sn; v[bj][1][j] = x2 * cs + x1 * sn;
                            }
                    }
                }
                int b, t, ntile; bf16_t* kbase; bf16_t* vbase;
                if (prompt) { b = mg >> 8; t = mg & 255; ntile = 8; kbase = KP; vbase = VTP; }
                else { b = (mg - NPR) >> 11; t = (mg - NPR) & 2047; ntile = 72; kbase = KS; vbase = VTS; }
                const size_t tbase = ((size_t)(b * 10 + head) * ntile + (t >> 5)) * 2048; const int kk = t & 31;
#pragma unroll
                for (int bj = 0; bj < 2; ++bj)
#pragma unroll
                    for (int n = 0; n < 2; ++n) {
                        const int d0 = 32 * bj + 16 * n + 4 * fq;
                        const f32x4 x = v[bj][n];
                        if (type == 0) { u32x2 w; w.x = pk2(x.x, x.y); w.y = pk2(x.z, x.w); *(u32x2*)(Q + (size_t)mg * 1024 + head * 64 + d0) = w; }
                        else if (type == 1) {
                            u32x2 w; w.x = pk2(x.x, x.y); w.y = pk2(x.z, x.w); *(u32x2*)(kbase + tbase + ((d0 >> 3) * 32 + kk) * 8 + (d0 & 7)) = w;
                            if (prompt) *(f32x4*)(newk + (size_t)mg * 640 + head * 64 + d0) = x;
                        } else {
                            bf16_t* vp = vbase + tbase + ((((((d0 >> 5) * 2 + (kk >> 4)) * 2 + ((kk >> 3) & 1)) * 2 + ((kk >> 2) & 1)) * 32 + (d0 & 31)) << 2) + (kk & 3);
                            const unsigned w0 = pk2(x.x, x.y), w1 = pk2(x.z, x.w);
                            vp[0] = (bf16_t)(w0 & 0xffffu); vp[4] = (bf16_t)(w0 >> 16); vp[8] = (bf16_t)(w1 & 0xffffu); vp[12] = (bf16_t)(w1 >> 16);
                            if (prompt) *(f32x4*)(newv + (size_t)mg * 640 + head * 64 + d0) = x;
                        }
                    }
                asm volatile("" ::: "memory");
            }
    }
};

DI float wave_sum(float v) {
#pragma unroll
    for (int o = 1; o < 64; o <<= 1) v += __shfl_xor(v, o);
    return v;
}
DI int perm_row32(int n0) { return (n0 & ~255) + 128 * ((n0 >> 5) & 1) + 32 * ((n0 >> 6) & 3); }

DI void transpose_item(const float* W, int N, int k0, int n0, bf16_t* WT, int ldt, int row0, LAS float* scr, int lane) {
#pragma unroll 8
    for (int i = 0; i < 32; ++i) { const int kk = 2 * i + (lane >> 5); scr[kk * 33 + (lane & 31)] = W[(size_t)(k0 + kk) * N + n0 + (lane & 31)]; }
    asm volatile("s_waitcnt lgkmcnt(0)" ::: "memory");
    const int c = lane & 7;
#pragma unroll
    for (int j = 0; j < 4; ++j) { const int n = (lane >> 3) + 8 * j; const LAS float* s = scr + (8 * c) * 33 + n;
        u32x4 o; o.x = pk2(s[0 * 33], s[1 * 33]); o.y = pk2(s[2 * 33], s[3 * 33]); o.z = pk2(s[4 * 33], s[5 * 33]); o.w = pk2(s[6 * 33], s[7 * 33]);
        *(u32x4*)(WT + (size_t)(row0 + n) * ldt + k0 + 8 * c) = o; }
    asm volatile("s_waitcnt lgkmcnt(0)" ::: "memory");
}
DI void transpose_matrix(const float* W, int K, int N, bf16_t* WT, LAS float* scr, int gw, int NGW, int lane) {
    const int nblk = N / 32, nitems = (K / 64) * nblk;
    for (int it = gw; it < nitems; it += NGW) { const int kb = it / nblk, nb = it % nblk; transpose_item(W, N, kb * 64, nb * 32, WT, K, perm_row32(nb * 32), scr, lane); }
}

DI void norm_phase(const float* xa, const float* xb, bf16_t* XB, const float* gain, const float* sh, const float* sc, bf16_t* H, int hp, int gw, int NGW, int lane, const float* P = nullptr) {
    for (int m0 = gw; m0 < NTOK; m0 += 2 * NGW) {
        const int m1 = m0 + NGW; const bool has1 = m1 < NTOK; const int m1c = has1 ? m1 : m0;
        f32x4 v0[4], v1[4];
        if (XB) {
#pragma unroll
            for (int j = 0; j < 4; ++j) {
                const u32x2 w0 = *(const u32x2*)(XB + (size_t)m0 * XBP + 4 * lane + 256 * j), w1 = *(const u32x2*)(XB + (size_t)m1c * XBP + 4 * lane + 256 * j);
                v0[j] = (f32x4){bflo(w0.x), bfhi(w0.x), bflo(w0.y), bfhi(w0.y)}; v1[j] = (f32x4){bflo(w1.x), bfhi(w1.x), bflo(w1.y), bfhi(w1.y)};
            }
        } else {
            const float* xr0 = (m0 < NPR) ? xa + (size_t)m0 * DM : xb + (size_t)(m0 - NPR) * DM;
            const float* xr1 = (m1c < NPR) ? xa + (size_t)m1c * DM : xb + (size_t)(m1c - NPR) * DM;
#pragma unroll
            for (int j = 0; j < 4; ++j) { v0[j] = *(const f32x4*)(xr0 + 4 * lane + 256 * j); v1[j] = *(const f32x4*)(xr1 + 4 * lane + 256 * j); }
        }
        if (P) {
#pragma unroll
            for (int j = 0; j < 4; ++j) {
                if (m0 >= 16384) { v0[j] = v0[j] + *(const f32x4*)(P + (size_t)(m0 - 16384) * DM + 4 * lane + 256 * j);
                    u32x2 o; o.x = pk2(v0[j].x, v0[j].y); o.y = pk2(v0[j].z, v0[j].w); *(u32x2*)(XB + (size_t)m0 * XBP + 4 * lane + 256 * j) = o; }
                if (has1 && m1 >= 16384) { v1[j] = v1[j] + *(const f32x4*)(P + (size_t)(m1 - 16384) * DM + 4 * lane + 256 * j);
                    u32x2 o; o.x = pk2(v1[j].x, v1[j].y); o.y = pk2(v1[j].z, v1[j].w); *(u32x2*)(XB + (size_t)m1 * XBP + 4 * lane + 256 * j) = o; }
            }
        }
        float s0 = 0.f, s1 = 0.f;
#pragma unroll
        for (int j = 0; j < 4; ++j) { s0 += (v0[j].x * v0[j].x + v0[j].y * v0[j].y) + (v0[j].z * v0[j].z + v0[j].w * v0[j].w); s1 += (v1[j].x * v1[j].x + v1[j].y * v1[j].y) + (v1[j].z * v1[j].z + v1[j].w * v1[j].w); }
        const float r0 = __builtin_amdgcn_rsqf(wave_sum(s0) * (1.0f / DM) + 1e-6f), r1 = __builtin_amdgcn_rsqf(wave_sum(s1) * (1.0f / DM) + 1e-6f);
        const int mr0 = (m0 < NPR) ? 0 : 1 + ((m0 - NPR) >> 11), mr1 = (m1c < NPR) ? 0 : 1 + ((m1c - NPR) >> 11);
#pragma unroll
        for (int j = 0; j < 4; ++j) {
            const int c = 4 * lane + 256 * j;
            const f32x4 g = *(const f32x4*)(gain + c);
            { const f32x4 a = *(const f32x4*)(sc + mr0 * MODW + c), b = *(const f32x4*)(sh + mr0 * MODW + c);
              const f32x4 o = v0[j] * r0 * g * (a + 1.0f) + b; u32x2 w; w.x = pk2(o.x, o.y); w.y = pk2(o.z, o.w); *(u32x2*)(H + (size_t)m0 * hp + c) = w; }
            if (has1) { const f32x4 a = *(const f32x4*)(sc + mr1 * MODW + c), b = *(const f32x4*)(sh + mr1 * MODW + c);
              const f32x4 o = v1[j] * r1 * g * (a + 1.0f) + b; u32x2 w; w.x = pk2(o.x, o.y); w.y = pk2(o.z, o.w); *(u32x2*)(H + (size_t)m1 * hp + c) = w; }
        }
    }
}

#define MFMA32(a, b, c) __builtin_amdgcn_mfma_f32_32x32x16_bf16((a), (b), (c), 0, 0, 0)
template <int NH, bool NA>
DI void attn_unit(const bf16_t* Qrow, const bf16_t* Kp, const bf16_t* VTp, int vstride,
                  int seg0_start, int seg0_tiles, int seg1_start, int seg1_tiles,
                  const LAS float* biasH, int qr, int c0, float shift, bf16_t* Orow, int lane) {
    const int r = lane & 31, hh = lane >> 5;
    bf16x8 Qf[NH][4];
#pragma unroll
    for (int h = 0; h < NH; ++h)
#pragma unroll
        for (int s = 0; s < 4; ++s) Qf[h][s] = *(const bf16x8*)(Qrow + (size_t)r * 1024 + 64 * h + 16 * s + 8 * hh);
    f32x16 O[NH][2]; float mrun[NH], lrun[NH];
#pragma unroll
    for (int h = 0; h < NH; ++h) { mrun[h] = -1e30f; lrun[h] = 0.f;
#pragma unroll
        for (int b = 0; b < 2; ++b)
#pragma unroll
            for (int i = 0; i < 16; ++i) O[h][b][i] = 0.f; }
    const float SC = 0.125f * 1.4426950408889634f;
    const int ntiles = seg0_tiles + seg1_tiles;
    bf16x8 Kn[4]; s16x4 Vln[2][2], Vhn[2][2];
    {
        const int k0 = seg0_tiles > 0 ? seg0_start : seg1_start;
        const bf16_t* kt = Kp + (size_t)(k0 >> 5) * 2048; const bf16_t* vt = VTp + (size_t)(k0 >> 5) * 2048;
#pragma unroll
        for (int s = 0; s < 4; ++s) Kn[s] = *(const bf16x8*)(kt + (s * 64 + lane) * 8);
#pragma unroll
        for (int b = 0; b < 2; ++b)
#pragma unroll
            for (int s = 0; s < 2; ++s) { Vln[b][s] = *(const s16x4*)(vt + (((b * 2 + s) * 2 + 0) * 64 + lane) * 4); Vhn[b][s] = *(const s16x4*)(vt + (((b * 2 + s) * 2 + 1) * 64 + lane) * 4); }
    }
    for (int ti = 0; ti < ntiles; ++ti) {
        const bool loc = ti < seg0_tiles;
        const int k0 = loc ? seg0_start + 32 * ti : seg1_start + 32 * (ti - seg0_tiles);
        bf16x8 Kf[4]; s16x4 Vlo[2][2], Vhi[2][2];
#pragma unroll
        for (int s = 0; s < 4; ++s) Kf[s] = Kn[s];
#pragma unroll
        for (int b = 0; b < 2; ++b)
#pragma unroll
            for (int s = 0; s < 2; ++s) { Vlo[b][s] = Vln[b][s]; Vhi[b][s] = Vhn[b][s]; }
        {
            const int tn = min(ti + 1, ntiles - 1);
            const int k1 = (tn < seg0_tiles) ? seg0_start + 32 * tn : seg1_start + 32 * (tn - seg0_tiles);
            const bf16_t* kt = Kp + (size_t)(k1 >> 5) * 2048; const bf16_t* vt = VTp + (size_t)(k1 >> 5) * 2048;
#pragma unroll
            for (int s = 0; s < 4; ++s) Kn[s] = *(const bf16x8*)(kt + (s * 64 + lane) * 8);
#pragma unroll
            for (int b = 0; b < 2; ++b)
#pragma unroll
                for (int s = 0; s < 2; ++s) { Vln[b][s] = *(const s16x4*)(vt + (((b * 2 + s) * 2 + 0) * 64 + lane) * 4); Vhn[b][s] = *(const s16x4*)(vt + (((b * 2 + s) * 2 + 1) * 64 + lane) * 4); }
        }
#pragma unroll
        for (int h = 0; h < NH; ++h) {
            f32x16 st;
#pragma unroll
            for (int i = 0; i < 16; ++i) st[i] = 0.f;
#pragma unroll
            for (int s = 0; s < 4; ++s) st = MFMA32(Kf[s], Qf[h][s], st);
            float ps = 0.f;
            if (NA && loc) {
                const int c = c0 + r, cs = min(max(c - 8, 0), 48);
                const int d0 = (k0 & 63) + 4 * hh - cs;
                const int b0 = ((k0 >> 6) - qr + 7) * 31 + (cs - c + 15);
#pragma unroll
                for (int i = 0; i < 16; ++i) {
                    const int d = d0 + (i & 3) + 8 * (i >> 2);
                    const bool valid = (unsigned)d < 16u;
                    const float bv = biasH[valid ? b0 + d : 0];
                    const float x = valid ? st[i] * SC - shift + bv * 1.4426950408889634f : -1e30f;
                    const float p = __builtin_amdgcn_exp2f(x); st[i] = p; ps += p;
                }
            } else {
#pragma unroll
                for (int i = 0; i < 16; ++i) { const float p = __builtin_amdgcn_exp2f(st[i] * SC - shift); st[i] = p; ps += p; }
            }
            lrun[h] += ps;
#pragma unroll
            for (int s = 0; s < 2; ++s) {
                u32x4 pw; pw.x = pk2(st[8 * s + 0], st[8 * s + 1]); pw.y = pk2(st[8 * s + 2], st[8 * s + 3]); pw.z = pk2(st[8 * s + 4], st[8 * s + 5]); pw.w = pk2(st[8 * s + 6], st[8 * s + 7]);
                const bf16x8 Pf = __builtin_bit_cast(bf16x8, pw);
#pragma unroll
                for (int b = 0; b < 2; ++b) {
                    const bf16x8 Vf = __builtin_shufflevector(Vlo[b][s], Vhi[b][s], 0, 1, 2, 3, 4, 5, 6, 7);
                    O[h][b] = MFMA32(Vf, Pf, O[h][b]);
                }
            }
        }
    }
#pragma unroll
    for (int h = 0; h < NH; ++h) {
        const float lt = lrun[h] + __shfl_xor(lrun[h], 32);
        const float inv = 1.0f / lt;
#pragma unroll
        for (int b = 0; b < 2; ++b)
#pragma unroll
            for (int g = 0; g < 4; ++g) {
                u32x2 w; w.x = pk2(O[h][b][4 * g] * inv, O[h][b][4 * g + 1] * inv); w.y = pk2(O[h][b][4 * g + 2] * inv, O[h][b][4 * g + 3] * inv);
                *(u32x2*)(Orow + (size_t)r * 1024 + 64 * h + 32 * b + 8 * g + 4 * hh) = w;
            }
    }
}

DI float wave_max(float v) {
#pragma unroll
    for (int o = 1; o < 64; o <<= 1) v = fmaxf(v, __shfl_xor(v, o));
    return v;
}
DI void attention_phase(const bf16_t* Q, const bf16_t* KS, const bf16_t* VTS, const bf16_t* KP, const bf16_t* VTP, const LAS float* rel_bias, const float* qna, const float* kna, const float* qnb, const float* knb,
                        bf16_t* AO, int gw, int NGW, int lane) {
    const float L2E = 1.4426950408889634f;
    const float shiftA = 8.0f * wave_max(fabsf(qna[lane])) * wave_max(fabsf(kna[lane])) * L2E;
    const float boundB = 8.0f * wave_max(fabsf(qnb[lane])) * wave_max(fabsf(knb[lane]));
    float bm = 0.f;
    for (int i = lane; i < 3720; i += 64) bm = fmaxf(bm, fabsf(rel_bias[i]));
    const float shiftB = boundB * L2E, shiftN = (boundB + wave_max(bm)) * L2E;
    for (int U = gw; U < 9216; U += NGW) {
        if (U < 2048) {
            const int u = U, b = u >> 8, kv = (u >> 7) & 1, gp = (u >> 6) & 1, qt = u & 63;
            const int m0 = NPR + b * 2048 + qt * 32, qc = (kv * 4 + gp * 2) * 64;
            attn_unit<2, false>(Q + (size_t)m0 * 1024 + qc, KS + (size_t)(b * 10 + kv) * 72 * 2048, VTS + (size_t)(b * 10 + kv) * 72 * 2048, 2304, 0, 72, 0, 0, nullptr, 0, 0, shiftA, AO + (size_t)m0 * 1024 + qc, lane);
        } else if (U < 6144) {
            const int u = U - 2048, b = u >> 9, h = (u >> 6) & 7, qt = u & 63, qr = qt >> 1, c0 = (qt & 1) * 32;
            const int m0 = NPR + b * 2048 + qt * 32, qc = 512 + h * 64;
            const int rs = min(max(qr - 4, 0), 24);
            attn_unit<1, true>(Q + (size_t)m0 * 1024 + qc, KS + (size_t)(b * 10 + 2 + h) * 72 * 2048, VTS + (size_t)(b * 10 + 2 + h) * 72 * 2048, 2304, rs * 64, 16, 2048, 8, rel_bias + h * 465, qr, c0, shiftN, AO + (size_t)m0 * 1024 + qc, lane);
        } else if (U < 7168) {
            const int u = U - 6144, b = u >> 5, kv = (u >> 4) & 1, gp = (u >> 3) & 1, qt = u & 7;
            const int m0 = b * 256 + qt * 32, qc = (kv * 4 + gp * 2) * 64;
            attn_unit<2, false>(Q + (size_t)m0 * 1024 + qc, KP + (size_t)(b * 10 + kv) * 8 * 2048, VTP + (size_t)(b * 10 + kv) * 8 * 2048, 256, 0, 8, 0, 0, nullptr, 0, 0, shiftA, AO + (size_t)m0 * 1024 + qc, lane);
        } else {
            const int u = U - 7168, b = u >> 6, h = (u >> 3) & 7, qt = u & 7;
            const int m0 = b * 256 + qt * 32, qc = 512 + h * 64;
            attn_unit<1, false>(Q + (size_t)m0 * 1024 + qc, KP + (size_t)(b * 10 + 2 + h) * 8 * 2048, VTP + (size_t)(b * 10 + 2 + h) * 8 * 2048, 256, 0, 8, 0, 0, nullptr, 0, 0, shiftB, AO + (size_t)m0 * 1024 + qc, lane);
        }
    }
}

DI float quad_sum(float x) {
    x += __builtin_bit_cast(float, __builtin_amdgcn_mov_dpp(__builtin_bit_cast(int, x), 0xB1, 0xF, 0xF, true));
    x += __builtin_bit_cast(float, __builtin_amdgcn_mov_dpp(__builtin_bit_cast(int, x), 0x4E, 0xF, 0xF, true));
    return x;
}
DI void delta_unit(LAS unsigned char* lds, const bf16_t* QKV, const float* AB, const float* conv_w, float Aexp, float dtb,
                   int m0, int T, int h, int dir, const float* s0  , float* sfin  , bf16_t* OUT) {
    const int tid = opq(threadIdx.x), wid = tid >> 6, lane = tid & 63, kq = lane & 3, vl = lane >> 2, v = 16 * wid + vl;
    LAS float* sQ = (LAS float*)lds; LAS float* sK = sQ + 32 * 128; LAS float* sV = sK + 32 * 128; LAS float* sA = sV + 32 * 128; LAS float* sB = sA + 32;
    float S[32];
#pragma unroll
    for (int i = 0; i < 32; ++i) S[i] = s0 ? s0[(size_t)(kq * 32 + i) * 128 + v] : 0.f;
    const int nblk = T / 32;
    for (int blk = 0; blk < nblk; ++blk) {
        const int t0 = (dir ? nblk - 1 - blk : blk) * 32;
        {
            const int tl = tid >> 4, cg = tid & 15, t = t0 + tl;
#pragma unroll
            for (int part = 0; part < 3; ++part) {
                const int col = part * 1024 + h * 128 + cg * 8;
                const bf16_t* base = QKV + (size_t)(m0 + t) * 3072 + col;
                u32x4 xm = {0u, 0u, 0u, 0u}, xp = {0u, 0u, 0u, 0u};
                const u32x4 x0 = *(const u32x4*)base;
                if (t > 0) xm = *(const u32x4*)(base - 3072);
                if (t < T - 1) xp = *(const u32x4*)(base + 3072);
                float o[8];
#pragma unroll
                for (int e = 0; e < 4; ++e) {
                    const f32x2 w0 = *(const f32x2*)(conv_w + col + 2 * e), w1 = *(const f32x2*)(conv_w + 3072 + col + 2 * e), w2 = *(const f32x2*)(conv_w + 6144 + col + 2 * e);
                    const float a0 = w0.x * bflo(xm[e]) + w1.x * bflo(x0[e]) + w2.x * bflo(xp[e]);
                    const float a1 = w0.y * bfhi(xm[e]) + w1.y * bfhi(x0[e]) + w2.y * bfhi(xp[e]);
                    o[2 * e] = siluf_(a0); o[2 * e + 1] = siluf_(a1);
                }
                LAS float* dst = (part == 0 ? sQ : (part == 1 ? sK : sV)) + tl * 128 + cg * 8;
                *(LAS f32x4*)dst = (f32x4){o[0], o[1], o[2], o[3]}; *(LAS f32x4*)(dst + 4) = (f32x4){o[4], o[5], o[6], o[7]};
            }
        }
        __syncthreads();
        {
            const int row = tid >> 3, sub = tid & 7;
            LAS float* p = (row < 32 ? sQ + row * 128 : sK + (row - 32) * 128) + sub * 16;
            f32x4 x[4]; float ss = 0.f;
#pragma unroll
            for (int i = 0; i < 4; ++i) { x[i] = *(LAS f32x4*)(p + 4 * i); ss += (x[i].x * x[i].x + x[i].y * x[i].y) + (x[i].z * x[i].z + x[i].w * x[i].w); }
            ss += __shfl_xor(ss, 1); ss += __shfl_xor(ss, 2); ss += __shfl_xor(ss, 4);
            const float sc = __builtin_amdgcn_rsqf(ss + 1e-6f) * (row < 32 ? 0.08838834764831845f : 1.0f);
#pragma unroll
            for (int i = 0; i < 4; ++i) *(LAS f32x4*)(p + 4 * i) = x[i] * sc;
            if (tid < 32) {
                const float* ab = AB + (size_t)(m0 + t0 + tid) * 32 + dir * 8 + h;
                const float xa = ab[0] + dtb, xb = ab[16];
                const float sp = xa > 20.f ? xa : log1pf(__expf(xa));
                sA[tid] = __expf(-Aexp * sp); sB[tid] = sigmoidf_(xb);
            }
        }
        __syncthreads();
        for (int i = 0; i < 32; ++i) {
            const int tl = dir ? 31 - i : i;
            const LAS float* kp = sK + tl * 128 + kq * 32; const LAS float* qp = sQ + tl * 128 + kq * 32;
            const float a = sA[tl], b = sB[tl], vt = sV[tl * 128 + v];
            f32x4 kk[8];
#pragma unroll
            for (int j = 0; j < 8; ++j) kk[j] = *(const LAS f32x4*)(kp + 4 * j);
            float ks = 0.f;
#pragma unroll
            for (int j = 0; j < 8; ++j) ks += (kk[j].x * S[4 * j] + kk[j].y * S[4 * j + 1]) + (kk[j].z * S[4 * j + 2] + kk[j].w * S[4 * j + 3]);
            ks = quad_sum(ks);
            const float d = b * (vt - a * ks);
            f32x4 qq[8];
#pragma unroll
            for (int j = 0; j < 8; ++j) qq[j] = *(const LAS f32x4*)(qp + 4 * j);
            float os = 0.f;
#pragma unroll
            for (int j = 0; j < 8; ++j) {
                S[4 * j] = a * S[4 * j] + kk[j].x * d; S[4 * j + 1] = a * S[4 * j + 1] + kk[j].y * d; S[4 * j + 2] = a * S[4 * j + 2] + kk[j].z * d; S[4 * j + 3] = a * S[4 * j + 3] + kk[j].w * d;
                os += (qq[j].x * S[4 * j] + qq[j].y * S[4 * j + 1]) + (qq[j].z * S[4 * j + 2] + qq[j].w * S[4 * j + 3]);
            }
            os = quad_sum(os);
            if (kq == 0) OUT[(size_t)(m0 + t0 + tl) * 1024 + h * 128 + v] = (bf16_t)(pk2(os, 0.f) & 0xffffu);
        }
        __syncthreads();
    }
    if (sfin) {
#pragma unroll
        for (int i = 0; i < 32; ++i) sfin[(size_t)(kq * 32 + i) * 128 + v] = S[i];
    }
}


constexpr int DP128 = 136, DP64 = 72;
constexpr int DL_QN = 0, DL_KN = 17408, DL_KNT = 34816, DL_VT = 53248, DL_ST = 71680, DL_ATT = 106496, DL_TM = 115712, DL_RT = 124928, DL_GATE = 143360;
constexpr int DL_AL1 = DL_KNT, DL_AL2 = DL_KNT + 9216, DL_TDT = DL_VT, DL_P1T = DL_VT + 9216, DL_T1 = DL_ST, DL_T1T = DL_ST + 9216, DL_AD = DL_ST + 18432;
constexpr int DL_VNT = DL_QN, DL_VNST = DL_VT, DL_CW = DL_GATE + 2048;
static_assert(DL_CW + 4608 <= LDS_BYTES, "delta LDS map");

DI int crow_(int i, int hh) { return (i & 3) + 8 * (i >> 2) + 4 * hh; }
DI bf16x8 ldfrag(const LAS bf16_t* base, int row, int pitch, int koff) { return *(const LAS bf16x8*)(base + row * pitch + koff); }
DI void store_tileT(LAS bf16_t* XT, int pitch, int col, int row0, int hh, const f32x16& a, float sc) {
#pragma unroll
    for (int g = 0; g < 4; ++g) { u32x2 w; w.x = pk2(a[4 * g] * sc, a[4 * g + 1] * sc); w.y = pk2(a[4 * g + 2] * sc, a[4 * g + 3] * sc);
        *(LAS u32x2*)(XT + col * pitch + row0 + 8 * g + 4 * hh) = w; }
}
DI void store_tileR(LAS bf16_t* X, int pitch, int col, int row0, int hh, const f32x16& a) {
#pragma unroll
    for (int i = 0; i < 16; ++i) X[(row0 + crow_(i, hh)) * pitch + col] = (bf16_t)(pk2(a[i], 0.f) & 0xffffu);
}
DI f32x16 mm64_tile(const LAS bf16_t* A, const LAS bf16_t* BT, int ib, int jb, int r, int hh, f32x16 acc) {
#pragma unroll
    for (int s = 0; s < 4; ++s) acc = MFMA32(ldfrag(A, 32 * ib + r, DP64, 16 * s + 8 * hh), ldfrag(BT, 32 * jb + r, DP64, 16 * s + 8 * hh), acc);
    return acc;
}

#ifdef PROBE_D1
#define REP_D1 _Pragma("unroll 1") for (int rep_ = 0; rep_ < 2; ++rep_)
#else
#define REP_D1
#endif
#ifdef PROBE_D3
#define REP_D3 _Pragma("unroll 1") for (int rep_ = 0; rep_ < 2; ++rep_)
#else
#define REP_D3
#endif
#ifdef PROBE_D6
#define REP_D6 _Pragma("unroll 1") for (int rep_ = 0; rep_ < 2; ++rep_)
#else
#define REP_D6
#endif
DI void delta_unit_chunked(LAS unsigned char* lds, const bf16_t* QKV, const float* AB, const float* conv_w, float Aexp, float dtb,
                           int m0, int T, int h, int dir, const float* s0, float* sfin, bf16_t* OUT) {
    const int tid0 = opq(threadIdx.x), w0 = __builtin_amdgcn_readfirstlane(tid0 >> 6);
    LAS bf16_t* QN = (LAS bf16_t*)(lds + DL_QN); LAS bf16_t* KN = (LAS bf16_t*)(lds + DL_KN); LAS bf16_t* KNT = (LAS bf16_t*)(lds + DL_KNT); LAS bf16_t* VT = (LAS bf16_t*)(lds + DL_VT);
    LAS bf16_t* ST = (LAS bf16_t*)(lds + DL_ST); LAS bf16_t* ATT = (LAS bf16_t*)(lds + DL_ATT); LAS bf16_t* TM = (LAS bf16_t*)(lds + DL_TM); LAS bf16_t* RT = (LAS bf16_t*)(lds + DL_RT);
    LAS float* GT = (LAS float*)(lds + DL_GATE);
    LAS bf16_t* AL1 = (LAS bf16_t*)(lds + DL_AL1); LAS bf16_t* AL2 = (LAS bf16_t*)(lds + DL_AL2); LAS bf16_t* TDT = (LAS bf16_t*)(lds + DL_TDT); LAS bf16_t* P1T = (LAS bf16_t*)(lds + DL_P1T);
    LAS bf16_t* T1 = (LAS bf16_t*)(lds + DL_T1); LAS bf16_t* T1T = (LAS bf16_t*)(lds + DL_T1T); LAS float* AD = (LAS float*)(lds + DL_AD);
    LAS bf16_t* VNT = (LAS bf16_t*)(lds + DL_VNT); LAS bf16_t* VNST = (LAS bf16_t*)(lds + DL_VNST);
    f32x16 Sacc[2];
    {
        const int lane = tid0 & 63, r = lane & 31, hh = lane >> 5, kb = w0 >> 1, vb0 = 2 * (w0 & 1);
#pragma unroll
        for (int e = 0; e < 2; ++e)
#pragma unroll
            for (int i = 0; i < 16; ++i) Sacc[e][i] = s0 ? s0[(size_t)(32 * kb + crow_(i, hh)) * 128 + 32 * (vb0 + e) + r] : 0.f;
    }
    LAS float* CW = (LAS float*)(lds + DL_CW);
    for (int i = tid0; i < 3 * 384; i += 512) { const int tap = i / 384, pc = i % 384; CW[i] = conv_w[tap * 3072 + (pc >> 7) * 1024 + h * 128 + (pc & 127)]; }
    __syncthreads();
    const int nch = T / 64;
    u32x4 xraw[3][4];
#define DELTA_LOAD_RAW(T0) do { const int tlo_ = (T0) + 2 * (tid0 >> 4), cg_ = tid0 & 15; \
        _Pragma("unroll") for (int part = 0; part < 3; ++part) _Pragma("unroll") for (int k = 0; k < 4; ++k) { \
            const int tt = tlo_ - 1 + k; const bool ok = (tt >= 0) && (tt < T); const int tc = min(max(tt, 0), T - 1); \
            u32x4 v_ = *(const u32x4*)(QKV + (size_t)(m0 + tc) * 3072 + part * 1024 + h * 128 + cg_ * 8); \
            if (!ok) v_ = (u32x4){0u, 0u, 0u, 0u}; xraw[part][k] = v_; } } while (0)
#ifdef DELTA_PREFETCH
    DELTA_LOAD_RAW((dir ? nch - 1 : 0) * 64);
#endif
#pragma unroll 1
    for (int ci = 0; ci < nch; ++ci) {
        const int tid = opq(threadIdx.x), w = __builtin_amdgcn_readfirstlane(tid >> 6), lane = tid & 63, r = lane & 31, hh = lane >> 5;
        const int kb = w >> 1, vb0 = 2 * (w & 1);
        const int t0 = (dir ? nch - 1 - ci : ci) * 64;
        u32x4 kpk[2], vpk[2];
        const int tlo = t0 + 2 * (tid >> 4);
#ifndef DELTA_PREFETCH
        DELTA_LOAD_RAW(t0);
#endif
        REP_D1 {
        {
            const int cg = tid & 15;
#pragma unroll
            for (int pass = 0; pass < 2; ++pass) {
                const int t = tlo + pass, i = dir ? t0 + 63 - t : t - t0;
                u32x4 pk[3];
#pragma unroll
                for (int part = 0; part < 3; ++part) {
                    const u32x4 xm = xraw[part][pass], x0 = xraw[part][pass + 1], xp = xraw[part][pass + 2];
                    float o[8]; float ss = 0.f;
#pragma unroll
                    for (int e = 0; e < 4; ++e) {
                        const f32x2 w0 = *(const LAS f32x2*)(CW + part * 128 + cg * 8 + 2 * e), w1 = *(const LAS f32x2*)(CW + 384 + part * 128 + cg * 8 + 2 * e), w2 = *(const LAS f32x2*)(CW + 768 + part * 128 + cg * 8 + 2 * e);
                        const float a0 = w0.x * bflo(xm[e]) + w1.x * bflo(x0[e]) + w2.x * bflo(xp[e]);
                        const float a1 = w0.y * bfhi(xm[e]) + w1.y * bfhi(x0[e]) + w2.y * bfhi(xp[e]);
                        o[2 * e] = siluf_(a0); o[2 * e + 1] = siluf_(a1);
                        ss += o[2 * e] * o[2 * e] + o[2 * e + 1] * o[2 * e + 1];
                    }
                    float sc = 1.0f;
                    if (part < 2) {
                        ss += __shfl_xor(ss, 1); ss += __shfl_xor(ss, 2); ss += __shfl_xor(ss, 4); ss += __shfl_xor(ss, 8);
                        sc = __builtin_amdgcn_rsqf(ss + 1e-6f) * (part == 0 ? 0.08838834764831845f : 1.0f);
                    }
                    pk[part].x = pk2(o[0] * sc, o[1] * sc); pk[part].y = pk2(o[2] * sc, o[3] * sc); pk[part].z = pk2(o[4] * sc, o[5] * sc); pk[part].w = pk2(o[6] * sc, o[7] * sc);
                }
                *(LAS u32x4*)(QN + i * DP128 + cg * 8) = pk[0];
                *(LAS u32x4*)(KN + i * DP128 + cg * 8) = pk[1];
                kpk[pass] = pk[1]; vpk[pass] = pk[2];
            }
        }
#ifdef DELTA_PREFETCH
        if (ci + 1 < nch) DELTA_LOAD_RAW((dir ? nch - 2 - ci : ci + 1) * 64);
#endif
        if (w == 0) {
            const int t = dir ? t0 + 63 - lane : t0 + lane;
            const float* ab = AB + (size_t)(m0 + t) * 32 + dir * 8 + h;
            const float xa = ab[0] + dtb, xb = ab[16];
            const float sp = xa > 20.f ? xa : log1pf(__expf(xa));
            float g = -Aexp * sp;
#pragma unroll
            for (int off = 1; off < 64; off <<= 1) { const float tmp = __shfl_up(g, off); if (lane >= off) g += tmp; }
            const float gl = __shfl(g, 63);
            GT[lane] = g; GT[64 + lane] = sigmoidf_(xb); GT[128 + lane] = __expf(g); GT[192 + lane] = __expf(gl - g);
            if (lane == 0) GT[256] = __expf(gl);
        }
        for (int i = tid; i < 64 * DP64 / 2; i += 512) { ((LAS unsigned*)TM)[i] = 0u; ((LAS unsigned*)TDT)[i] = 0u; }
        __syncthreads();
        }
        REP_D3 {
        {
            const int mat = w >> 2, ib = (w >> 1) & 1, jb = w & 1;
            f32x16 acc;
#pragma unroll
            for (int i = 0; i < 16; ++i) acc[i] = 0.f;
            if (ib >= jb) {
                const LAS bf16_t* X = mat ? QN : KN;
#pragma unroll
                for (int s = 0; s < 8; ++s) acc = MFMA32(ldfrag(X, 32 * ib + r, DP128, 16 * s + 8 * hh), ldfrag(KN, 32 * jb + r, DP128, 16 * s + 8 * hh), acc);
            }
            const int col = 32 * jb + r; const float gc = GT[col];
#pragma unroll
            for (int i = 0; i < 16; ++i) {
                const int row = 32 * ib + crow_(i, hh);
                const float dg = (row >= col) ? __expf(GT[row] - gc) : 0.f;
                if (mat == 0) {
                    const float a = (row > col) ? GT[64 + row] * acc[i] * dg : 0.f;
                    const bool same16 = (row >> 4) == (col >> 4), same32 = (row >> 5) == (col >> 5);
                    if (same16) AD[((row >> 4) * 16 + (row & 15)) * 20 + (col & 15)] = a;
                    AL1[row * DP64 + col] = (bf16_t)(pk2((same32 && !same16) ? a : 0.f, 0.f) & 0xffffu);
                    AL2[row * DP64 + col] = (bf16_t)(pk2(!same32 ? a : 0.f, 0.f) & 0xffffu);
                } else {
                    ATT[row * DP64 + col] = (bf16_t)(pk2((row >= col) ? acc[i] * dg : 0.f, 0.f) & 0xffffu);
                }
            }
        }
        __syncthreads();
        if (w == 0) {
            const int b = lane >> 4, c = lane & 15;
            const LAS float* ad = AD + b * 16 * 20;
            float X[16];
#pragma unroll
            for (int i = 0; i < 16; ++i) {
                float x = (i == c) ? 1.f : 0.f;
#pragma unroll
                for (int j4 = 0; j4 < (i + 3) / 4; ++j4) {
                    const f32x4 a = *(const LAS f32x4*)(ad + i * 20 + 4 * j4);
                    if (4 * j4 + 0 < i) x -= a.x * X[4 * j4 + 0];
                    if (4 * j4 + 1 < i) x -= a.y * X[4 * j4 + 1];
                    if (4 * j4 + 2 < i) x -= a.z * X[4 * j4 + 2];
                    if (4 * j4 + 3 < i) x -= a.w * X[4 * j4 + 3];
                }
                X[i] = x;
            }
#pragma unroll
            for (int i = 0; i < 16; ++i) TM[(16 * b + i) * DP64 + 16 * b + c] = (bf16_t)(pk2(X[i], 0.f) & 0xffffu);
#pragma unroll
            for (int g = 0; g < 4; ++g) { u32x2 wv; wv.x = pk2(X[4 * g], X[4 * g + 1]); wv.y = pk2(X[4 * g + 2], X[4 * g + 3]);
                *(LAS u32x2*)(TDT + (16 * b + c) * DP64 + 16 * b + 4 * g) = wv; }
        }
        __syncthreads();
        }
        const int ib5 = (w >> 1) & 1, jb5 = w & 1;
        f32x16 zero16;
#pragma unroll
        for (int i = 0; i < 16; ++i) zero16[i] = 0.f;
        if (w < 4) { const f32x16 p1 = mm64_tile(AL1, TDT, ib5, jb5, r, hh, zero16); store_tileT(P1T, DP64, 32 * jb5 + r, 32 * ib5, hh, p1, -1.0f); }
        __syncthreads();
        if (w < 4) {
            f32x16 c0;
#pragma unroll
            for (int i = 0; i < 16; ++i) c0[i] = bf2f(TM[(32 * ib5 + crow_(i, hh)) * DP64 + 32 * jb5 + r]);
            const f32x16 t1 = mm64_tile(TM, P1T, ib5, jb5, r, hh, c0);
            store_tileR(T1, DP64, 32 * jb5 + r, 32 * ib5, hh, t1); store_tileT(T1T, DP64, 32 * jb5 + r, 32 * ib5, hh, t1, 1.0f);
        }
        __syncthreads();
        if (w < 4) { const f32x16 p3 = mm64_tile(AL2, T1T, ib5, jb5, r, hh, zero16); store_tileT(P1T, DP64, 32 * jb5 + r, 32 * ib5, hh, p3, -1.0f); }
        __syncthreads();
        if (w < 4) {
            f32x16 c0;
#pragma unroll
            for (int i = 0; i < 16; ++i) c0[i] = bf2f(T1[(32 * ib5 + crow_(i, hh)) * DP64 + 32 * jb5 + r]);
            const f32x16 tt = mm64_tile(T1, P1T, ib5, jb5, r, hh, c0);
            store_tileR(TM, DP64, 32 * jb5 + r, 32 * ib5, hh, tt);
        }
        __syncthreads();
        const int cb = w >> 2, vb = w & 3;
        f32x16 O0;
        REP_D6 {
        {
            const int cg = tid & 15;
#pragma unroll
            for (int pass = 0; pass < 2; ++pass) {
                const int t = tlo + pass, i = dir ? t0 + 63 - t : t - t0;
#pragma unroll
                for (int e = 0; e < 4; ++e) {
                    const int ci_ = (((i >> 3) ^ (cg & 7)) << 3) + (i & 7);
                    KNT[(cg * 8 + 2 * e) * DP64 + ci_] = (bf16_t)(kpk[pass][e] & 0xffffu); KNT[(cg * 8 + 2 * e + 1) * DP64 + ci_] = (bf16_t)(kpk[pass][e] >> 16);
                    VT[(cg * 8 + 2 * e) * DP64 + ci_] = (bf16_t)(vpk[pass][e] & 0xffffu); VT[(cg * 8 + 2 * e + 1) * DP64 + ci_] = (bf16_t)(vpk[pass][e] >> 16);
                }
            }
#pragma unroll
            for (int e = 0; e < 2; ++e) store_tileT(ST, DP128, 32 * (vb0 + e) + r, 32 * kb, hh, Sacc[e], 1.0f);
        }
        __syncthreads();
        {
            f32x16 ks = zero16, qs = zero16;
#pragma unroll
            for (int s = 0; s < 8; ++s) {
                const bf16x8 sf = ldfrag(ST, 32 * vb + r, DP128, 16 * s + 8 * hh);
                ks = MFMA32(ldfrag(KN, 32 * cb + r, DP128, 16 * s + 8 * hh), sf, ks);
                qs = MFMA32(ldfrag(QN, 32 * cb + r, DP128, 16 * s + 8 * hh), sf, qs);
            }
            f32x16 rr;
#pragma unroll
            for (int g = 0; g < 4; ++g) {
                const u32x2 vv = *(const LAS u32x2*)(VT + (32 * vb + r) * DP64 + (((4 * cb + g) ^ ((r >> 3) & 3) ^ ((vb & 1) << 2)) << 3) + 4 * hh);
                const float v4[4] = {bflo(vv.x), bfhi(vv.x), bflo(vv.y), bfhi(vv.y)};
#pragma unroll
                for (int j = 0; j < 4; ++j) {
                    const int c = 32 * cb + 8 * g + 4 * hh + j; const float eg = GT[128 + c];
                    rr[4 * g + j] = GT[64 + c] * (v4[j] - eg * ks[4 * g + j]);
                    O0[4 * g + j] = eg * qs[4 * g + j];
                }
            }
            store_tileT(RT, DP64, 32 * vb + r, 32 * cb, hh, rr, 1.0f);
        }
        __syncthreads();
        }
        {
            const f32x16 vn = mm64_tile(TM, RT, cb, vb, r, hh, zero16);
            f32x16 vs;
#pragma unroll
            for (int i = 0; i < 16; ++i) vs[i] = vn[i] * GT[192 + 32 * cb + crow_(i, hh)];
            store_tileT(VNT, DP64, 32 * vb + r, 32 * cb, hh, vn, 1.0f);
            store_tileT(VNST, DP64, 32 * vb + r, 32 * cb, hh, vs, 1.0f);
        }
        __syncthreads();
        {
            const f32x16 o = mm64_tile(ATT, VNT, cb, vb, r, hh, O0);
#pragma unroll
            for (int i = 0; i < 16; ++i) {
                const int c = 32 * cb + crow_(i, hh), t = dir ? t0 + 63 - c : t0 + c;
                OUT[(size_t)(m0 + t) * 1024 + h * 128 + 32 * vb + r] = (bf16_t)(pk2(o[i], 0.f) & 0xffffu);
            }
            const float egl = GT[256];
#pragma unroll
            for (int e = 0; e < 2; ++e) {
                f32x16 a = Sacc[e] * egl;
#pragma unroll
                for (int s2 = 0; s2 < 4; ++s2) {
                    const int row = 32 * kb + r, blk = (2 * s2 + hh) ^ ((row >> 3) & 7);
                    a = MFMA32(ldfrag(KNT, row, DP64, 8 * blk), ldfrag(VNST, 32 * (vb0 + e) + r, DP64, 16 * s2 + 8 * hh), a);
                }
                Sacc[e] = a;
            }
        }
        __syncthreads();
    }
    if (sfin) {
        const int lane = tid0 & 63, r = lane & 31, hh = lane >> 5, kb = w0 >> 1, vb0 = 2 * (w0 & 1);
#pragma unroll
        for (int e = 0; e < 2; ++e)
#pragma unroll
            for (int i = 0; i < 16; ++i) sfin[(size_t)(32 * kb + crow_(i, hh)) * 128 + 32 * (vb0 + e) + r] = Sacc[e][i];
    }
}

DI void delta_gates(LAS float* GT, const float* AB, int m0, int t0, int h, int dir, float Aexp, float dtb, int lane) {
    const int t = dir ? t0 + 63 - lane : t0 + lane;
    const float* ab = AB + (size_t)(m0 + t) * 32 + dir * 8 + h;
    const float xa = ab[0] + dtb, xb = ab[16];
    const float sp = xa > 20.f ? xa : log1pf(__expf(xa));
    float g = -Aexp * sp;
#pragma unroll
    for (int off = 1; off < 64; off <<= 1) { const float tmp = __shfl_up(g, off); if (lane >= off) g += tmp; }
    const float gl = __shfl(g, 63);
    GT[lane] = g; GT[64 + lane] = sigmoidf_(xb); GT[128 + lane] = __expf(g); GT[192 + lane] = __expf(gl - g);
    if (lane == 0) GT[256] = __expf(gl);
}

DI void delta_prep_unit(LAS unsigned char* lds, bf16_t* QKV, const bf16_t* HALO, const float* AB, const float* conv_w, const float* a_log, const float* dt_bias,
                        int m0, int T, int t0, int h, bf16_t* OF, bf16_t* OB) {
    const int tid = opq(threadIdx.x);
    LAS bf16_t* QN = (LAS bf16_t*)(lds + DL_QN); LAS bf16_t* KN = (LAS bf16_t*)(lds + DL_KN);
    LAS bf16_t* ATT = (LAS bf16_t*)(lds + DL_ATT); LAS bf16_t* TM = (LAS bf16_t*)(lds + DL_TM);
    LAS float* GT = (LAS float*)(lds + DL_GATE);
    LAS bf16_t* AL1 = (LAS bf16_t*)(lds + DL_AL1); LAS bf16_t* AL2 = (LAS bf16_t*)(lds + DL_AL2); LAS bf16_t* TDT = (LAS bf16_t*)(lds + DL_TDT); LAS bf16_t* P1T = (LAS bf16_t*)(lds + DL_P1T);
    LAS bf16_t* T1 = (LAS bf16_t*)(lds + DL_T1); LAS bf16_t* T1T = (LAS bf16_t*)(lds + DL_T1T); LAS float* AD = (LAS float*)(lds + DL_AD);
    LAS float* CW = (LAS float*)(lds + DL_CW);
    for (int i = tid; i < 3 * 384; i += 512) { const int tap = i / 384, pc = i % 384; CW[i] = conv_w[tap * 3072 + (pc >> 7) * 1024 + h * 128 + (pc & 127)]; }
    const int cg = tid & 15, tlo = t0 + 2 * (tid >> 4), chg = (m0 + t0) >> 6;
    u32x4 xraw[3][4];
#pragma unroll
    for (int part = 0; part < 3; ++part)
#pragma unroll
        for (int k = 0; k < 4; ++k) {
            const int tt = tlo - 1 + k; const int col = part * 1024 + h * 128 + cg * 8;
            u32x4 v = {0u, 0u, 0u, 0u};
            if (tt < t0) { if (t0 > 0) v = *(const u32x4*)(HALO + ((size_t)(chg - 1) * 2 + 1) * 3072 + col); }
            else if (tt >= t0 + 64) { if (t0 + 64 < T) v = *(const u32x4*)(HALO + ((size_t)(chg + 1) * 2 + 0) * 3072 + col); }
            else v = *(const u32x4*)(QKV + (size_t)(m0 + tt) * 3072 + col);
            xraw[part][k] = v;
        }
    asm volatile("s_waitcnt vmcnt(0)" ::: "memory");
    __syncthreads();
    u32x4 pq[2], pkk[2];
#pragma unroll
    for (int pass = 0; pass < 2; ++pass) {
        const int t = tlo + pass;
        u32x4 pk[3];
#pragma unroll
        for (int part = 0; part < 3; ++part) {
            const u32x4 xm = xraw[part][pass], x0 = xraw[part][pass + 1], xp = xraw[part][pass + 2];
            float o[8]; float ss = 0.f;
#pragma unroll
            for (int e = 0; e < 4; ++e) {
                const f32x2 w0 = *(const LAS f32x2*)(CW + part * 128 + cg * 8 + 2 * e), w1 = *(const LAS f32x2*)(CW + 384 + part * 128 + cg * 8 + 2 * e), w2 = *(const LAS f32x2*)(CW + 768 + part * 128 + cg * 8 + 2 * e);
                const float a0 = w0.x * bflo(xm[e]) + w1.x * bflo(x0[e]) + w2.x * bflo(xp[e]);
                const float a1 = w0.y * bfhi(xm[e]) + w1.y * bfhi(x0[e]) + w2.y * bfhi(xp[e]);
                o[2 * e] = siluf_(a0); o[2 * e + 1] = siluf_(a1);
                ss += o[2 * e] * o[2 * e] + o[2 * e + 1] * o[2 * e + 1];
            }
            float sc = 1.0f;
            if (part < 2) {
                ss += __shfl_xor(ss, 1); ss += __shfl_xor(ss, 2); ss += __shfl_xor(ss, 4); ss += __shfl_xor(ss, 8);
                sc = __builtin_amdgcn_rsqf(ss + 1e-6f) * (part == 0 ? 0.08838834764831845f : 1.0f);
            }
            pk[part].x = pk2(o[0] * sc, o[1] * sc); pk[part].y = pk2(o[2] * sc, o[3] * sc); pk[part].z = pk2(o[4] * sc, o[5] * sc); pk[part].w = pk2(o[6] * sc, o[7] * sc);
            *(u32x4*)(QKV + (size_t)(m0 + t) * 3072 + part * 1024 + h * 128 + cg * 8) = pk[part];
        }
        pq[pass] = pk[0]; pkk[pass] = pk[1];
    }
#pragma unroll 1
    for (int dir = 0; dir < 2; ++dir) {
        const int tid2 = opq(threadIdx.x), w = __builtin_amdgcn_readfirstlane(tid2 >> 6), lane = tid2 & 63, r = lane & 31, hh = lane >> 5;
        const float Aexp = __expf(a_log[dir * 8 + h]), dtb = dt_bias[dir * 8 + h];
#pragma unroll
        for (int pass = 0; pass < 2; ++pass) {
            const int loc = tlo + pass - t0, i = dir ? 63 - loc : loc;
            *(LAS u32x4*)(QN + i * DP128 + cg * 8) = pq[pass];
            *(LAS u32x4*)(KN + i * DP128 + cg * 8) = pkk[pass];
        }
        if (w == 0) delta_gates(GT, AB, m0, t0, h, dir, Aexp, dtb, lane);
        for (int i = tid2; i < 64 * DP64 / 2; i += 512) { ((LAS unsigned*)TM)[i] = 0u; ((LAS unsigned*)TDT)[i] = 0u; }
        __syncthreads();
        {
            const int mat = w >> 2, ib = (w >> 1) & 1, jb = w & 1;
            f32x16 acc;
#pragma unroll
            for (int i = 0; i < 16; ++i) acc[i] = 0.f;
            if (ib >= jb) {
                const LAS bf16_t* X = mat ? QN : KN;
#pragma unroll
                for (int s = 0; s < 8; ++s) acc = MFMA32(ldfrag(X, 32 * ib + r, DP128, 16 * s + 8 * hh), ldfrag(KN, 32 * jb + r, DP128, 16 * s + 8 * hh), acc);
            }
            const int col = 32 * jb + r; const float gc = GT[col];
#pragma unroll
            for (int i = 0; i < 16; ++i) {
                const int row = 32 * ib + crow_(i, hh);
                const float dg = (row >= col) ? __expf(GT[row] - gc) : 0.f;
                if (mat == 0) {
                    const float a = (row > col) ? GT[64 + row] * acc[i] * dg : 0.f;
                    const bool same16 = (row >> 4) == (col >> 4), same32 = (row >> 5) == (col >> 5);
                    if (same16) AD[((row >> 4) * 16 + (row & 15)) * 20 + (col & 15)] = a;
                    AL1[row * DP64 + col] = (bf16_t)(pk2((same32 && !same16) ? a : 0.f, 0.f) & 0xffffu);
                    AL2[row * DP64 + col] = (bf16_t)(pk2(!same32 ? a : 0.f, 0.f) & 0xffffu);
                } else {
                    ATT[row * DP64 + col] = (bf16_t)(pk2((row >= col) ? acc[i] * dg : 0.f, 0.f) & 0xffffu);
                }
            }
        }
        __syncthreads();
        if (w == 0) {
            const int b = lane >> 4, c = lane & 15;
            const LAS float* ad = AD + b * 16 * 20;
            float X[16];
#pragma unroll
            for (int i = 0; i < 16; ++i) {
                float x = (i == c) ? 1.f : 0.f;
#pragma unroll
                for (int j4 = 0; j4 < (i + 3) / 4; ++j4) {
                    const f32x4 a = *(const LAS f32x4*)(ad + i * 20 + 4 * j4);
                    if (4 * j4 + 0 < i) x -= a.x * X[4 * j4 + 0];
                    if (4 * j4 + 1 < i) x -= a.y * X[4 * j4 + 1];
                    if (4 * j4 + 2 < i) x -= a.z * X[4 * j4 + 2];
                    if (4 * j4 + 3 < i) x -= a.w * X[4 * j4 + 3];
                }
                X[i] = x;
            }
#pragma unroll
            for (int i = 0; i < 16; ++i) TM[(16 * b + i) * DP64 + 16 * b + c] = (bf16_t)(pk2(X[i], 0.f) & 0xffffu);
#pragma unroll
            for (int g = 0; g < 4; ++g) { u32x2 wv; wv.x = pk2(X[4 * g], X[4 * g + 1]); wv.y = pk2(X[4 * g + 2], X[4 * g + 3]);
                *(LAS u32x2*)(TDT + (16 * b + c) * DP64 + 16 * b + 4 * g) = wv; }
        }
        __syncthreads();
        const int ib5 = (w >> 1) & 1, jb5 = w & 1;
        f32x16 zero16;
#pragma unroll
        for (int i = 0; i < 16; ++i) zero16[i] = 0.f;
        if (w < 4) { const f32x16 p1 = mm64_tile(AL1, TDT, ib5, jb5, r, hh, zero16); store_tileT(P1T, DP64, 32 * jb5 + r, 32 * ib5, hh, p1, -1.0f); }
        __syncthreads();
        if (w < 4) {
            f32x16 c0;
#pragma unroll
            for (int i = 0; i < 16; ++i) c0[i] = bf2f(TM[(32 * ib5 + crow_(i, hh)) * DP64 + 32 * jb5 + r]);
            const f32x16 t1 = mm64_tile(TM, P1T, ib5, jb5, r, hh, c0);
            store_tileR(T1, DP64, 32 * jb5 + r, 32 * ib5, hh, t1); store_tileT(T1T, DP64, 32 * jb5 + r, 32 * ib5, hh, t1, 1.0f);
        }
        __syncthreads();
        if (w < 4) { const f32x16 p3 = mm64_tile(AL2, T1T, ib5, jb5, r, hh, zero16); store_tileT(P1T, DP64, 32 * jb5 + r, 32 * ib5, hh, p3, -1.0f); }
        __syncthreads();
        if (w < 4) {
            f32x16 c0;
#pragma unroll
            for (int i = 0; i < 16; ++i) c0[i] = bf2f(T1[(32 * ib5 + crow_(i, hh)) * DP64 + 32 * jb5 + r]);
            const f32x16 tt = mm64_tile(T1, P1T, ib5, jb5, r, hh, c0);
            store_tileR(TM, DP64, 32 * jb5 + r, 32 * ib5, hh, tt);
        }
        __syncthreads();
        {
            bf16_t* OUTd = dir ? OB : OF;
#pragma unroll
            for (int k2 = 0; k2 < 2; ++k2) {
                const int pc_ = tid2 + 512 * k2, row = pc_ >> 4, pc = pc_ & 15;
                const LAS bf16_t* src = (pc < 8 ? TM : ATT) + row * DP64 + (pc & 7) * 8;
                *(u32x4*)(OUTd + (size_t)(m0 + t0 + row) * 1024 + h * 128 + pc * 8) = *(const LAS u32x4*)src;
            }
        }
        __syncthreads();
    }
}

DI void delta_scan_unit(LAS unsigned char* lds, const bf16_t* QKV, const float* AB, float Aexp, float dtb,
                        int m0, int T, int h, int dir, const float* s0, float* sfin, bf16_t* OUT) {
    const int tid0 = opq(threadIdx.x), w0 = __builtin_amdgcn_readfirstlane(tid0 >> 6);
    LAS bf16_t* QN = (LAS bf16_t*)(lds + DL_QN); LAS bf16_t* KN = (LAS bf16_t*)(lds + DL_KN); LAS bf16_t* KNT = (LAS bf16_t*)(lds + DL_KNT); LAS bf16_t* VT = (LAS bf16_t*)(lds + DL_VT);
    LAS bf16_t* ST = (LAS bf16_t*)(lds + DL_ST); LAS bf16_t* ATT = (LAS bf16_t*)(lds + DL_ATT); LAS bf16_t* TM = (LAS bf16_t*)(lds + DL_TM); LAS bf16_t* RT = (LAS bf16_t*)(lds + DL_RT);
    LAS float* GT = (LAS float*)(lds + DL_GATE);
    LAS bf16_t* VNT = (LAS bf16_t*)(lds + DL_VNT); LAS bf16_t* VNST = (LAS bf16_t*)(lds + DL_VNST);
    f32x16 Sacc[2];
    {
        const int lane = tid0 & 63, r = lane & 31, hh = lane >> 5, kb = w0 >> 1, vb0 = 2 * (w0 & 1);
#pragma unroll
        for (int e = 0; e < 2; ++e)
#pragma unroll
            for (int i = 0; i < 16; ++i) Sacc[e][i] = s0 ? s0[(size_t)(32 * kb + crow_(i, hh)) * 128 + 32 * (vb0 + e) + r] : 0.f;
    }
    const int nch = T / 64;
    u32x4 pre[8];
#define DSCAN_LOAD(T0) do { const int tlo_ = (T0) + 2 * (tid0 >> 4), cg_ = tid0 & 15; \
        _Pragma("unroll") for (int pass = 0; pass < 2; ++pass) _Pragma("unroll") for (int part = 0; part < 3; ++part) \
            pre[pass * 3 + part] = *(const u32x4*)(QKV + (size_t)(m0 + tlo_ + pass) * 3072 + part * 1024 + h * 128 + cg_ * 8); \
        _Pragma("unroll") for (int k2 = 0; k2 < 2; ++k2) { const int pc_ = tid0 + 512 * k2; \
            pre[6 + k2] = *(const u32x4*)(OUT + (size_t)(m0 + (T0) + (pc_ >> 4)) * 1024 + h * 128 + (pc_ & 15) * 8); } } while (0)
    DSCAN_LOAD((dir ? nch - 1 : 0) * 64);
#pragma unroll 1
    for (int ci = 0; ci < nch; ++ci) {
        const int tid = opq(threadIdx.x), w = __builtin_amdgcn_readfirstlane(tid >> 6), lane = tid & 63, r = lane & 31, hh = lane >> 5;
        const int kb = w >> 1, vb0 = 2 * (w & 1);
        const int t0 = (dir ? nch - 1 - ci : ci) * 64;
        {
            const int cg = tid & 15, tlo = t0 + 2 * (tid >> 4);
#pragma unroll
            for (int pass = 0; pass < 2; ++pass) {
                const int loc = tlo + pass - t0, i = dir ? 63 - loc : loc;
                *(LAS u32x4*)(QN + i * DP128 + cg * 8) = pre[pass * 3 + 0];
                *(LAS u32x4*)(KN + i * DP128 + cg * 8) = pre[pass * 3 + 1];
                const int ci_ = (((i >> 3) ^ (cg & 7)) << 3) + (i & 7);
#pragma unroll
                for (int e = 0; e < 4; ++e) {
                    KNT[(cg * 8 + 2 * e) * DP64 + ci_] = (bf16_t)(pre[pass * 3 + 1][e] & 0xffffu); KNT[(cg * 8 + 2 * e + 1) * DP64 + ci_] = (bf16_t)(pre[pass * 3 + 1][e] >> 16);
                    VT[(cg * 8 + 2 * e) * DP64 + ci_] = (bf16_t)(pre[pass * 3 + 2][e] & 0xffffu); VT[(cg * 8 + 2 * e + 1) * DP64 + ci_] = (bf16_t)(pre[pass * 3 + 2][e] >> 16);
                }
            }
#pragma unroll
            for (int k2 = 0; k2 < 2; ++k2) {
                const int pc_ = tid + 512 * k2, row = pc_ >> 4, pc = pc_ & 15;
                *(LAS u32x4*)((pc < 8 ? TM : ATT) + row * DP64 + (pc & 7) * 8) = pre[6 + k2];
            }
#pragma unroll
            for (int e = 0; e < 2; ++e) store_tileT(ST, DP128, 32 * (vb0 + e) + r, 32 * kb, hh, Sacc[e], 1.0f);
        }
        if (w == 0) delta_gates(GT, AB, m0, t0, h, dir, Aexp, dtb, lane);
        if (ci + 1 < nch) DSCAN_LOAD((dir ? nch - 2 - ci : ci + 1) * 64);
        __syncthreads();
        f32x16 zero16;
#pragma unroll
        for (int i = 0; i < 16; ++i) zero16[i] = 0.f;
        const int cb = w >> 2, vb = w & 3;
        f32x16 O0;
        {
            f32x16 ks = zero16, qs = zero16;
#pragma unroll
            for (int s = 0; s < 8; ++s) {
                const bf16x8 sf = ldfrag(ST, 32 * vb + r, DP128, 16 * s + 8 * hh);
                ks = MFMA32(ldfrag(KN, 32 * cb + r, DP128, 16 * s + 8 * hh), sf, ks);
                qs = MFMA32(ldfrag(QN, 32 * cb + r, DP128, 16 * s + 8 * hh), sf, qs);
            }
            f32x16 rr;
#pragma unroll
            for (int g = 0; g < 4; ++g) {
                const u32x2 vv = *(const LAS u32x2*)(VT + (32 * vb + r) * DP64 + (((4 * cb + g) ^ ((r >> 3) & 3) ^ ((vb & 1) << 2)) << 3) + 4 * hh);
                const float v4[4] = {bflo(vv.x), bfhi(vv.x), bflo(vv.y), bfhi(vv.y)};
#pragma unroll
                for (int j = 0; j < 4; ++j) {
                    const int c = 32 * cb + 8 * g + 4 * hh + j; const float eg = GT[128 + c];
                    rr[4 * g + j] = GT[64 + c] * (v4[j] - eg * ks[4 * g + j]);
                    O0[4 * g + j] = eg * qs[4 * g + j];
                }
            }
            store_tileT(RT, DP64, 32 * vb + r, 32 * cb, hh, rr, 1.0f);
        }
        __syncthreads();
        {
            const f32x16 vn = mm64_tile(TM, RT, cb, vb, r, hh, zero16);
            f32x16 vs;
#pragma unroll
            for (int i = 0; i < 16; ++i) vs[i] = vn[i] * GT[192 + 32 * cb + crow_(i, hh)];
            store_tileT(VNT, DP64, 32 * vb + r, 32 * cb, hh, vn, 1.0f);
            store_tileT(VNST, DP64, 32 * vb + r, 32 * cb, hh, vs, 1.0f);
        }
        __syncthreads();
        {
            const f32x16 o = mm64_tile(ATT, VNT, cb, vb, r, hh, O0);
#pragma unroll
            for (int i = 0; i < 16; ++i) {
                const int c = 32 * cb + crow_(i, hh), t = dir ? t0 + 63 - c : t0 + c;
                OUT[(size_t)(m0 + t) * 1024 + h * 128 + 32 * vb + r] = (bf16_t)(pk2(o[i], 0.f) & 0xffffu);
            }
            const float egl = GT[256];
#pragma unroll
            for (int e = 0; e < 2; ++e) {
                f32x16 a = Sacc[e] * egl;
#pragma unroll
                for (int s2 = 0; s2 < 4; ++s2) {
                    const int row = 32 * kb + r, blk = (2 * s2 + hh) ^ ((row >> 3) & 7);
                    a = MFMA32(ldfrag(KNT, row, DP64, 8 * blk), ldfrag(VNST, 32 * (vb0 + e) + r, DP64, 16 * s2 + 8 * hh), a);
                }
                Sacc[e] = a;
            }
        }
        __syncthreads();
    }
    if (sfin) {
        const int lane = tid0 & 63, r = lane & 31, hh = lane >> 5, kb = w0 >> 1, vb0 = 2 * (w0 & 1);
#pragma unroll
        for (int e = 0; e < 2; ++e)
#pragma unroll
            for (int i = 0; i < 16; ++i) sfin[(size_t)(32 * kb + crow_(i, hh)) * 128 + 32 * (vb0 + e) + r] = Sacc[e][i];
    }
#undef DSCAN_LOAD
}
DI void delta_dispatch(LAS unsigned char* lds, int U, const bf16_t* QKV, const float* AB, const float* conv_w, const float* a_log, const float* dt_bias,
                       const float* state, float* news, bf16_t* OF, bf16_t* OB) {
    int b, h, dir, m0, T; const float* s0 = nullptr; float* sf = nullptr;
    if (U < 128) { b = U >> 4; h = (U >> 1) & 7; dir = U & 1; m0 = NPR + b * 2048; T = 2048; s0 = state + (size_t)((b * 2 + dir) * 8 + h) * 16384; }
    else { const int u = U - 128; b = u >> 4; h = (u >> 1) & 7; dir = u & 1; m0 = b * 256; T = 256; sf = news + (size_t)((b * 2 + dir) * 8 + h) * 16384; }
    const float Aexp = __expf(a_log[dir * 8 + h]), dtb = dt_bias[dir * 8 + h];
#ifdef DELTA_SEQ
    delta_unit(lds, QKV, AB, conv_w, Aexp, dtb, m0, T, h, dir, s0, sf, dir ? OB : OF);
#else
    delta_scan_unit(lds, QKV, AB, Aexp, dtb, m0, T, h, dir, s0, sf, dir ? OB : OF);
#endif
}

DI void y_phase(bf16_t* OF, const bf16_t* OB, const bf16_t* Z, int zp, const float* out_norm, int gw, int NGW, int lane) {
    for (int m = gw; m < NTOK; m += NGW) {
        const size_t off = (size_t)m * 1024 + 16 * lane;
        const u32x4 f0 = *(const u32x4*)(OF + off), f1 = *(const u32x4*)(OF + off + 8);
        const u32x4 b0 = *(const u32x4*)(OB + off), b1 = *(const u32x4*)(OB + off + 8);
        const size_t zoff = (size_t)m * zp + 16 * lane;
        const u32x4 z0 = *(const u32x4*)(Z + zoff), z1 = *(const u32x4*)(Z + zoff + 8);
        float o[16], z[16]; float ss = 0.f;
#pragma unroll
        for (int e = 0; e < 4; ++e) {
            o[2 * e] = bflo(f0[e]) + bflo(b0[e]); o[2 * e + 1] = bfhi(f0[e]) + bfhi(b0[e]);
            o[8 + 2 * e] = bflo(f1[e]) + bflo(b1[e]); o[8 + 2 * e + 1] = bfhi(f1[e]) + bfhi(b1[e]);
            z[2 * e] = bflo(z0[e]); z[2 * e + 1] = bfhi(z0[e]); z[8 + 2 * e] = bflo(z1[e]); z[8 + 2 * e + 1] = bfhi(z1[e]);
        }
#pragma unroll
        for (int e = 0; e < 16; ++e) ss += o[e] * o[e];
        ss += __shfl_xor(ss, 1); ss += __shfl_xor(ss, 2); ss += __shfl_xor(ss, 4);
        const float rstd = __builtin_amdgcn_rsqf(ss * (1.0f / 128.0f) + 1e-6f);
        const float* gn = out_norm + ((16 * lane) & 127);
        float y[16];
#pragma unroll
        for (int e = 0; e < 16; ++e) y[e] = o[e] * rstd * gn[e] * siluf_(z[e]);
        u32x4 w0, w1;
        w0.x = pk2(y[0], y[1]); w0.y = pk2(y[2], y[3]); w0.z = pk2(y[4], y[5]); w0.w = pk2(y[6], y[7]);
        w1.x = pk2(y[8], y[9]); w1.y = pk2(y[10], y[11]); w1.z = pk2(y[12], y[13]); w1.w = pk2(y[14], y[15]);
        *(u32x4*)(OF + off) = w0; *(u32x4*)(OF + off + 8) = w1;
    }
}

__global__ void __launch_bounds__(512, 2) fwd_megakernel(Params p) {
    extern __shared__ __attribute__((aligned(16))) unsigned char lds_raw[];
    LAS unsigned char* lds = (LAS unsigned char*)lds_raw;
    cg::grid_group grid = cg::this_grid();
    const int G = gridDim.x, bid = blockIdx.x, NGW = G * 8;
#define IDS() const int tid = opq(threadIdx.x), lane = tid & 63, wave = __builtin_amdgcn_readfirstlane(tid >> 6), gw = bid * 8 + wave; (void)gw; (void)lane; (void)tid
    unsigned char* ws = p.ws;
    float* mod = (float*)(ws + WS_MOD);
    float* Y = p.out + OUT_Y;
    bf16_t* XB = (bf16_t*)(p.out + OUT_Y) + 1024;
    bf16_t* WQKV1 = (bf16_t*)(ws + WS_WQKV1); bf16_t* WZ1 = (bf16_t*)(ws + WS_WZ1); bf16_t* WOUT1 = (bf16_t*)(ws + WS_WOUT1);
    bf16_t* WIN0 = (bf16_t*)(ws + B_WIN0); bf16_t* WOUT0 = (bf16_t*)(ws + B_WOUT0); bf16_t* W1_0 = (bf16_t*)(ws + B_W1_0); bf16_t* W2_0 = (bf16_t*)(ws + B_W2_0);
    bf16_t* H0 = (bf16_t*)(ws + B_H0); bf16_t* Qb = (bf16_t*)(ws + B_Q); bf16_t* KS = (bf16_t*)(ws + B_KS); bf16_t* VTS = (bf16_t*)(ws + B_VTS);
    bf16_t* KP = (bf16_t*)(ws + B_KP); bf16_t* VTP = (bf16_t*)(ws + B_VTP); bf16_t* FF0 = (bf16_t*)(ws + B_FF0);
    bf16_t* QKV1 = (bf16_t*)(ws + B_QKV1); float* AB = (float*)(ws + B_AB); bf16_t* OF = (bf16_t*)(ws + B_OF); bf16_t* OB = (bf16_t*)(ws + B_OB);
    bf16_t* H1 = (bf16_t*)(ws + B_H1); bf16_t* W1_1 = (bf16_t*)(ws + B_W1_1); bf16_t* W2_1 = (bf16_t*)(ws + B_W2_1); bf16_t* H1B = (bf16_t*)(ws + B_H1B);
    bf16_t* Zb = (bf16_t*)(ws + B_Z); bf16_t* FF1 = (bf16_t*)(ws + B_FF1);
    float* Pside = (float*)(ws + B_PS);
    bf16_t* HL = (bf16_t*)(p.out + OUT_Y);
    bf16_t* FFL0 = (bf16_t*)(ws + B_FFL0); bf16_t* FFL1 = (bf16_t*)(ws + B_FFL1);

    unsigned* barw = (unsigned*)(ws + 524288);
    volatile LAS unsigned* bar_st = (volatile LAS unsigned*)(lds + LDS_BYTES - 512);
    if (threadIdx.x < 2) bar_st[threadIdx.x] = 0u;
    if (p.ws == nullptr) grid.sync();
    __syncthreads();
    const XcdBarrier xbar = xcd_barrier_post(barw, bar_st);
#define GSYNC() xcd_barrier(xbar)
#define W2_GEMM(FFb, W2b, modl) do { \
        pg8::Gemm g{FFb, W2b, 4096, 4096, NTOK, 1024, 4096}; \
        EpiRes E{nullptr, nullptr, XB, modl + 5120, Pside, 0}; \
        if (G == 256) { pg8::W2Order S; S.c = bid; S.ntf = 64; pg8::gemm_phase(lds, g, S, E); } \
        else { pg8::StaticOrder S; S.init(NTOK, 1024, G, bid); pg8::gemm_phase(lds, g, S, E); } } while (0)
    {
        IDS();
        LAS float* scr = (LAS float*)(lds + wave * 8704);
        transpose_matrix(p.in[10], 1024, 2304, WIN0, scr, gw, NGW, lane);
        const bool later = (G == 256);
        if (!later) {
        transpose_matrix(p.in[16], 1024, 1024, WOUT0, scr, gw, NGW, lane);
        transpose_matrix(p.in[18], 1024, 4096, W1_0, scr, gw, NGW, lane);
        transpose_matrix(p.in[19], 4096, 1024, W2_0, scr, gw, NGW, lane);
        transpose_matrix(p.in[28], 1024, 1024, WOUT1, scr, gw, NGW, lane);
        }
        if (!later) {
            const float* W = p.in[23]; const int nblk = 129, nitems = 16 * nblk;
            for (int it = gw; it < nitems; it += NGW) { const int kb = it / nblk, nb = it % nblk, n0 = nb * 32;
                if (n0 < 3072) transpose_item(W, 4128, kb * 64, n0, WQKV1, 1024, perm_row32(n0), scr, lane);
                else if (n0 < 4096) transpose_item(W, 4128, kb * 64, n0, WZ1, 1024, perm_row32(n0 - 3072), scr, lane);
                else transpose_item(W, 4128, kb * 64, n0, WQKV1, 1024, 3072, scr, lane); }
            u32x4* zp = (u32x4*)(WQKV1 + (size_t)3104 * 1024); const int nz = 224 * 1024 * 2 / 16;
            for (int i = bid * 512 + tid; i < nz; i += G * 512) zp[i] = (u32x4){0u, 0u, 0u, 0u};
        }
        {
            const float* ck = p.in[3]; const float* cv = p.in[4];
            for (int e = bid * 512 + tid; e < 8 * 256 * 640; e += G * 512) {
                const int b = e / (256 * 640), rem = e % (256 * 640), pp = rem / 640, hd = rem % 640, head = hd >> 6, d = hd & 63, kk = pp & 31;
                const size_t tbase = ((size_t)(b * 10 + head) * 72 + 64 + (pp >> 5)) * 2048;
                KS[tbase + ((d >> 3) * 32 + kk) * 8 + (d & 7)] = (bf16_t)(pk2(ck[e], 0.f) & 0xffffu);
                VTS[tbase + ((((((d >> 5) * 2 + (kk >> 4)) * 2 + ((kk >> 3) & 1)) * 2 + ((kk >> 2) & 1)) * 32 + (d & 31)) << 2) + (kk & 3)] = (bf16_t)(pk2(cv[e], 0.f) & 0xffffu);
            }
        }
        __syncthreads();
        LAS float* sv = (LAS float*)lds;
        LAS float* red = sv + 1024 * 12;
        bool sv_ready = false;
        for (int U = bid; U < 192; U += G) {
            if (!sv_ready) {
                for (int i = tid; i < 9 * 1024; i += 512) { const int r = i >> 10, k = i & 1023; const float x = (r == 0) ? p.in[6][k] : p.in[2][(r - 1) * 1024 + k]; sv[k * 12 + r] = siluf_(x); }
                sv_ready = true; __syncthreads();
            }
            const int l = U / 96, j0 = (U % 96) * 64;
            const float* W = p.in[l ? 20 : 7]; const float* bias = p.in[l ? 21 : 8];
            float a[9];
#pragma unroll
            for (int r = 0; r < 9; ++r) a[r] = 0.f;
            const int kbeg = wave * 128;
#pragma unroll 16
            for (int k = kbeg; k < kbeg + 128; ++k) {
                const float w = W[(size_t)k * MODW + j0 + lane];
                const f32x4 s0 = *(const LAS f32x4*)(sv + k * 12), s1 = *(const LAS f32x4*)(sv + k * 12 + 4); const float s8 = sv[k * 12 + 8];
                a[0] += w * s0.x; a[1] += w * s0.y; a[2] += w * s0.z; a[3] += w * s0.w; a[4] += w * s1.x; a[5] += w * s1.y; a[6] += w * s1.z; a[7] += w * s1.w; a[8] += w * s8;
            }
#pragma unroll
            for (int r = 0; r < 9; ++r) red[(wave * 9 + r) * 64 + lane] = a[r];
            __syncthreads();
            for (int i = tid; i < 576; i += 512) { const int r = i >> 6, c = i & 63; float s = bias[j0 + c];
#pragma unroll
                for (int w = 0; w < 8; ++w) s += red[(w * 9 + r) * 64 + c];
                mod[(size_t)(l * 9 + r) * MODW + j0 + c] = s; }
            __syncthreads();
        }
    }
    GSYNC();

    const float* mod0 = mod; const float* mod1 = mod + 9 * MODW;
    { IDS(); norm_phase(p.in[0], p.in[1], nullptr, p.in[9], mod0 + 0, mod0 + 1024, H0, DM, gw, NGW, lane); }
    GSYNC();
    {
        pg8::Gemm g{H0, WIN0, 1024, 1024, NTOK, 2304, 1024}; pg8::StaticOrder S; S.init(NTOK, 2304, G, bid);
        EpiQKV0 E{Qb, KS, VTS, KP, VTP, p.out + OUT_NEWK, p.out + OUT_NEWV, p.in[11], p.in[12], p.in[13], p.in[14]};
        pg8::gemm_phase(lds, g, S, E);
        if (G == 256 && bid >= 96) {
            IDS();
            LAS float* scr = (LAS float*)(lds + wave * 8704);
            const int gw2 = (bid - 96) * 8 + wave, NGW2 = 160 * 8;
            transpose_matrix(p.in[16], 1024, 1024, WOUT0, scr, gw2, NGW2, lane);
            transpose_matrix(p.in[18], 1024, 4096, W1_0, scr, gw2, NGW2, lane);
            transpose_matrix(p.in[19], 4096, 1024, W2_0, scr, gw2, NGW2, lane);
            transpose_matrix(p.in[28], 1024, 1024, WOUT1, scr, gw2, NGW2, lane);
            const float* W = p.in[23]; const int nblk = 129, nitems = 16 * nblk;
            for (int it = gw2; it < nitems; it += NGW2) { const int kb = it / nblk, nb = it % nblk, n0 = nb * 32;
                if (n0 < 3072) transpose_item(W, 4128, kb * 64, n0, WQKV1, 1024, perm_row32(n0), scr, lane);
                else if (n0 < 4096) transpose_item(W, 4128, kb * 64, n0, WZ1, 1024, perm_row32(n0 - 3072), scr, lane);
                else transpose_item(W, 4128, kb * 64, n0, WQKV1, 1024, 3072, scr, lane); }
            u32x4* zp = (u32x4*)(WQKV1 + (size_t)3104 * 1024); const int nz = 224 * 1024 * 2 / 16;
            for (int i = (bid - 96) * 512 + tid; i < nz; i += 160 * 512) zp[i] = (u32x4){0u, 0u, 0u, 0u};
        }
    }
    GSYNC();
    { IDS();
      LAS float* sbias = (LAS float*)lds;
      for (int i = tid; i < 3720; i += 512) sbias[i] = p.in[15][i];
      __syncthreads();
      attention_phase(Qb, KS, VTS, KP, VTP, sbias, p.in[11], p.in[12], p.in[13], p.in[14], H0, gw, NGW, lane); }
#ifdef PROBE_ATTN
    GSYNC();
    { IDS(); attention_phase(Qb, KS, VTS, KP, VTP, (const LAS float*)lds, p.in[11], p.in[12], p.in[13], p.in[14], H0, gw, NGW, lane); }
#endif
    GSYNC();
    {
        pg8::Gemm g{H0, WOUT0, 1024, 1024, NTOK, 1024, 1024}; pg8::StaticOrder S; S.init(NTOK, 1024, G, bid);
        EpiRes E{p.in[0], p.in[1], XB, mod0 + 2048, nullptr, 0};
        pg8::gemm_phase(lds, g, S, E);
    }
    GSYNC();
    { IDS(); norm_phase(nullptr, nullptr, XB, p.in[17], mod0 + 3072, mod0 + 4096, HL, XBP, gw, NGW, lane); }
    GSYNC();
    {
        pg8::Gemm g{HL, W1_0, XBP, 1024, NTOK, 4096, 1024}; pg8::StaticOrder S; S.init(NTOK, 4096, G, bid);
        EpiBf16<1> E{FFL0, 4096};
        pg8::gemm_phase(lds, g, S, E);
    }
    GSYNC();
    W2_GEMM(FFL0, W2_0, mod0);
    GSYNC();
    { IDS(); norm_phase(nullptr, nullptr, XB, p.in[22], mod1 + 0, mod1 + 1024, H1, DM, gw, NGW, lane, (G == 256) ? Pside : nullptr); }
    GSYNC();
    {
        pg8::Gemm g{H1, WQKV1, 1024, 1024, NTOK, 4352, 1024}; pg8::StaticOrder S; S.init(NTOK, 4352, G, bid);
        EpiQKV1 E{QKV1, AB, HL, XBP, (bf16_t*)(ws + B_HALO)};
        pg8::gemm_phase(lds, g, S, E);
    }
    GSYNC();
    {
#pragma unroll 1
        for (int U = bid; U < 3072; U += G) {
            const int ch = U >> 3, h = U & 7, mrow = ch * 64;
            const int m0 = (mrow < NPR) ? (mrow & ~255) : NPR + ((mrow - NPR) & ~2047), T = (mrow < NPR) ? 256 : 2048;
            delta_prep_unit(lds, QKV1, (const bf16_t*)(ws + B_HALO), AB, p.in[24], p.in[25], p.in[26], m0, T, mrow - m0, h, OF, OB);
        }
    }
    GSYNC();
#ifdef PROBE_DELTA
    for (int rep = 0; rep < 2; ++rep)
#endif
    {
        float* news = p.out + OUT_NEWS;
#ifdef PROBE_DELTA
        if (rep) GSYNC();
#endif
        const bool bal = (G == 256);
        const int nun = bal ? (bid < 128 ? 1 : 4) : (640 - bid + G - 1) / G;
#pragma unroll 1
        for (int i = 0; i < nun; ++i) {
            const int U = bal ? (bid < 128 ? bid : 128 + (bid - 128) * 4 + i) : bid + i * G;
            delta_dispatch(lds, U, QKV1, AB, p.in[24], p.in[25], p.in[26], p.in[5], news, OF, OB);
        }
    }
    GSYNC();
    if (G != 256) {
        IDS();
        LAS float* scr = (LAS float*)(lds + wave * 8704);
        transpose_matrix(p.in[30], 1024, 4096, W1_1, scr, gw, NGW, lane);
        transpose_matrix(p.in[31], 4096, 1024, W2_1, scr, gw, NGW, lane);
    }
    { IDS(); y_phase(OF, OB, HL, XBP, p.in[27], gw, NGW, lane); }
    GSYNC();
    {
        pg8::Gemm g{OF, WOUT1, 1024, 1024, NTOK, 1024, 1024}; pg8::StaticOrder S; S.init(NTOK, 1024, G, bid);
        EpiRes E{nullptr, nullptr, XB, mod1 + 2048, nullptr, 0};
        pg8::gemm_phase(lds, g, S, E);
        if (G == 256 && bid >= 128) {
            IDS();
            LAS float* scr = (LAS float*)(lds + wave * 8704);
            const int gw2 = (bid - 128) * 8 + wave, NGW2 = 128 * 8;
            transpose_matrix(p.in[30], 1024, 4096, W1_1, scr, gw2, NGW2, lane);
            transpose_matrix(p.in[31], 4096, 1024, W2_1, scr, gw2, NGW2, lane);
        }
    }
    GSYNC();
    { IDS(); norm_phase(nullptr, nullptr, XB, p.in[29], mod1 + 3072, mod1 + 4096, HL, XBP, gw, NGW, lane); }
    GSYNC();
    {
        pg8::Gemm g{HL, W1_1, XBP, 1024, NTOK, 4096, 1024}; pg8::StaticOrder S; S.init(NTOK, 4096, G, bid);
        EpiBf16<1> E{FFL1, 4096};
        pg8::gemm_phase(lds, g, S, E);
    }
    GSYNC();
    W2_GEMM(FFL1, W2_1, mod1);
    {
        GSYNC();
        IDS();
        const bool fold = (G == 256);
        for (int m = gw; m < NTOK; m += NGW) {
            const bf16_t* xr = XB + (size_t)m * XBP + 16 * lane;
            const u32x4 w0 = *(const u32x4*)xr, w1 = *(const u32x4*)(xr + 8);
            f32x4 o[4] = {(f32x4){bflo(w0.x), bfhi(w0.x), bflo(w0.y), bfhi(w0.y)}, (f32x4){bflo(w0.z), bfhi(w0.z), bflo(w0.w), bfhi(w0.w)},
                          (f32x4){bflo(w1.x), bfhi(w1.x), bflo(w1.y), bfhi(w1.y)}, (f32x4){bflo(w1.z), bfhi(w1.z), bflo(w1.w), bfhi(w1.w)}};
            if (fold && m >= 16384) {
#pragma unroll
                for (int j = 0; j < 4; ++j) o[j] = o[j] + *(const f32x4*)(Pside + (size_t)(m - 16384) * DM + 16 * lane + 4 * j);
            }
            asm volatile("s_waitcnt vmcnt(0)" ::: "memory");
#pragma unroll
            for (int j = 0; j < 4; ++j) *(f32x4*)(Y + (size_t)m * DM + 16 * lane + 4 * j) = o[j];
        }
    }
}

extern "C" void kernel_launch(void* const* d_in, const int* in_sizes, int n_in, void* d_out, int out_size, void* d_ws, size_t ws_size, hipStream_t stream) {
    static int grid_blocks = 0;
    if (!grid_blocks) {
        if (n_in != 32 || ws_size < WS_NEED) { fprintf(stderr, "kernel_launch: unexpected n_in %d / ws_size %zu (need %zu)\n", n_in, ws_size, (size_t)WS_NEED); grid_blocks = -1; return; }
        int dev = 0, cus = 0, per_cu = 0;
        hipGetDevice(&dev);
        hipDeviceGetAttribute(&cus, hipDeviceAttributeMultiprocessorCount, dev);
        hipFuncSetAttribute((const void*)fwd_megakernel, hipFuncAttributeMaxDynamicSharedMemorySize, LDS_BYTES);
        hipOccupancyMaxActiveBlocksPerMultiprocessor(&per_cu, (const void*)fwd_megakernel, 512, LDS_BYTES);
        if (per_cu < 1) { fprintf(stderr, "kernel_launch: occupancy query returned %d\n", per_cu); per_cu = 1; }
        grid_blocks = cus * per_cu;
    }
    if (grid_blocks < 0) return;
    Params p{};
    for (int i = 0; i < 32; ++i) p.in[i] = (const float*)d_in[i];
    p.out = (float*)d_out; p.ws = (unsigned char*)d_ws;
    if (hipMemsetAsync((char*)d_ws + 524288, 0, XCD_BAR_WORDS * 4, stream) != hipSuccess) { fprintf(stderr, "kernel_launch: memset of barrier words failed\n"); return; }
    void* args[] = {&p};
    hipError_t e = hipLaunchCooperativeKernel((const void*)fwd_megakernel, dim3(grid_blocks), dim3(512), args, LDS_BYTES, stream);
    if (e != hipSuccess) fprintf(stderr, "cooperative launch failed: %s (grid %d)\n", hipGetErrorString(e), grid_blocks);
}
```

```cpp
#include <hip/hip_runtime.h>
#include <hip/hip_cooperative_groups.h>
#include <cstdio>
namespace cg = cooperative_groups;

#define LAS __attribute__((address_space(3)))
#define DI __device__ __forceinline__
typedef unsigned short bf16_t;
typedef short bf16x8 __attribute__((ext_vector_type(8)));
typedef short s16x4 __attribute__((ext_vector_type(4)));
typedef float f32x2 __attribute__((ext_vector_type(2)));
typedef float f32x4 __attribute__((ext_vector_type(4)));
typedef float f32x16 __attribute__((ext_vector_type(16)));
typedef unsigned u32x2 __attribute__((ext_vector_type(2)));
typedef unsigned u32x4 __attribute__((ext_vector_type(4)));
typedef __bf16 nbf16x2 __attribute__((ext_vector_type(2)));

DI unsigned pk2(float a, float b) { f32x2 v = {a, b}; nbf16x2 r = __builtin_convertvector(v, nbf16x2); return __builtin_bit_cast(unsigned, r); }
DI float bf2f(unsigned short h) { return __builtin_bit_cast(float, (unsigned)h << 16); }
DI float bflo(unsigned w) { return __builtin_bit_cast(float, w << 16); }
DI float bfhi(unsigned w) { return __builtin_bit_cast(float, w & 0xffff0000u); }
DI float sigmoidf_(float x) { return __builtin_amdgcn_rcpf(1.0f + __expf(-x)); }
DI float siluf_(float x) { return x * __builtin_amdgcn_rcpf(1.0f + __expf(-x)); }
DI int opq(int x) { asm volatile("" : "+v"(x)); return x; }

constexpr int NTOK = 24576, NPR = 8192, DM = 1024;
constexpr int MODW = 6144;
constexpr size_t OUT_Y = 0, OUT_NEWK = 25165824, OUT_NEWV = OUT_NEWK + 5242880, OUT_NEWS = OUT_NEWV + 5242880;
constexpr size_t WS_MOD = 0;
constexpr size_t WS_WQKV1 = 1048576;
constexpr size_t WS_WZ1 = WS_WQKV1 + 3328ull * 1024 * 2;
constexpr size_t WS_WOUT1 = WS_WZ1 + 1024ull * 1024 * 2;
constexpr size_t WS_BIG = WS_WOUT1 + 1024ull * 1024 * 2;
constexpr size_t B_WIN0 = WS_BIG, B_WOUT0 = B_WIN0 + 2304ull * 1024 * 2, B_W1_0 = B_WOUT0 + 1024ull * 1024 * 2, B_W2_0 = B_W1_0 + 4096ull * 1024 * 2;
constexpr size_t B_H0 = B_W2_0 + 4096ull * 1024 * 2;
constexpr size_t B_Q = B_H0 + (size_t)NTOK * 1024 * 2;
constexpr size_t B_KS = B_Q + (size_t)NTOK * 1024 * 2;
constexpr size_t B_VTS = B_KS + 8ull * 2304 * 640 * 2;
constexpr size_t B_KP = B_VTS + 8ull * 2304 * 640 * 2;
constexpr size_t B_VTP = B_KP + 8192ull * 640 * 2;
constexpr size_t B_FF0 = B_Q;
constexpr size_t B_QKV1 = WS_BIG;
constexpr size_t B_AB = B_QKV1 + (size_t)NTOK * 3072 * 2;
constexpr size_t B_OF = B_AB + (size_t)NTOK * 32 * 4;
constexpr size_t B_OB = B_OF + (size_t)NTOK * 1024 * 2;
constexpr size_t B_H1 = B_OF;
constexpr size_t B_W1_1 = WS_BIG, B_W2_1 = B_W1_1 + 4096ull * 1024 * 2;
constexpr size_t B_H1B = B_W2_1 + 4096ull * 1024 * 2;
constexpr size_t B_Z = B_H1B + (size_t)NTOK * 1024 * 2;
constexpr size_t B_FF1 = B_Z;
constexpr size_t B_FFL0 = B_H0, B_FFL1 = B_H1B;
constexpr size_t B_PS = B_FFL0 + (size_t)NTOK * 4096 * 2;
constexpr size_t B_HALO = B_OB + (size_t)NTOK * 1024 * 2;
constexpr size_t WS_NEED = (B_PS + 8192ull * 1024 * 4 > B_HALO + 384ull * 2 * 3072 * 2) ? B_PS + 8192ull * 1024 * 4 : B_HALO + 384ull * 2 * 3072 * 2;
static_assert(WS_NEED <= 271868064ull, "ws budget (halo)");
static_assert(B_FFL1 + (size_t)NTOK * 4096 * 2 <= B_PS && B_OB + (size_t)NTOK * 1024 * 2 <= WS_NEED, "ws map (mlp)");
static_assert(B_VTP + 8192ull * 640 * 2 <= WS_NEED && B_FF0 + (size_t)NTOK * 2048 * 2 <= WS_NEED && B_FF1 + (size_t)NTOK * 2048 * 2 <= WS_NEED, "ws map");
static_assert(B_Z + (size_t)NTOK * 1024 * 2 <= B_AB, "z inside dead qkv region");
static_assert(WS_NEED <= 271868064ull, "ws budget");

constexpr int LDS_BYTES = 151552;

struct Params { const float* in[32]; float* out; unsigned char* ws; };

namespace pg8 {
constexpr int BM = 256, BK = 64, HALF = 128, HTB = HALF * BK * 2, STAGE_BYTES = 8 * HTB, NXCD = 8, WGM = 8;
DI int lds_byte(int r, int c) { const int st = (r >> 4) * 2 + (c >> 5), rr = r & 15, cc = c & 31, ob = rr * 64 + cc * 2; return st * 1024 + (ob ^ (((ob >> 9) & 1) << 5)); }
DI void stage_rc(int b, int& R, int& C) { const int st = b / 1024, sb = b % 1024, swz = sb ^ (((sb >> 9) & 1) << 5); R = (st >> 1) * 16 + swz / 64; C = (st & 1) * 32 + (swz % 64) / 2; }
struct Unit { int pm, pn, kofs, nt, mode; };
struct Gemm { const bf16_t* A; const bf16_t* Bt; int lda, ldb, M, N, K; };
struct StaticOrder {
    int nM, nN, nwg, G, c;
    DI void init(int M, int N, int G_, int c_) { nM = M / BM; nN = N / BM; nwg = nM * nN; G = G_; c = c_; }
    DI bool next(int i, Unit& u) const {
        const long L = (long)i * G + c; if (L >= nwg) return false;
        int wgid = (int)L; { const int q = nwg / NXCD, r = nwg % NXCD, xcd = wgid % NXCD, off = wgid / NXCD; wgid = (xcd < r ? xcd * (q + 1) : r * (q + 1) + (xcd - r) * q) + off; }
        const int nig = WGM * nN, gid = wgid / nig, fm = gid * WGM, gsz = (nM - fm) < WGM ? (nM - fm) : WGM;
        u.pm = fm + ((wgid % nig) % gsz); u.pn = (wgid % nig) / gsz; u.kofs = 0; u.nt = 0; u.mode = 0; return true;
    }
};

struct W2Order { int c, ntf;
    DI bool next(int i, Unit& u) const {
        const int x = c & 7, j = c >> 3;
        if (i == 0) { u.pm = 8 * x + (j >> 2); u.pn = j & 3; u.kofs = 0; u.nt = ntf; u.mode = 0; return true; }
        if (i == 1) { const int st = j >> 1; u.pm = 64 + 4 * x + (st >> 2); u.pn = st & 3; u.kofs = (j & 1) * (ntf * 32); u.nt = ntf / 2; u.mode = j & 1; return true; }
        return false; } };

template <class Epi, class Sched>
DI void gemm_phase(LAS unsigned char* lds, const Gemm g, const Sched& S, const Epi& E) {
    const int tid = opq(threadIdx.x), wid = __builtin_amdgcn_readfirstlane(tid >> 6), lane = tid & 63, wr = wid >> 2, wc = wid & 3, fr = lane & 15, fq = lane >> 4;
    const int K = g.K;
    unsigned voffA[2], voffB[2];
#pragma unroll
    for (int i = 0; i < 2; ++i) { int R, C; stage_rc(tid * 16 + i * 8192, R, C);
        voffA[i] = (unsigned)(R * g.lda + C) * 2u; voffB[i] = (unsigned)(R * g.ldb + C) * 2u; }
    const size_t kstep = (size_t)(BK * 2);
    const size_t hstepA = (size_t)HALF * g.lda * 2, hstepB = (size_t)HALF * g.ldb * 2;
    const size_t tstepA = 2 * hstepA, tstepB = 2 * hstepB;
    const unsigned ldsw = (unsigned)wid * 1024u;
    const int aoff = lds_byte(wr * 64 + fr, fq * 8), boff = lds_byte(wc * 32 + fr, fq * 8);
#define PG8_SA(b, h) (((b) * 2 + (h)) * HTB)
#define PG8_SB(b, h) ((4 + (b) * 2 + (h)) * HTB)
#define PG8_STAGE(bufoff, gbase, voff) do { _Pragma("unroll") for (int _i = 0; _i < 2; ++_i) \
        __builtin_amdgcn_global_load_lds((const unsigned*)((const char*)(gbase) + (voff)[_i]), (LAS unsigned*)(lds + (bufoff) + ldsw + _i * 8192), 16, 0, 0); } while (0)
#define PG8_LDA(dst, b, h) do { _Pragma("unroll") for (int m = 0; m < 4; ++m) _Pragma("unroll") for (int k = 0; k < 2; ++k) dst[m][k] = *(const LAS bf16x8*)(lds + PG8_SA(b, h) + aoff + m * 2048 + k * 1024); } while (0)
#define PG8_LDB(dst, b, h) do { _Pragma("unroll") for (int n = 0; n < 2; ++n) _Pragma("unroll") for (int k = 0; k < 2; ++k) dst[n][k] = *(const LAS bf16x8*)(lds + PG8_SB(b, h) + boff + n * 2048 + k * 1024); } while (0)
#define PG8_MMA(ai, bj, At, Bt) do { __builtin_amdgcn_s_setprio(1); _Pragma("unroll") for (int m = 0; m < 4; ++m) _Pragma("unroll") for (int n = 0; n < 2; ++n) _Pragma("unroll") for (int k = 0; k < 2; ++k) \
        acc[ai][bj][m][n] = __builtin_amdgcn_mfma_f32_16x16x32_bf16(Bt[n][k], At[m][k], acc[ai][bj][m][n], 0, 0, 0); __builtin_amdgcn_s_setprio(0); } while (0)
#define PG8_WAIT_V(n) asm volatile("s_waitcnt vmcnt(" #n ")" ::: "memory")
#define PG8_WAIT_L(n) asm volatile("s_waitcnt lgkmcnt(" #n ")" ::: "memory")
#define PG8_BAR __builtin_amdgcn_s_barrier()
#define PG8_SCHED __builtin_amdgcn_sched_barrier(0)
    Unit cur, nxt; int ui = 0;
    if (!S.next(0, cur)) return;
    if (cur.nt == 0) cur.nt = K / BK;
    f32x4 acc[2][2][4][2];
#pragma unroll
    for (int a = 0; a < 2; ++a)
#pragma unroll
        for (int b = 0; b < 2; ++b)
#pragma unroll
            for (int m = 0; m < 4; ++m)
#pragma unroll
                for (int n = 0; n < 2; ++n) acc[a][b][m][n] = (f32x4){0.f, 0.f, 0.f, 0.f};
    bf16x8 At[4][2], B0[2][2], B1[2][2];
    const char* cA = (const char*)g.A + (size_t)cur.pm * tstepA + (size_t)cur.kofs * 2; const char* cB = (const char*)g.Bt + (size_t)cur.pn * tstepB + (size_t)cur.kofs * 2;
    PG8_STAGE(PG8_SB(0, 0), cB, voffB); PG8_STAGE(PG8_SB(0, 1), cB + hstepB, voffB); PG8_STAGE(PG8_SA(0, 0), cA, voffA); PG8_STAGE(PG8_SA(0, 1), cA + hstepA, voffA);
    if (wr == 1) PG8_BAR;
    PG8_WAIT_V(2); PG8_BAR;
    PG8_STAGE(PG8_SB(1, 0), cB + kstep, voffB); PG8_STAGE(PG8_SA(1, 0), cA + kstep, voffA); PG8_STAGE(PG8_SB(1, 1), cB + hstepB + kstep, voffB);
    PG8_WAIT_V(6); PG8_BAR;
    for (;;) {
        const bool has_next = S.next(ui + 1, nxt);
        if (has_next && nxt.nt == 0) nxt.nt = K / BK;
        const char* nA = has_next ? (const char*)g.A + (size_t)nxt.pm * tstepA + (size_t)nxt.kofs * 2 : cA; const char* nB = has_next ? (const char*)g.Bt + (size_t)nxt.pn * tstepB + (size_t)nxt.kofs * 2 : cB;
        const int nt = cur.nt;
        for (int t = 0; t < nt; t += 2) {
            const bool last = (t == nt - 2);
            const char* a1 = cA + (size_t)(t + 1) * kstep;
            const char* a2 = last ? nA : cA + (size_t)(t + 2) * kstep; const char* b2 = last ? nB : cB + (size_t)(t + 2) * kstep;
            const char* a3 = a2 + kstep; const char* b3 = b2 + kstep;
            PG8_LDB(B0, 0, 0); PG8_LDB(B1, 0, 1); PG8_SCHED; PG8_LDA(At, 0, 0); PG8_STAGE(PG8_SA(1, 1), a1 + hstepA, voffA);
            PG8_WAIT_V(8); PG8_WAIT_L(0); PG8_BAR; PG8_MMA(0, 0, At, B0); PG8_MMA(0, 1, At, B1); PG8_BAR; PG8_SCHED;
            PG8_LDA(At, 0, 1); PG8_STAGE(PG8_SB(0, 0), b2, voffB); PG8_STAGE(PG8_SB(0, 1), b2 + hstepB, voffB); PG8_STAGE(PG8_SA(0, 0), a2, voffA);
            PG8_WAIT_V(8); PG8_WAIT_L(0); PG8_BAR; PG8_MMA(1, 0, At, B0); PG8_MMA(1, 1, At, B1); PG8_BAR; PG8_SCHED;
            PG8_LDB(B0, 1, 0); PG8_LDB(B1, 1, 1); PG8_SCHED; PG8_LDA(At, 1, 0); PG8_STAGE(PG8_SA(0, 1), a2 + hstepA, voffA);
            PG8_WAIT_V(8); PG8_WAIT_L(0); PG8_BAR; PG8_MMA(0, 0, At, B0); PG8_MMA(0, 1, At, B1); PG8_BAR; PG8_SCHED;
            PG8_LDA(At, 1, 1); PG8_STAGE(PG8_SB(1, 0), b3, voffB); PG8_STAGE(PG8_SB(1, 1), b3 + hstepB, voffB); PG8_STAGE(PG8_SA(1, 0), a3, voffA);
            PG8_WAIT_V(8); PG8_WAIT_L(0); PG8_BAR; PG8_MMA(1, 0, At, B0); PG8_MMA(1, 1, At, B1); PG8_BAR; PG8_SCHED;
        }
        if (wr == 0) PG8_BAR;
        E(acc, cur, wr, wc, fr, fq);
        if (!has_next) break;
#pragma unroll
        for (int a = 0; a < 2; ++a)
#pragma unroll
            for (int b = 0; b < 2; ++b)
#pragma unroll
                for (int m = 0; m < 4; ++m)
#pragma unroll
                    for (int n = 0; n < 2; ++n) acc[a][b][m][n] = (f32x4){0.f, 0.f, 0.f, 0.f};
        cur = nxt; cA = nA; cB = nB; ++ui;
        if (wr == 1) PG8_BAR;
    }
    PG8_WAIT_V(0);
    PG8_BAR;
#undef PG8_SA
#undef PG8_SB
#undef PG8_STAGE
#undef PG8_LDA
#undef PG8_LDB
#undef PG8_MMA
#undef PG8_WAIT_V
#undef PG8_WAIT_L
#undef PG8_BAR
#undef PG8_SCHED
}
}
using pg8::Unit;

#define XB_TMO      128
#define XB_XCNT(j)  (256  + 64 * (j))
#define XB_XSUB(j)  (1280 + 64 * (j))
#define XB_XGEN(j)  (2304 + 64 * (j))
#define XB_TOP      3328
#define XB_TOPGEN   3392
#define XCD_BAR_WORDS 3456
#define XB_SPIN_CAP (1u << 18)

__device__ __forceinline__ unsigned xb_ld(unsigned* p)              { return __hip_atomic_load(p, __ATOMIC_RELAXED, __HIP_MEMORY_SCOPE_AGENT); }
__device__ __forceinline__ unsigned xb_add(unsigned* p, unsigned v) { return __hip_atomic_fetch_add(p, v, __ATOMIC_RELAXED, __HIP_MEMORY_SCOPE_AGENT); }
__device__ __forceinline__ unsigned xb_xcc_id() { return (unsigned)__builtin_amdgcn_s_getreg((3 << 11) | 20) & 0xFu; }
#define XB_SPIN(cond, bar) do { unsigned _sp = 0; while (cond) { __builtin_amdgcn_s_sleep(1); \
    if ((++_sp & 255u) == 0u) { if (xb_ld(&(bar)[XB_TMO])) break; if (_sp > XB_SPIN_CAP) { atomicAdd(&(bar)[XB_TMO], 1u); break; } } } } while (0)

struct XcdBarrier {
    unsigned* bar; unsigned x;
    volatile LAS unsigned* st;
};

__device__ __forceinline__ XcdBarrier xcd_barrier_post(unsigned* bar, volatile LAS unsigned* st) {
    XcdBarrier b; b.bar = bar; b.x = xb_xcc_id(); b.st = st;
    if (threadIdx.x == 0) (void)xb_add(&bar[XB_XCNT(b.x)], 1u);
    return b;
}
__device__ __forceinline__ void xcd_barrier_complete(unsigned* bar, unsigned x, unsigned& nloc, unsigned& nx) {
    const unsigned G = gridDim.x * gridDim.y * gridDim.z;
    unsigned sum, cnt, mine, sp = 0u;
    for (;;) {
        sum = 0u; cnt = 0u; mine = 0u;
#pragma unroll
        for (unsigned j = 0; j < 16; ++j) { const unsigned c = xb_ld(&bar[XB_XCNT(j)]); sum += c; cnt += (c > 0u) ? 1u : 0u; mine = (j == x) ? c : mine; }
        if (sum == G) break;
        __builtin_amdgcn_s_sleep(1);
        if ((++sp & 255u) == 0u) { if (xb_ld(&bar[XB_TMO])) break; if (sp > XB_SPIN_CAP) { atomicAdd(&bar[XB_TMO], 1u); break; } }
    }
    nloc = mine > 0u ? mine : 1u; nx = cnt > 0u ? cnt : 1u;
}

__device__ __forceinline__ void xcd_barrier(const XcdBarrier& b) {
    asm volatile("s_waitcnt vmcnt(0)" ::: "memory");
    __syncthreads();
    if (threadIdx.x == 0) {
        unsigned* bar = b.bar;
        __builtin_amdgcn_s_waitcnt(0);
        unsigned nloc = b.st[0], nx = b.st[1];
        if (nloc == 0u) { xcd_barrier_complete(bar, b.x, nloc, nx); b.st[0] = nloc; b.st[1] = nx; }
        const unsigned old = xb_add(&bar[XB_XSUB(b.x)], 1u);
        const unsigned gen = old / nloc;
        if (old + 1u == (gen + 1u) * nloc) {
            __builtin_amdgcn_fence(__ATOMIC_RELEASE, "agent");
            asm volatile("s_waitcnt vmcnt(0)" ::: "memory");
            const unsigned og = xb_add(&bar[XB_TOP], 1u);
            const unsigned tg = og / nx;
            if (og + 1u == (tg + 1u) * nx) xb_add(&bar[XB_TOPGEN], 1u);
            else XB_SPIN(xb_ld(&bar[XB_TOPGEN]) == tg, bar);
            __builtin_amdgcn_fence(__ATOMIC_ACQUIRE, "agent");
            xb_add(&bar[XB_XGEN(b.x)], 1u);
            asm volatile("s_waitcnt vmcnt(0)" ::: "memory");
        } else {
            XB_SPIN(xb_ld(&bar[XB_XGEN(b.x)]) == gen, bar);
            __builtin_amdgcn_fence(__ATOMIC_ACQUIRE, "agent");
            asm volatile("s_waitcnt vmcnt(0)" ::: "memory");
        }
    }
    __syncthreads();
}


DI int mod_row(int pm) { return pm < 32 ? 0 : 1 + ((pm - 32) >> 3); }

constexpr int XBP = 2048;
struct EpiRes {
    const float* inA; const float* inB; bf16_t* XB; const float* gate;
    float* P; int accum;
    DI void operator()(const f32x4 (&acc)[2][2][4][2], const Unit& u, int wr, int wc, int fr, int fq) const {
        const int col0 = u.pn * 256 + wc * 64 + 4 * fq;
        const float* gp = gate + mod_row(u.pm) * MODW + col0;
        f32x4 gv[2][2];
#pragma unroll
        for (int bj = 0; bj < 2; ++bj)
#pragma unroll
            for (int n = 0; n < 2; ++n) gv[bj][n] = *(const f32x4*)(gp + 32 * bj + 16 * n);
        const int row0 = u.pm * 256 + wr * 64 + fr;
        const float* xin = inA ? ((u.pm < 32) ? inA + (size_t)row0 * DM : inB + (size_t)(row0 - NPR) * DM) : nullptr;
#pragma unroll
        for (int ai = 0; ai < 2; ++ai)
#pragma unroll
            for (int m = 0; m < 4; ++m) {
                const size_t ro = (size_t)(ai * 128 + m * 16) * DM + col0;
                bf16_t* xp = XB + (size_t)(row0 + ai * 128 + m * 16) * XBP + col0;
#pragma unroll
                for (int bj = 0; bj < 2; ++bj)
#pragma unroll
                    for (int n = 0; n < 2; ++n) {
                        if (u.mode == 0) {
                            f32x4 x;
                            if (xin) x = *(const f32x4*)(xin + ro + 32 * bj + 16 * n);
                            else { const u32x2 w = *(const u32x2*)(xp + 32 * bj + 16 * n); x = (f32x4){bflo(w.x), bfhi(w.x), bflo(w.y), bfhi(w.y)}; }
                            x = x + gv[bj][n] * acc[ai][bj][m][n];
                            u32x2 o; o.x = pk2(x.x, x.y); o.y = pk2(x.z, x.w);
                            *(u32x2*)(xp + 32 * bj + 16 * n) = o;
                        } else {
                            f32x4* pp = (f32x4*)(P + (size_t)(row0 - 16384) * DM + ro + 32 * bj + 16 * n);
                            f32x4 v = gv[bj][n] * acc[ai][bj][m][n];
                            if (accum) v = v + *pp;
                            *pp = v;
                        }
                    }
            }
    }
};

template <int ACT> struct EpiBf16 {
    bf16_t* O; int ldc;
    DI void operator()(const f32x4 (&acc)[2][2][4][2], const Unit& u, int wr, int wc, int fr, int fq) const {
        const int col0 = u.pn * 256 + wc * 64 + 4 * fq;
        const int row0 = u.pm * 256 + wr * 64 + fr;
#pragma unroll
        for (int ai = 0; ai < 2; ++ai)
#pragma unroll
            for (int m = 0; m < 4; ++m) {
                bf16_t* op = O + (size_t)(row0 + ai * 128 + m * 16) * ldc + col0;
#pragma unroll
                for (int bj = 0; bj < 2; ++bj)
#pragma unroll
                    for (int n = 0; n < 2; ++n) {
                        f32x4 v = acc[ai][bj][m][n];
                        if (ACT == 1) { v.x = fmaxf(v.x, 0.f); v.y = fmaxf(v.y, 0.f); v.z = fmaxf(v.z, 0.f); v.w = fmaxf(v.w, 0.f); v = v * v; }
                        u32x2 w; w.x = pk2(v.x, v.y); w.y = pk2(v.z, v.w);
                        *(u32x2*)(op + 32 * bj + 16 * n) = w;
                    }
            }
    }
};

struct EpiQKV1 {
    bf16_t* QKV; float* AB; bf16_t* ZL; int zp; bf16_t* HALO;
    DI void operator()(const f32x4 (&acc)[2][2][4][2], const Unit& u, int wr, int wc, int fr, int fq) const {
        asm volatile("" : "+v"(fr), "+v"(fq));
        const int row0 = u.pm * 256 + wr * 64 + fr;
        if (u.pn < 12) {
            const int col0 = u.pn * 256 + wc * 64 + 4 * fq;
#pragma unroll
            for (int ai = 0; ai < 2; ++ai)
#pragma unroll
                for (int m = 0; m < 4; ++m) {
                    bf16_t* op = QKV + (size_t)(row0 + ai * 128 + m * 16) * 3072 + col0;
#pragma unroll
                    for (int bj = 0; bj < 2; ++bj)
#pragma unroll
                        for (int n = 0; n < 2; ++n) {
                            const f32x4 v = acc[ai][bj][m][n];
                            u32x2 w; w.x = pk2(v.x, v.y); w.y = pk2(v.z, v.w);
                            *(u32x2*)(op + 32 * bj + 16 * n) = w;
                            if ((m == 0 && fr == 0) || (m == 3 && fr == 15))
                                *(u32x2*)(HALO + ((size_t)((row0 + ai * 128 + m * 16) >> 6) * 2 + (m == 3 ? 1 : 0)) * 3072 + col0 + 32 * bj + 16 * n) = w;
                        }
                }
        } else if (u.pn > 12) {
            const int col0 = (u.pn - 13) * 256 + wc * 64 + 4 * fq;
#pragma unroll
            for (int ai = 0; ai < 2; ++ai)
#pragma unroll
                for (int m = 0; m < 4; ++m) {
                    bf16_t* op = ZL + (size_t)(row0 + ai * 128 + m * 16) * zp + col0;
#pragma unroll
                    for (int bj = 0; bj < 2; ++bj)
#pragma unroll
                        for (int n = 0; n < 2; ++n) {
                            const f32x4 v = acc[ai][bj][m][n];
                            u32x2 w; w.x = pk2(v.x, v.y); w.y = pk2(v.z, v.w);
                            *(u32x2*)(op + 32 * bj + 16 * n) = w;
                        }
                }
        } else if (wc == 0) {
#pragma unroll
            for (int ai = 0; ai < 2; ++ai)
#pragma unroll
                for (int m = 0; m < 4; ++m) {
                    float* op = AB + (size_t)(row0 + ai * 128 + m * 16) * 32 + 4 * fq;
#pragma unroll
                    for (int n = 0; n < 2; ++n) *(f32x4*)(op + 16 * n) = acc[ai][0][m][n];
                }
        }
    }
};

struct EpiQKV0 {
    bf16_t *Q, *KS, *VTS, *KP, *VTP; float *newk, *newv;
    const float *qna, *kna, *qnb, *knb;
    DI void operator()(const f32x4 (&acc)[2][2][4][2], const Unit& u, int wr, int wc, int fr, int fq) const {
        asm volatile("" : "+v"(fr), "+v"(fq));
        const int pn = u.pn; const bool prompt = u.pm < 32;
        int type, head; const float* gain = qna; bool rope = false;
        if (pn < 2) { type = 0; head = 4 * pn + wc; gain = qna; rope = true; }
        else if (pn == 2) { if (wc < 2) { type = 1; head = wc; gain = kna; rope = true; } else { type = 2; head = wc - 2; } }
        else if (pn < 5) { type = 0; head = 8 + 4 * (pn - 3) + wc; gain = qnb; }
        else if (pn < 7) { type = 1; head = 2 + 4 * (pn - 5) + wc; gain = knb; }
        else { type = 2; head = 2 + 4 * (pn - 7) + wc; }
        rope = rope && !prompt;
        float invf[4];
#pragma unroll
        for (int j = 0; j < 4; ++j) invf[j] = __builtin_amdgcn_exp2f(-(float)(4 * fq + j) * 0.83048202372184059f);
        const int row0 = u.pm * 256 + wr * 64 + fr;
#pragma unroll
        for (int ai = 0; ai < 2; ++ai)
#pragma unroll
            for (int m = 0; m < 4; ++m) {
                const int mg = row0 + ai * 128 + m * 16;
                f32x4 v[2][2];
#pragma unroll
                for (int bj = 0; bj < 2; ++bj)
#pragma unroll
                    for (int n = 0; n < 2; ++n) v[bj][n] = acc[ai][bj][m][n];
                if (type != 2) {
                    float ss = 0.f;
#pragma unroll
                    for (int bj = 0; bj < 2; ++bj)
#pragma unroll
                        for (int n = 0; n < 2; ++n) { const f32x4 x = v[bj][n]; ss += (x.x * x.x + x.y * x.y) + (x.z * x.z + x.w * x.w); }
                    ss += __shfl_xor(ss, 16); ss += __shfl_xor(ss, 32);
                    const float rinv = __builtin_amdgcn_rsqf(ss * (1.0f / 64.0f) + 1e-6f);
#pragma unroll
                    for (int bj = 0; bj < 2; ++bj)
#pragma unroll
                        for (int n = 0; n < 2; ++n) v[bj][n] = v[bj][n] * rinv * *(const f32x4*)(gain + 32 * bj + 16 * n + 4 * fq);
                    if (rope) {
                        const int t = (mg - NPR) & 2047;
                        const float pos[2] = {(float)(t >> 6), (float)(t & 63)};
#pragma unroll
                        for (int bj = 0; bj < 2; ++bj)
#pragma unroll
                            for (int j = 0; j < 4; ++j) {
                                const float ang = pos[bj] * invf[j];
                                const float cs = __cosf(ang), sn = __sinf(ang);
                                const float x1 = v[bj][0][j], x2 = v[bj][1][j];
                                v[bj][0][j] = x1 * cs - x2 * sn; v[bj][1][j] = x2 * cs + x1 * sn;
                            }
                    }
                }
                int b, t, ntile; bf16_t* kbase; bf16_t* vbase;
                if (prompt) { b = mg >> 8; t = mg & 255; ntile = 8; kbase = KP; vbase = VTP; }
                else { b = (mg - NPR) >> 11; t = (mg - NPR) & 2047; ntile = 72; kbase = KS; vbase = VTS; }
                const size_t tbase = ((size_t)(b * 10 + head) * ntile + (t >> 5)) * 2048; const int kk = t & 31;
#pragma unroll
                for (int bj = 0; bj < 2; ++bj)
#pragma unroll
                    for (int n = 0; n < 2; ++n) {
                        const int d0 = 32 * bj + 16 * n + 4 * fq;
                        const f32x4 x = v[bj][n];
                        if (type == 0) { u32x2 w; w.x = pk2(x.x, x.y); w.y = pk2(x.z, x.w); *(u32x2*)(Q + (size_t)mg * 1024 + head * 64 + d0) = w; }
                        else if (type == 1) {
                            u32x2 w; w.x = pk2(x.x, x.y); w.y = pk2(x.z, x.w); *(u32x2*)(kbase + tbase + ((d0 >> 3) * 32 + kk) * 8 + (d0 & 7)) = w;
                            if (prompt) *(f32x4*)(newk + (size_t)mg * 640 + head * 64 + d0) = x;
                        } else {
                            bf16_t* vp = vbase + tbase + ((((((d0 >> 5) * 2 + (kk >> 4)) * 2 + ((kk >> 3) & 1)) * 2 + ((kk >> 2) & 1)) * 32 + (d0 & 31)) << 2) + (kk & 3);
                            const unsigned w0 = pk2(x.x, x.y), w1 = pk2(x.z, x.w);
                            vp[0] = (bf16_t)(w0 & 0xffffu); vp[4] = (bf16_t)(w0 >> 16); vp[8] = (bf16_t)(w1 & 0xffffu); vp[12] = (bf16_t)(w1 >> 16);
                            if (prompt) *(f32x4*)(newv + (size_t)mg * 640 + head * 64 + d0) = x;
                        }
                    }
                asm volatile("" ::: "memory");
            }
    }
};

DI float wave_sum(float v) {
#pragma unroll
    for (int o = 1; o < 64; o <<= 1) v += __shfl_xor(v, o);
    return v;
}
DI int perm_row32(int n0) { return (n0 & ~255) + 128 * ((n0 >> 5) & 1) + 32 * ((n0 >> 6) & 3); }

DI void transpose_item(const float* W, int N, int k0, int n0, bf16_t* WT, int ldt, int row0, LAS float* scr, int lane) {
#pragma unroll 8
    for (int i = 0; i < 32; ++i) { const int kk = 2 * i + (lane >> 5); scr[kk * 33 + (lane & 31)] = W[(size_t)(k0 + kk) * N + n0 + (lane & 31)]; }
    asm volatile("s_waitcnt lgkmcnt(0)" ::: "memory");
    const int c = lane & 7;
#pragma unroll
    for (int j = 0; j < 4; ++j) { const int n = (lane >> 3) + 8 * j; const LAS float* s = scr + (8 * c) * 33 + n;
        u32x4 o; o.x = pk2(s[0 * 33], s[1 * 33]); o.y = pk2(s[2 * 33], s[3 * 33]); o.z = pk2(s[4 * 33], s[5 * 33]); o.w = pk2(s[6 * 33], s[7 * 33]);
        *(u32x4*)(WT + (size_t)(row0 + n) * ldt + k0 + 8 * c) = o; }
    asm volatile("s_waitcnt lgkmcnt(0)" ::: "memory");
}
DI void transpose_matrix(const float* W, int K, int N, bf16_t* WT, LAS float* scr, int gw, int NGW, int lane) {
    const int nblk = N / 32, nitems = (K / 64) * nblk;
    for (int it = gw; it < nitems; it += NGW) { const int kb = it / nblk, nb = it % nblk; transpose_item(W, N, kb * 64, nb * 32, WT, K, perm_row32(nb * 32), scr, lane); }
}

DI void norm_phase(const float* xa, const float* xb, bf16_t* XB, const float* gain, const float* sh, const float* sc, bf16_t* H, int hp, int gw, int NGW, int lane, const float* P = nullptr) {
    for (int m0 = gw; m0 < NTOK; m0 += 2 * NGW) {
        const int m1 = m0 + NGW; const bool has1 = m1 < NTOK; const int m1c = has1 ? m1 : m0;
        f32x4 v0[4], v1[4];
        if (XB) {
#pragma unroll
            for (int j = 0; j < 4; ++j) {
                const u32x2 w0 = *(const u32x2*)(XB + (size_t)m0 * XBP + 4 * lane + 256 * j), w1 = *(const u32x2*)(XB + (size_t)m1c * XBP + 4 * lane + 256 * j);
                v0[j] = (f32x4){bflo(w0.x), bfhi(w0.x), bflo(w0.y), bfhi(w0.y)}; v1[j] = (f32x4){bflo(w1.x), bfhi(w1.x), bflo(w1.y), bfhi(w1.y)};
            }
        } else {
            const float* xr0 = (m0 < NPR) ? xa + (size_t)m0 * DM : xb + (size_t)(m0 - NPR) * DM;
            const float* xr1 = (m1c < NPR) ? xa + (size_t)m1c * DM : xb + (size_t)(m1c - NPR) * DM;
#pragma unroll
            for (int j = 0; j < 4; ++j) { v0[j] = *(const f32x4*)(xr0 + 4 * lane + 256 * j); v1[j] = *(const f32x4*)(xr1 + 4 * lane + 256 * j); }
        }
        if (P) {
#pragma unroll
            for (int j = 0; j < 4; ++j) {
                if (m0 >= 16384) { v0[j] = v0[j] + *(const f32x4*)(P + (size_t)(m0 - 16384) * DM + 4 * lane + 256 * j);
                    u32x2 o; o.x = pk2(v0[j].x, v0[j].y); o.y = pk2(v0[j].z, v0[j].w); *(u32x2*)(XB + (size_t)m0 * XBP + 4 * lane + 256 * j) = o; }
                if (has1 && m1 >= 16384) { v1[j] = v1[j] + *(const f32x4*)(P + (size_t)(m1 - 16384) * DM + 4 * lane + 256 * j);
                    u32x2 o; o.x = pk2(v1[j].x, v1[j].y); o.y = pk2(v1[j].z, v1[j].w); *(u32x2*)(XB + (size_t)m1 * XBP + 4 * lane + 256 * j) = o; }
            }
        }
        float s0 = 0.f, s1 = 0.f;
#pragma unroll
        for (int j = 0; j < 4; ++j) { s0 += (v0[j].x * v0[j].x + v0[j].y * v0[j].y) + (v0[j].z * v0[j].z + v0[j].w * v0[j].w); s1 += (v1[j].x * v1[j].x + v1[j].y * v1[j].y) + (v1[j].z * v1[j].z + v1[j].w * v1[j].w); }
        const float r0 = __builtin_amdgcn_rsqf(wave_sum(s0) * (1.0f / DM) + 1e-6f), r1 = __builtin_amdgcn_rsqf(wave_sum(s1) * (1.0f / DM) + 1e-6f);
        const int mr0 = (m0 < NPR) ? 0 : 1 + ((m0 - NPR) >> 11), mr1 = (m1c < NPR) ? 0 : 1 + ((m1c - NPR) >> 11);
#pragma unroll
        for (int j = 0; j < 4; ++j) {
            const int c = 4 * lane + 256 * j;
            const f32x4 g = *(const f32x4*)(gain + c);
            { const f32x4 a = *(const f32x4*)(sc + mr0 * MODW + c), b = *(const f32x4*)(sh + mr0 * MODW + c);
              const f32x4 o = v0[j] * r0 * g * (a + 1.0f) + b; u32x2 w; w.x = pk2(o.x, o.y); w.y = pk2(o.z, o.w); *(u32x2*)(H + (size_t)m0 * hp + c) = w; }
            if (has1) { const f32x4 a = *(const f32x4*)(sc + mr1 * MODW + c), b = *(const f32x4*)(sh + mr1 * MODW + c);
              const f32x4 o = v1[j] * r1 * g * (a + 1.0f) + b; u32x2 w; w.x = pk2(o.x, o.y); w.y = pk2(o.z, o.w); *(u32x2*)(H + (size_t)m1 * hp + c) = w; }
        }
    }
}

#define MFMA32(a, b, c) __builtin_amdgcn_mfma_f32_32x32x16_bf16((a), (b), (c), 0, 0, 0)
template <int NH, bool NA>
DI void attn_unit(const bf16_t* Qrow, const bf16_t* Kp, const bf16_t* VTp, int vstride,
                  int seg0_start, int seg0_tiles, int seg1_start, int seg1_tiles,
                  const LAS float* biasH, int qr, int c0, float shift, bf16_t* Orow, int lane) {
    const int r = lane & 31, hh = lane >> 5;
    bf16x8 Qf[NH][4];
#pragma unroll
    for (int h = 0; h < NH; ++h)
#pragma unroll
        for (int s = 0; s < 4; ++s) Qf[h][s] = *(const bf16x8*)(Qrow + (size_t)r * 1024 + 64 * h + 16 * s + 8 * hh);
    f32x16 O[NH][2]; float mrun[NH], lrun[NH];
#pragma unroll
    for (int h = 0; h < NH; ++h) { mrun[h] = -1e30f; lrun[h] = 0.f;
#pragma unroll
        for (int b = 0; b < 2; ++b)
#pragma unroll
            for (int i = 0; i < 16; ++i) O[h][b][i] = 0.f; }
    const float SC = 0.125f * 1.4426950408889634f;
    const int ntiles = seg0_tiles + seg1_tiles;
    bf16x8 Kn[4]; s16x4 Vln[2][2], Vhn[2][2];
    {
        const int k0 = seg0_tiles > 0 ? seg0_start : seg1_start;
        const bf16_t* kt = Kp + (size_t)(k0 >> 5) * 2048; const bf16_t* vt = VTp + (size_t)(k0 >> 5) * 2048;
#pragma unroll
        for (int s = 0; s < 4; ++s) Kn[s] = *(const bf16x8*)(kt + (s * 64 + lane) * 8);
#pragma unroll
        for (int b = 0; b < 2; ++b)
#pragma unroll
            for (int s = 0; s < 2; ++s) { Vln[b][s] = *(const s16x4*)(vt + (((b * 2 + s) * 2 + 0) * 64 + lane) * 4); Vhn[b][s] = *(const s16x4*)(vt + (((b * 2 + s) * 2 + 1) * 64 + lane) * 4); }
    }
    for (int ti = 0; ti < ntiles; ++ti) {
        const bool loc = ti < seg0_tiles;
        const int k0 = loc ? seg0_start + 32 * ti : seg1_start + 32 * (ti - seg0_tiles);
        bf16x8 Kf[4]; s16x4 Vlo[2][2], Vhi[2][2];
#pragma unroll
        for (int s = 0; s < 4; ++s) Kf[s] = Kn[s];
#pragma unroll
        for (int b = 0; b < 2; ++b)
#pragma unroll
            for (int s = 0; s < 2; ++s) { Vlo[b][s] = Vln[b][s]; Vhi[b][s] = Vhn[b][s]; }
        {
            const int tn = min(ti + 1, ntiles - 1);
            const int k1 = (tn < seg0_tiles) ? seg0_start + 32 * tn : seg1_start + 32 * (tn - seg0_tiles);
            const bf16_t* kt = Kp + (size_t)(k1 >> 5) * 2048; const bf16_t* vt = VTp + (size_t)(k1 >> 5) * 2048;
#pragma unroll
            for (int s = 0; s < 4; ++s) Kn[s] = *(const bf16x8*)(kt + (s * 64 + lane) * 8);
#pragma unroll
            for (int b = 0; b < 2; ++b)
#pragma unroll
                for (int s = 0; s < 2; ++s) { Vln[b][s] = *(const s16x4*)(vt + (((b * 2 + s) * 2 + 0) * 64 + lane) * 4); Vhn[b][s] = *(const s16x4*)(vt + (((b * 2 + s) * 2 + 1) * 64 + lane) * 4); }
        }
#pragma unroll
        for (int h = 0; h < NH; ++h) {
            f32x16 st;
#pragma unroll
            for (int i = 0; i < 16; ++i) st[i] = 0.f;
#pragma unroll
            for (int s = 0; s < 4; ++s) st = MFMA32(Kf[s], Qf[h][s], st);
            float ps = 0.f;
            if (NA && loc) {
                const int c = c0 + r, cs = min(max(c - 8, 0), 48);
                const int d0 = (k0 & 63) + 4 * hh - cs;
                const int b0 = ((k0 >> 6) - qr + 7) * 31 + (cs - c + 15);
#pragma unroll
                for (int i = 0; i < 16; ++i) {
                    const int d = d0 + (i & 3) + 8 * (i >> 2);
                    const bool valid = (unsigned)d < 16u;
                    const float bv = biasH[valid ? b0 + d : 0];
                    const float x = valid ? st[i] * SC - shift + bv * 1.4426950408889634f : -1e30f;
                    const float p = __builtin_amdgcn_exp2f(x); st[i] = p; ps += p;
                }
            } else {
#pragma unroll
                for (int i = 0; i < 16; ++i) { const float p = __builtin_amdgcn_exp2f(st[i] * SC - shift); st[i] = p; ps += p; }
            }
            lrun[h] += ps;
#pragma unroll
            for (int s = 0; s < 2; ++s) {
                u32x4 pw; pw.x = pk2(st[8 * s + 0], st[8 * s + 1]); pw.y = pk2(st[8 * s + 2], st[8 * s + 3]); pw.z = pk2(st[8 * s + 4], st[8 * s + 5]); pw.w = pk2(st[8 * s + 6], st[8 * s + 7]);
                const bf16x8 Pf = __builtin_bit_cast(bf16x8, pw);
#pragma unroll
                for (int b = 0; b < 2; ++b) {
                    const bf16x8 Vf = __builtin_shufflevector(Vlo[b][s], Vhi[b][s], 0, 1, 2, 3, 4, 5, 6, 7);
                    O[h][b] = MFMA32(Vf, Pf, O[h][b]);
                }
            }
        }
    }
#pragma unroll
    for (int h = 0; h < NH; ++h) {
        const float lt = lrun[h] + __shfl_xor(lrun[h], 32);
        const float inv = 1.0f / lt;
#pragma unroll
        for (int b = 0; b < 2; ++b)
#pragma unroll
            for (int g = 0; g < 4; ++g) {
                u32x2 w; w.x = pk2(O[h][b][4 * g] * inv, O[h][b][4 * g + 1] * inv); w.y = pk2(O[h][b][4 * g + 2] * inv, O[h][b][4 * g + 3] * inv);
                *(u32x2*)(Orow + (size_t)r * 1024 + 64 * h + 32 * b + 8 * g + 4 * hh) = w;
            }
    }
}

DI float wave_max(float v) {
#pragma unroll
    for (int o = 1; o < 64; o <<= 1) v = fmaxf(v, __shfl_xor(v, o));
    return v;
}
DI void attention_phase(const bf16_t* Q, const bf16_t* KS, const bf16_t* VTS, const bf16_t* KP, const bf16_t* VTP, const LAS float* rel_bias, const float* qna, const float* kna, const float* qnb, const float* knb,
                        bf16_t* AO, int gw, int NGW, int lane) {
    const float L2E = 1.4426950408889634f;
    const float shiftA = 8.0f * wave_max(fabsf(qna[lane])) * wave_max(fabsf(kna[lane])) * L2E;
    const float boundB = 8.0f * wave_max(fabsf(qnb[lane])) * wave_max(fabsf(knb[lane]));
    float bm = 0.f;
    for (int i = lane; i < 3720; i += 64) bm = fmaxf(bm, fabsf(rel_bias[i]));
    const float shiftB = boundB * L2E, shiftN = (boundB + wave_max(bm)) * L2E;
    for (int U = gw; U < 9216; U += NGW) {
        if (U < 2048) {
            const int u = U, b = u >> 8, kv = (u >> 7) & 1, gp = (u >> 6) & 1, qt = u & 63;
            const int m0 = NPR + b * 2048 + qt * 32, qc = (kv * 4 + gp * 2) * 64;
            attn_unit<2, false>(Q + (size_t)m0 * 1024 + qc, KS + (size_t)(b * 10 + kv) * 72 * 2048, VTS + (size_t)(b * 10 + kv) * 72 * 2048, 2304, 0, 72, 0, 0, nullptr, 0, 0, shiftA, AO + (size_t)m0 * 1024 + qc, lane);
        } else if (U < 6144) {
            const int u = U - 2048, b = u >> 9, h = (u >> 6) & 7, qt = u & 63, qr = qt >> 1, c0 = (qt & 1) * 32;
            const int m0 = NPR + b * 2048 + qt * 32, qc = 512 + h * 64;
            const int rs = min(max(qr - 4, 0), 24);
            attn_unit<1, true>(Q + (size_t)m0 * 1024 + qc, KS + (size_t)(b * 10 + 2 + h) * 72 * 2048, VTS + (size_t)(b * 10 + 2 + h) * 72 * 2048, 2304, rs * 64, 16, 2048, 8, rel_bias + h * 465, qr, c0, shiftN, AO + (size_t)m0 * 1024 + qc, lane);
        } else if (U < 7168) {
            const int u = U - 6144, b = u >> 5, kv = (u >> 4) & 1, gp = (u >> 3) & 1, qt = u & 7;
            const int m0 = b * 256 + qt * 32, qc = (kv * 4 + gp * 2) * 64;
            attn_unit<2, false>(Q + (size_t)m0 * 1024 + qc, KP + (size_t)(b * 10 + kv) * 8 * 2048, VTP + (size_t)(b * 10 + kv) * 8 * 2048, 256, 0, 8, 0, 0, nullptr, 0, 0, shiftA, AO + (size_t)m0 * 1024 + qc, lane);
        } else {
            const int u = U - 7168, b = u >> 6, h = (u >> 3) & 7, qt = u & 7;
            const int m0 = b * 256 + qt * 32, qc = 512 + h * 64;
            attn_unit<1, false>(Q + (size_t)m0 * 1024 + qc, KP + (size_t)(b * 10 + 2 + h) * 8 * 2048, VTP + (size_t)(b * 10 + 2 + h) * 8 * 2048, 256, 0, 8, 0, 0, nullptr, 0, 0, shiftB, AO + (size_t)m0 * 1024 + qc, lane);
        }
    }
}

DI float quad_sum(float x) {
    x += __builtin_bit_cast(float, __builtin_amdgcn_mov_dpp(__builtin_bit_cast(int, x), 0xB1, 0xF, 0xF, true));
    x += __builtin_bit_cast(float, __builtin_amdgcn_mov_dpp(__builtin_bit_cast(int, x), 0x4E, 0xF, 0xF, true));
    return x;
}
DI void delta_unit(LAS unsigned char* lds, const bf16_t* QKV, const float* AB, const float* conv_w, float Aexp, float dtb,
                   int m0, int T, int h, int dir, const float* s0  , float* sfin  , bf16_t* OUT) {
    const int tid = opq(threadIdx.x), wid = tid >> 6, lane = tid & 63, kq = lane & 3, vl = lane >> 2, v = 16 * wid + vl;
    LAS float* sQ = (LAS float*)lds; LAS float* sK = sQ + 32 * 128; LAS float* sV = sK + 32 * 128; LAS float* sA = sV + 32 * 128; LAS float* sB = sA + 32;
    float S[32];
#pragma unroll
    for (int i = 0; i < 32; ++i) S[i] = s0 ? s0[(size_t)(kq * 32 + i) * 128 + v] : 0.f;
    const int nblk = T / 32;
    for (int blk = 0; blk < nblk; ++blk) {
        const int t0 = (dir ? nblk - 1 - blk : blk) * 32;
        {
            const int tl = tid >> 4, cg = tid & 15, t = t0 + tl;
#pragma unroll
            for (int part = 0; part < 3; ++part) {
                const int col = part * 1024 + h * 128 + cg * 8;
                const bf16_t* base = QKV + (size_t)(m0 + t) * 3072 + col;
                u32x4 xm = {0u, 0u, 0u, 0u}, xp = {0u, 0u, 0u, 0u};
                const u32x4 x0 = *(const u32x4*)base;
                if (t > 0) xm = *(const u32x4*)(base - 3072);
                if (t < T - 1) xp = *(const u32x4*)(base + 3072);
                float o[8];
#pragma unroll
                for (int e = 0; e < 4; ++e) {
                    const f32x2 w0 = *(const f32x2*)(conv_w + col + 2 * e), w1 = *(const f32x2*)(conv_w + 3072 + col + 2 * e), w2 = *(const f32x2*)(conv_w + 6144 + col + 2 * e);
                    const float a0 = w0.x * bflo(xm[e]) + w1.x * bflo(x0[e]) + w2.x * bflo(xp[e]);
                    const float a1 = w0.y * bfhi(xm[e]) + w1.y * bfhi(x0[e]) + w2.y * bfhi(xp[e]);
                    o[2 * e] = siluf_(a0); o[2 * e + 1] = siluf_(a1);
                }
                LAS float* dst = (part == 0 ? sQ : (part == 1 ? sK : sV)) + tl * 128 + cg * 8;
                *(LAS f32x4*)dst = (f32x4){o[0], o[1], o[2], o[3]}; *(LAS f32x4*)(dst + 4) = (f32x4){o[4], o[5], o[6], o[7]};
            }
        }
        __syncthreads();
        {
            const int row = tid >> 3, sub = tid & 7;
            LAS float* p = (row < 32 ? sQ + row * 128 : sK + (row - 32) * 128) + sub * 16;
            f32x4 x[4]; float ss = 0.f;
#pragma unroll
            for (int i = 0; i < 4; ++i) { x[i] = *(LAS f32x4*)(p + 4 * i); ss += (x[i].x * x[i].x + x[i].y * x[i].y) + (x[i].z * x[i].z + x[i].w * x[i].w); }
            ss += __shfl_xor(ss, 1); ss += __shfl_xor(ss, 2); ss += __shfl_xor(ss, 4);
            const float sc = __builtin_amdgcn_rsqf(ss + 1e-6f) * (row < 32 ? 0.08838834764831845f : 1.0f);
#pragma unroll
            for (int i = 0; i < 4; ++i) *(LAS f32x4*)(p + 4 * i) = x[i] * sc;
            if (tid < 32) {
                const float* ab = AB + (size_t)(m0 + t0 + tid) * 32 + dir * 8 + h;
                const float xa = ab[0] + dtb, xb = ab[16];
                const float sp = xa > 20.f ? xa : log1pf(__expf(xa));
                sA[tid] = __expf(-Aexp * sp); sB[tid] = sigmoidf_(xb);
            }
        }
        __syncthreads();
        for (int i = 0; i < 32; ++i) {
            const int tl = dir ? 31 - i : i;
            const LAS float* kp = sK + tl * 128 + kq * 32; const LAS float* qp = sQ + tl * 128 + kq * 32;
            const float a = sA[tl], b = sB[tl], vt = sV[tl * 128 + v];
            f32x4 kk[8];
#pragma unroll
            for (int j = 0; j < 8; ++j) kk[j] = *(const LAS f32x4*)(kp + 4 * j);
            float ks = 0.f;
#pragma unroll
            for (int j = 0; j < 8; ++j) ks += (kk[j].x * S[4 * j] + kk[j].y * S[4 * j + 1]) + (kk[j].z * S[4 * j + 2] + kk[j].w * S[4 * j + 3]);
            ks = quad_sum(ks);
            const float d = b * (vt - a * ks);
            f32x4 qq[8];
#pragma unroll
            for (int j = 0; j < 8; ++j) qq[j] = *(const LAS f32x4*)(qp + 4 * j);
            float os = 0.f;
#pragma unroll
            for (int j = 0; j < 8; ++j) {
                S[4 * j] = a * S[4 * j] + kk[j].x * d; S[4 * j + 1] = a * S[4 * j + 1] + kk[j].y * d; S[4 * j + 2] = a * S[4 * j + 2] + kk[j].z * d; S[4 * j + 3] = a * S[4 * j + 3] + kk[j].w * d;
                os += (qq[j].x * S[4 * j] + qq[j].y * S[4 * j + 1]) + (qq[j].z * S[4 * j + 2] + qq[j].w * S[4 * j + 3]);
            }
            os = quad_sum(os);
            if (kq == 0) OUT[(size_t)(m0 + t0 + tl) * 1024 + h * 128 + v] = (bf16_t)(pk2(os, 0.f) & 0xffffu);
        }
        __syncthreads();
    }
    if (sfin) {
#pragma unroll
        for (int i = 0; i < 32; ++i) sfin[(size_t)(kq * 32 + i) * 128 + v] = S[i];
    }
}


constexpr int DP128 = 136, DP64 = 72;
constexpr int DL_QN = 0, DL_KN = 17408, DL_KNT = 34816, DL_VT = 53248, DL_ST = 71680, DL_ATT = 106496, DL_TM = 115712, DL_RT = 124928, DL_GATE = 143360;
constexpr int DL_AL1 = DL_KNT, DL_AL2 = DL_KNT + 9216, DL_TDT = DL_VT, DL_P1T = DL_VT + 9216, DL_T1 = DL_ST, DL_T1T = DL_ST + 9216, DL_AD = DL_ST + 18432;
constexpr int DL_VNT = DL_QN, DL_VNST = DL_VT, DL_CW = DL_GATE + 2048;
static_assert(DL_CW + 4608 <= LDS_BYTES, "delta LDS map");

DI int crow_(int i, int hh) { return (i & 3) + 8 * (i >> 2) + 4 * hh; }
DI bf16x8 ldfrag(const LAS bf16_t* base, int row, int pitch, int koff) { return *(const LAS bf16x8*)(base + row * pitch + koff); }
DI void store_tileT(LAS bf16_t* XT, int pitch, int col, int row0, int hh, const f32x16& a, float sc) {
#pragma unroll
    for (int g = 0; g < 4; ++g) { u32x2 w; w.x = pk2(a[4 * g] * sc, a[4 * g + 1] * sc); w.y = pk2(a[4 * g + 2] * sc, a[4 * g + 3] * sc);
        *(LAS u32x2*)(XT + col * pitch + row0 + 8 * g + 4 * hh) = w; }
}
DI void store_tileR(LAS bf16_t* X, int pitch, int col, int row0, int hh, const f32x16& a) {
#pragma unroll
    for (int i = 0; i < 16; ++i) X[(row0 + crow_(i, hh)) * pitch + col] = (bf16_t)(pk2(a[i], 0.f) & 0xffffu);
}
DI f32x16 mm64_tile(const LAS bf16_t* A, const LAS bf16_t* BT, int ib, int jb, int r, int hh, f32x16 acc) {
#pragma unroll
    for (int s = 0; s < 4; ++s) acc = MFMA32(ldfrag(A, 32 * ib + r, DP64, 16 * s + 8 * hh), ldfrag(BT, 32 * jb + r, DP64, 16 * s + 8 * hh), acc);
    return acc;
}

#ifdef PROBE_D1
#define REP_D1 _Pragma("unroll 1") for (int rep_ = 0; rep_ < 2; ++rep_)
#else
#define REP_D1
#endif
#ifdef PROBE_D3
#define REP_D3 _Pragma("unroll 1") for (int rep_ = 0; rep_ < 2; ++rep_)
#else
#define REP_D3
#endif
#ifdef PROBE_D6
#define REP_D6 _Pragma("unroll 1") for (int rep_ = 0; rep_ < 2; ++rep_)
#else
#define REP_D6
#endif
DI void delta_unit_chunked(LAS unsigned char* lds, const bf16_t* QKV, const float* AB, const float* conv_w, float Aexp, float dtb,
                           int m0, int T, int h, int dir, const float* s0, float* sfin, bf16_t* OUT) {
    const int tid0 = opq(threadIdx.x), w0 = __builtin_amdgcn_readfirstlane(tid0 >> 6);
    LAS bf16_t* QN = (LAS bf16_t*)(lds + DL_QN); LAS bf16_t* KN = (LAS bf16_t*)(lds + DL_KN); LAS bf16_t* KNT = (LAS bf16_t*)(lds + DL_KNT); LAS bf16_t* VT = (LAS bf16_t*)(lds + DL_VT);
    LAS bf16_t* ST = (LAS bf16_t*)(lds + DL_ST); LAS bf16_t* ATT = (LAS bf16_t*)(lds + DL_ATT); LAS bf16_t* TM = (LAS bf16_t*)(lds + DL_TM); LAS bf16_t* RT = (LAS bf16_t*)(lds + DL_RT);
    LAS float* GT = (LAS float*)(lds + DL_GATE);
    LAS bf16_t* AL1 = (LAS bf16_t*)(lds + DL_AL1); LAS bf16_t* AL2 = (LAS bf16_t*)(lds + DL_AL2); LAS bf16_t* TDT = (LAS bf16_t*)(lds + DL_TDT); LAS bf16_t* P1T = (LAS bf16_t*)(lds + DL_P1T);
    LAS bf16_t* T1 = (LAS bf16_t*)(lds + DL_T1); LAS bf16_t* T1T = (LAS bf16_t*)(lds + DL_T1T); LAS float* AD = (LAS float*)(lds + DL_AD);
    LAS bf16_t* VNT = (LAS bf16_t*)(lds + DL_VNT); LAS bf16_t* VNST = (LAS bf16_t*)(lds + DL_VNST);
    f32x16 Sacc[2];
    {
        const int lane = tid0 & 63, r = lane & 31, hh = lane >> 5, kb = w0 >> 1, vb0 = 2 * (w0 & 1);
#pragma unroll
        for (int e = 0; e < 2; ++e)
#pragma unroll
            for (int i = 0; i < 16; ++i) Sacc[e][i] = s0 ? s0[(size_t)(32 * kb + crow_(i, hh)) * 128 + 32 * (vb0 + e) + r] : 0.f;
    }
    LAS float* CW = (LAS float*)(lds + DL_CW);
    for (int i = tid0; i < 3 * 384; i += 512) { const int tap = i / 384, pc = i % 384; CW[i] = conv_w[tap * 3072 + (pc >> 7) * 1024 + h * 128 + (pc & 127)]; }
    __syncthreads();
    const int nch = T / 64;
    u32x4 xraw[3][4];
#define DELTA_LOAD_RAW(T0) do { const int tlo_ = (T0) + 2 * (tid0 >> 4), cg_ = tid0 & 15; \
        _Pragma("unroll") for (int part = 0; part < 3; ++part) _Pragma("unroll") for (int k = 0; k < 4; ++k) { \
            const int tt = tlo_ - 1 + k; const bool ok = (tt >= 0) && (tt < T); const int tc = min(max(tt, 0), T - 1); \
            u32x4 v_ = *(const u32x4*)(QKV + (size_t)(m0 + tc) * 3072 + part * 1024 + h * 128 + cg_ * 8); \
            if (!ok) v_ = (u32x4){0u, 0u, 0u, 0u}; xraw[part][k] = v_; } } while (0)
#ifdef DELTA_PREFETCH
    DELTA_LOAD_RAW((dir ? nch - 1 : 0) * 64);
#endif
#pragma unroll 1
    for (int ci = 0; ci < nch; ++ci) {
        const int tid = opq(threadIdx.x), w = __builtin_amdgcn_readfirstlane(tid >> 6), lane = tid & 63, r = lane & 31, hh = lane >> 5;
        const int kb = w >> 1, vb0 = 2 * (w & 1);
        const int t0 = (dir ? nch - 1 - ci : ci) * 64;
        u32x4 kpk[2], vpk[2];
        const int tlo = t0 + 2 * (tid >> 4);
#ifndef DELTA_PREFETCH
        DELTA_LOAD_RAW(t0);
#endif
        REP_D1 {
        {
            const int cg = tid & 15;
#pragma unroll
            for (int pass = 0; pass < 2; ++pass) {
                const int t = tlo + pass, i = dir ? t0 + 63 - t : t - t0;
                u32x4 pk[3];
#pragma unroll
                for (int part = 0; part < 3; ++part) {
                    const u32x4 xm = xraw[part][pass], x0 = xraw[part][pass + 1], xp = xraw[part][pass + 2];
                    float o[8]; float ss = 0.f;
#pragma unroll
                    for (int e = 0; e < 4; ++e) {
                        const f32x2 w0 = *(const LAS f32x2*)(CW + part * 128 + cg * 8 + 2 * e), w1 = *(const LAS f32x2*)(CW + 384 + part * 128 + cg * 8 + 2 * e), w2 = *(const LAS f32x2*)(CW + 768 + part * 128 + cg * 8 + 2 * e);
                        const float a0 = w0.x * bflo(xm[e]) + w1.x * bflo(x0[e]) + w2.x * bflo(xp[e]);
                        const float a1 = w0.y * bfhi(xm[e]) + w1.y * bfhi(x0[e]) + w2.y * bfhi(xp[e]);
                        o[2 * e] = siluf_(a0); o[2 * e + 1] = siluf_(a1);
                        ss += o[2 * e] * o[2 * e] + o[2 * e + 1] * o[2 * e + 1];
                    }
                    float sc = 1.0f;
                    if (part < 2) {
                        ss += __shfl_xor(ss, 1); ss += __shfl_xor(ss, 2); ss += __shfl_xor(ss, 4); ss += __shfl_xor(ss, 8);
                        sc = __builtin_amdgcn_rsqf(ss + 1e-6f) * (part == 0 ? 0.08838834764831845f : 1.0f);
                    }
                    pk[part].x = pk2(o[0] * sc, o[1] * sc); pk[part].y = pk2(o[2] * sc, o[3] * sc); pk[part].z = pk2(o[4] * sc, o[5] * sc); pk[part].w = pk2(o[6] * sc, o[7] * sc);
                }
                *(LAS u32x4*)(QN + i * DP128 + cg * 8) = pk[0];
                *(LAS u32x4*)(KN + i * DP128 + cg * 8) = pk[1];
                kpk[pass] = pk[1]; vpk[pass] = pk[2];
            }
        }
#ifdef DELTA_PREFETCH
        if (ci + 1 < nch) DELTA_LOAD_RAW((dir ? nch - 2 - ci : ci + 1) * 64);
#endif
        if (w == 0) {
            const int t = dir ? t0 + 63 - lane : t0 + lane;
            const float* ab = AB + (size_t)(m0 + t) * 32 + dir * 8 + h;
            const float xa = ab[0] + dtb, xb = ab[16];
            const float sp = xa > 20.f ? xa : log1pf(__expf(xa));
            float g = -Aexp * sp;
#pragma unroll
            for (int off = 1; off < 64; off <<= 1) { const float tmp = __shfl_up(g, off); if (lane >= off) g += tmp; }
            const float gl = __shfl(g, 63);
            GT[lane] = g; GT[64 + lane] = sigmoidf_(xb); GT[128 + lane] = __expf(g); GT[192 + lane] = __expf(gl - g);
            if (lane == 0) GT[256] = __expf(gl);
        }
        for (int i = tid; i < 64 * DP64 / 2; i += 512) { ((LAS unsigned*)TM)[i] = 0u; ((LAS unsigned*)TDT)[i] = 0u; }
        __syncthreads();
        }
        REP_D3 {
        {
            const int mat = w >> 2, ib = (w >> 1) & 1, jb = w & 1;
            f32x16 acc;
#pragma unroll
            for (int i = 0; i < 16; ++i) acc[i] = 0.f;
            if (ib >= jb) {
                const LAS bf16_t* X = mat ? QN : KN;
#pragma unroll
                for (int s = 0; s < 8; ++s) acc = MFMA32(ldfrag(X, 32 * ib + r, DP128, 16 * s + 8 * hh), ldfrag(KN, 32 * jb + r, DP128, 16 * s + 8 * hh), acc);
            }
            const int col = 32 * jb + r; const float gc = GT[col];
#pragma unroll
            for (int i = 0; i < 16; ++i) {
                const int row = 32 * ib + crow_(i, hh);
                const float dg = (row >= col) ? __expf(GT[row] - gc) : 0.f;
                if (mat == 0) {
                    const float a = (row > col) ? GT[64 + row] * acc[i] * dg : 0.f;
                    const bool same16 = (row >> 4) == (col >> 4), same32 = (row >> 5) == (col >> 5);
                    if (same16) AD[((row >> 4) * 16 + (row & 15)) * 20 + (col & 15)] = a;
                    AL1[row * DP64 + col] = (bf16_t)(pk2((same32 && !same16) ? a : 0.f, 0.f) & 0xffffu);
                    AL2[row * DP64 + col] = (bf16_t)(pk2(!same32 ? a : 0.f, 0.f) & 0xffffu);
                } else {
                    ATT[row * DP64 + col] = (bf16_t)(pk2((row >= col) ? acc[i] * dg : 0.f, 0.f) & 0xffffu);
                }
            }
        }
        __syncthreads();
        if (w == 0) {
            const int b = lane >> 4, c = lane & 15;
            const LAS float* ad = AD + b * 16 * 20;
            float X[16];
#pragma unroll
            for (int i = 0; i < 16; ++i) {
                float x = (i == c) ? 1.f : 0.f;
#pragma unroll
                for (int j4 = 0; j4 < (i + 3) / 4; ++j4) {
                    const f32x4 a = *(const LAS f32x4*)(ad + i * 20 + 4 * j4);
                    if (4 * j4 + 0 < i) x -= a.x * X[4 * j4 + 0];
                    if (4 * j4 + 1 < i) x -= a.y * X[4 * j4 + 1];
                    if (4 * j4 + 2 < i) x -= a.z * X[4 * j4 + 2];
                    if (4 * j4 + 3 < i) x -= a.w * X[4 * j4 + 3];
                }
                X[i] = x;
            }
#pragma unroll
            for (int i = 0; i < 16; ++i) TM[(16 * b + i) * DP64 + 16 * b + c] = (bf16_t)(pk2(X[i], 0.f) & 0xffffu);
#pragma unroll
            for (int g = 0; g < 4; ++g) { u32x2 wv; wv.x = pk2(X[4 * g], X[4 * g + 1]); wv.y = pk2(X[4 * g + 2], X[4 * g + 3]);
                *(LAS u32x2*)(TDT + (16 * b + c) * DP64 + 16 * b + 4 * g) = wv; }
        }
        __syncthreads();
        }
        const int ib5 = (w >> 1) & 1, jb5 = w & 1;
        f32x16 zero16;
#pragma unroll
        for (int i = 0; i < 16; ++i) zero16[i] = 0.f;
        if (w < 4) { const f32x16 p1 = mm64_tile(AL1, TDT, ib5, jb5, r, hh, zero16); store_tileT(P1T, DP64, 32 * jb5 + r, 32 * ib5, hh, p1, -1.0f); }
        __syncthreads();
        if (w < 4) {
            f32x16 c0;
#pragma unroll
            for (int i = 0; i < 16; ++i) c0[i] = bf2f(TM[(32 * ib5 + crow_(i, hh)) * DP64 + 32 * jb5 + r]);
            const f32x16 t1 = mm64_tile(TM, P1T, ib5, jb5, r, hh, c0);
            store_tileR(T1, DP64, 32 * jb5 + r, 32 * ib5, hh, t1); store_tileT(T1T, DP64, 32 * jb5 + r, 32 * ib5, hh, t1, 1.0f);
        }
        __syncthreads();
        if (w < 4) { const f32x16 p3 = mm64_tile(AL2, T1T, ib5, jb5, r, hh, zero16); store_tileT(P1T, DP64, 32 * jb5 + r, 32 * ib5, hh, p3, -1.0f); }
        __syncthreads();
        if (w < 4) {
            f32x16 c0;
#pragma unroll
            for (int i = 0; i < 16; ++i) c0[i] = bf2f(T1[(32 * ib5 + crow_(i, hh)) * DP64 + 32 * jb5 + r]);
            const f32x16 tt = mm64_tile(T1, P1T, ib5, jb5, r, hh, c0);
            store_tileR(TM, DP64, 32 * jb5 + r, 32 * ib5, hh, tt);
        }
        __syncthreads();
        const int cb = w >> 2, vb = w & 3;
        f32x16 O0;
        REP_D6 {
        {
            const int cg = tid & 15;
#pragma unroll
            for (int pass = 0; pass < 2; ++pass) {
                const int t = tlo + pass, i = dir ? t0 + 63 - t : t - t0;
#pragma unroll
                for (int e = 0; e < 4; ++e) {
                    const int ci_ = (((i >> 3) ^ (cg & 7)) << 3) + (i & 7);
                    KNT[(cg * 8 + 2 * e) * DP64 + ci_] = (bf16_t)(kpk[pass][e] & 0xffffu); KNT[(cg * 8 + 2 * e + 1) * DP64 + ci_] = (bf16_t)(kpk[pass][e] >> 16);
                    VT[(cg * 8 + 2 * e) * DP64 + ci_] = (bf16_t)(vpk[pass][e] & 0xffffu); VT[(cg * 8 + 2 * e + 1) * DP64 + ci_] = (bf16_t)(vpk[pass][e] >> 16);
                }
            }
#pragma unroll
            for (int e = 0; e < 2; ++e) store_tileT(ST, DP128, 32 * (vb0 + e) + r, 32 * kb, hh, Sacc[e], 1.0f);
        }
        __syncthreads();
        {
            f32x16 ks = zero16, qs = zero16;
#pragma unroll
            for (int s = 0; s < 8; ++s) {
                const bf16x8 sf = ldfrag(ST, 32 * vb + r, DP128, 16 * s + 8 * hh);
                ks = MFMA32(ldfrag(KN, 32 * cb + r, DP128, 16 * s + 8 * hh), sf, ks);
                qs = MFMA32(ldfrag(QN, 32 * cb + r, DP128, 16 * s + 8 * hh), sf, qs);
            }
            f32x16 rr;
#pragma unroll
            for (int g = 0; g < 4; ++g) {
                const u32x2 vv = *(const LAS u32x2*)(VT + (32 * vb + r) * DP64 + (((4 * cb + g) ^ ((r >> 3) & 3) ^ ((vb & 1) << 2)) << 3) + 4 * hh);
                const float v4[4] = {bflo(vv.x), bfhi(vv.x), bflo(vv.y), bfhi(vv.y)};
#pragma unroll
                for (int j = 0; j < 4; ++j) {
                    const int c = 32 * cb + 8 * g + 4 * hh + j; const float eg = GT[128 + c];
                    rr[4 * g + j] = GT[64 + c] * (v4[j] - eg * ks[4 * g + j]);
                    O0[4 * g + j] = eg * qs[4 * g + j];
                }
            }
            store_tileT(RT, DP64, 32 * vb + r, 32 * cb, hh, rr, 1.0f);
        }
        __syncthreads();
        }
        {
            const f32x16 vn = mm64_tile(TM, RT, cb, vb, r, hh, zero16);
            f32x16 vs;
#pragma unroll
            for (int i = 0; i < 16; ++i) vs[i] = vn[i] * GT[192 + 32 * cb + crow_(i, hh)];
            store_tileT(VNT, DP64, 32 * vb + r, 32 * cb, hh, vn, 1.0f);
            store_tileT(VNST, DP64, 32 * vb + r, 32 * cb, hh, vs, 1.0f);
        }
        __syncthreads();
        {
            const f32x16 o = mm64_tile(ATT, VNT, cb, vb, r, hh, O0);
#pragma unroll
            for (int i = 0; i < 16; ++i) {
                const int c = 32 * cb + crow_(i, hh), t = dir ? t0 + 63 - c : t0 + c;
                OUT[(size_t)(m0 + t) * 1024 + h * 128 + 32 * vb + r] = (bf16_t)(pk2(o[i], 0.f) & 0xffffu);
            }
            const float egl = GT[256];
#pragma unroll
            for (int e = 0; e < 2; ++e) {
                f32x16 a = Sacc[e] * egl;
#pragma unroll
                for (int s2 = 0; s2 < 4; ++s2) {
                    const int row = 32 * kb + r, blk = (2 * s2 + hh) ^ ((row >> 3) & 7);
                    a = MFMA32(ldfrag(KNT, row, DP64, 8 * blk), ldfrag(VNST, 32 * (vb0 + e) + r, DP64, 16 * s2 + 8 * hh), a);
                }
                Sacc[e] = a;
            }
        }
        __syncthreads();
    }
    if (sfin) {
        const int lane = tid0 & 63, r = lane & 31, hh = lane >> 5, kb = w0 >> 1, vb0 = 2 * (w0 & 1);
#pragma unroll
        for (int e = 0; e < 2; ++e)
#pragma unroll
            for (int i = 0; i < 16; ++i) sfin[(size_t)(32 * kb + crow_(i, hh)) * 128 + 32 * (vb0 + e) + r] = Sacc[e][i];
    }
}

DI void delta_gates_load(const float* AB, int m0, int t0, int h, int dir, int lane, float& xa, float& xb) {
    const int t = dir ? t0 + 63 - lane : t0 + lane;
    const float* ab = AB + (size_t)(m0 + t) * 32 + dir * 8 + h;
    xa = ab[0]; xb = ab[16];
}
DI void delta_gates_compute(LAS float* GT, float xa_raw, float xb, float Aexp, float dtb, int lane) {
    const float xa = xa_raw + dtb;
    const float sp = xa > 20.f ? xa : log1pf(__expf(xa));
    float g = -Aexp * sp;
#pragma unroll
    for (int off = 1; off < 64; off <<= 1) { const float tmp = __shfl_up(g, off); if (lane >= off) g += tmp; }
    const float gl = __shfl(g, 63);
    GT[lane] = g; GT[64 + lane] = sigmoidf_(xb); GT[128 + lane] = __expf(g); GT[192 + lane] = __expf(gl - g);
    if (lane == 0) GT[256] = __expf(gl);
}

DI void delta_prep_unit(LAS unsigned char* lds, bf16_t* QKV, const bf16_t* HALO, const float* AB, const float* conv_w, const float* a_log, const float* dt_bias,
                        int m0, int T, int t0, int h, bf16_t* OF, bf16_t* OB) {
    const int tid = opq(threadIdx.x);
    LAS bf16_t* QN = (LAS bf16_t*)(lds + DL_QN); LAS bf16_t* KN = (LAS bf16_t*)(lds + DL_KN);
    LAS bf16_t* ATT = (LAS bf16_t*)(lds + DL_ATT); LAS bf16_t* TM = (LAS bf16_t*)(lds + DL_TM);
    LAS bf16_t* AL1 = (LAS bf16_t*)(lds + DL_AL1); LAS bf16_t* AL2 = (LAS bf16_t*)(lds + DL_AL2); LAS bf16_t* TDT = (LAS bf16_t*)(lds + DL_TDT); LAS bf16_t* P1T = (LAS bf16_t*)(lds + DL_P1T);
    LAS bf16_t* T1 = (LAS bf16_t*)(lds + DL_T1); LAS bf16_t* T1T = (LAS bf16_t*)(lds + DL_T1T); LAS float* AD = (LAS float*)(lds + DL_AD);
    LAS float* CW = (LAS float*)(lds + DL_CW);
    for (int i = tid; i < 3 * 384; i += 512) { const int tap = i / 384, pc = i % 384; CW[i] = conv_w[tap * 3072 + (pc >> 7) * 1024 + h * 128 + (pc & 127)]; }
    const int wt = __builtin_amdgcn_readfirstlane(tid >> 6);
    float gxa = 0.f, gxb = 0.f;
    if (wt < 2) delta_gates_load(AB, m0, t0, h, wt, tid & 63, gxa, gxb);
    const int cg = tid & 15, tlo = t0 + 2 * (tid >> 4), chg = (m0 + t0) >> 6;
    u32x4 xraw[3][4];
#pragma unroll
    for (int part = 0; part < 3; ++part)
#pragma unroll
        for (int k = 0; k < 4; ++k) {
            const int tt = tlo - 1 + k; const int col = part * 1024 + h * 128 + cg * 8;
            u32x4 v = {0u, 0u, 0u, 0u};
            if (tt < t0) { if (t0 > 0) v = *(const u32x4*)(HALO + ((size_t)(chg - 1) * 2 + 1) * 3072 + col); }
            else if (tt >= t0 + 64) { if (t0 + 64 < T) v = *(const u32x4*)(HALO + ((size_t)(chg + 1) * 2 + 0) * 3072 + col); }
            else v = *(const u32x4*)(QKV + (size_t)(m0 + tt) * 3072 + col);
            xraw[part][k] = v;
        }
    if (wt < 2) delta_gates_compute(wt ? (LAS float*)(lds + DL_RT) : (LAS float*)(lds + DL_GATE), gxa, gxb, __expf(a_log[wt * 8 + h]), dt_bias[wt * 8 + h], tid & 63);
    asm volatile("s_waitcnt vmcnt(0)" ::: "memory");
    __syncthreads();
    u32x4 pq[2], pkk[2];
#pragma unroll
    for (int pass = 0; pass < 2; ++pass) {
        const int t = tlo + pass;
        u32x4 pk[3];
#pragma unroll
        for (int part = 0; part < 3; ++part) {
            const u32x4 xm = xraw[part][pass], x0 = xraw[part][pass + 1], xp = xraw[part][pass + 2];
            float o[8]; float ss = 0.f;
#pragma unroll
            for (int e = 0; e < 4; ++e) {
                const f32x2 w0 = *(const LAS f32x2*)(CW + part * 128 + cg * 8 + 2 * e), w1 = *(const LAS f32x2*)(CW + 384 + part * 128 + cg * 8 + 2 * e), w2 = *(const LAS f32x2*)(CW + 768 + part * 128 + cg * 8 + 2 * e);
                const float a0 = w0.x * bflo(xm[e]) + w1.x * bflo(x0[e]) + w2.x * bflo(xp[e]);
                const float a1 = w0.y * bfhi(xm[e]) + w1.y * bfhi(x0[e]) + w2.y * bfhi(xp[e]);
                o[2 * e] = siluf_(a0); o[2 * e + 1] = siluf_(a1);
                ss += o[2 * e] * o[2 * e] + o[2 * e + 1] * o[2 * e + 1];
            }
            float sc = 1.0f;
            if (part < 2) {
                ss += __shfl_xor(ss, 1); ss += __shfl_xor(ss, 2); ss += __shfl_xor(ss, 4); ss += __shfl_xor(ss, 8);
                sc = __builtin_amdgcn_rsqf(ss + 1e-6f) * (part == 0 ? 0.08838834764831845f : 1.0f);
            }
            pk[part].x = pk2(o[0] * sc, o[1] * sc); pk[part].y = pk2(o[2] * sc, o[3] * sc); pk[part].z = pk2(o[4] * sc, o[5] * sc); pk[part].w = pk2(o[6] * sc, o[7] * sc);
            *(u32x4*)(QKV + (size_t)(m0 + t) * 3072 + part * 1024 + h * 128 + cg * 8) = pk[part];
        }
        pq[pass] = pk[0]; pkk[pass] = pk[1];
    }
#pragma unroll 1
    for (int dir = 0; dir < 2; ++dir) {
        const int tid2 = opq(threadIdx.x), w = __builtin_amdgcn_readfirstlane(tid2 >> 6), lane = tid2 & 63, r = lane & 31, hh = lane >> 5;
        LAS float* GT = dir ? (LAS float*)(lds + DL_RT) : (LAS float*)(lds + DL_GATE);
#pragma unroll
        for (int pass = 0; pass < 2; ++pass) {
            const int loc = tlo + pass - t0, i = dir ? 63 - loc : loc;
            *(LAS u32x4*)(QN + i * DP128 + cg * 8) = pq[pass];
            *(LAS u32x4*)(KN + i * DP128 + cg * 8) = pkk[pass];
        }
        for (int i = tid2; i < 64 * DP64 / 2; i += 512) { ((LAS unsigned*)TM)[i] = 0u; ((LAS unsigned*)TDT)[i] = 0u; }
        __syncthreads();
        {
            const int mat = w >> 2, ib = (w >> 1) & 1, jb = w & 1;
            f32x16 acc;
#pragma unroll
            for (int i = 0; i < 16; ++i) acc[i] = 0.f;
            if (ib >= jb) {
                const LAS bf16_t* X = mat ? QN : KN;
#pragma unroll
                for (int s = 0; s < 8; ++s) acc = MFMA32(ldfrag(X, 32 * ib + r, DP128, 16 * s + 8 * hh), ldfrag(KN, 32 * jb + r, DP128, 16 * s + 8 * hh), acc);
            }
            const int col = 32 * jb + r; const float gc = GT[col];
#pragma unroll
            for (int i = 0; i < 16; ++i) {
                const int row = 32 * ib + crow_(i, hh);
                const float dg = (row >= col) ? __expf(GT[row] - gc) : 0.f;
                if (mat == 0) {
                    const float a = (row > col) ? GT[64 + row] * acc[i] * dg : 0.f;
                    const bool same16 = (row >> 4) == (col >> 4), same32 = (row >> 5) == (col >> 5);
                    if (same16) AD[((row >> 4) * 16 + (row & 15)) * 20 + (col & 15)] = a;
                    AL1[row * DP64 + col] = (bf16_t)(pk2((same32 && !same16) ? a : 0.f, 0.f) & 0xffffu);
                    AL2[row * DP64 + col] = (bf16_t)(pk2(!same32 ? a : 0.f, 0.f) & 0xffffu);
                } else {
                    ATT[row * DP64 + col] = (bf16_t)(pk2((row >= col) ? acc[i] * dg : 0.f, 0.f) & 0xffffu);
                }
            }
        }
        __syncthreads();
        if (w == 0) {
            const int b = lane >> 4, c = lane & 15;
            const LAS float* ad = AD + b * 16 * 20;
            float X[16];
#pragma unroll
            for (int i = 0; i < 16; ++i) {
                float x = (i == c) ? 1.f : 0.f;
#pragma unroll
                for (int j4 = 0; j4 < (i + 3) / 4; ++j4) {
                    const f32x4 a = *(const LAS f32x4*)(ad + i * 20 + 4 * j4);
                    if (4 * j4 + 0 < i) x -= a.x * X[4 * j4 + 0];
                    if (4 * j4 + 1 < i) x -= a.y * X[4 * j4 + 1];
                    if (4 * j4 + 2 < i) x -= a.z * X[4 * j4 + 2];
                    if (4 * j4 + 3 < i) x -= a.w * X[4 * j4 + 3];
                }
                X[i] = x;
            }
#pragma unroll
            for (int i = 0; i < 16; ++i) TM[(16 * b + i) * DP64 + 16 * b + c] = (bf16_t)(pk2(X[i], 0.f) & 0xffffu);
#pragma unroll
            for (int g = 0; g < 4; ++g) { u32x2 wv; wv.x = pk2(X[4 * g], X[4 * g + 1]); wv.y = pk2(X[4 * g + 2], X[4 * g + 3]);
                *(LAS u32x2*)(TDT + (16 * b + c) * DP64 + 16 * b + 4 * g) = wv; }
        }
        __syncthreads();
        const int ib5 = (w >> 1) & 1, jb5 = w & 1;
        f32x16 zero16;
#pragma unroll
        for (int i = 0; i < 16; ++i) zero16[i] = 0.f;
        if (w < 4) { const f32x16 p1 = mm64_tile(AL1, TDT, ib5, jb5, r, hh, zero16); store_tileT(P1T, DP64, 32 * jb5 + r, 32 * ib5, hh, p1, -1.0f); }
        __syncthreads();
        if (w < 4) {
            f32x16 c0;
#pragma unroll
            for (int i = 0; i < 16; ++i) c0[i] = bf2f(TM[(32 * ib5 + crow_(i, hh)) * DP64 + 32 * jb5 + r]);
            const f32x16 t1 = mm64_tile(TM, P1T, ib5, jb5, r, hh, c0);
            store_tileR(T1, DP64, 32 * jb5 + r, 32 * ib5, hh, t1); store_tileT(T1T, DP64, 32 * jb5 + r, 32 * ib5, hh, t1, 1.0f);
        }
        __syncthreads();
        if (w < 4) { const f32x16 p3 = mm64_tile(AL2, T1T, ib5, jb5, r, hh, zero16); store_tileT(P1T, DP64, 32 * jb5 + r, 32 * ib5, hh, p3, -1.0f); }
        __syncthreads();
        if (w < 4) {
            f32x16 c0;
#pragma unroll
            for (int i = 0; i < 16; ++i) c0[i] = bf2f(T1[(32 * ib5 + crow_(i, hh)) * DP64 + 32 * jb5 + r]);
            const f32x16 tt = mm64_tile(T1, P1T, ib5, jb5, r, hh, c0);
            store_tileR(TM, DP64, 32 * jb5 + r, 32 * ib5, hh, tt);
        }
        __syncthreads();
        {
            bf16_t* OUTd = dir ? OB : OF;
#pragma unroll
            for (int k2 = 0; k2 < 2; ++k2) {
                const int pc_ = tid2 + 512 * k2, row = pc_ >> 4, pc = pc_ & 15;
                const LAS bf16_t* src = (pc < 8 ? TM : ATT) + row * DP64 + (pc & 7) * 8;
                *(u32x4*)(OUTd + (size_t)(m0 + t0 + row) * 1024 + h * 128 + pc * 8) = *(const LAS u32x4*)src;
            }
        }
        __syncthreads();
    }
}

DI void delta_scan_unit(LAS unsigned char* lds, const bf16_t* QKV, const float* AB, float Aexp, float dtb,
                        int m0, int T, int h, int dir, const float* s0, float* sfin, bf16_t* OUT) {
    const int tid0 = opq(threadIdx.x), w0 = __builtin_amdgcn_readfirstlane(tid0 >> 6);
    LAS bf16_t* QN = (LAS bf16_t*)(lds + DL_QN); LAS bf16_t* KN = (LAS bf16_t*)(lds + DL_KN); LAS bf16_t* KNT = (LAS bf16_t*)(lds + DL_KNT); LAS bf16_t* VT = (LAS bf16_t*)(lds + DL_VT);
    LAS bf16_t* ST = (LAS bf16_t*)(lds + DL_ST); LAS bf16_t* ATT = (LAS bf16_t*)(lds + DL_ATT); LAS bf16_t* TM = (LAS bf16_t*)(lds + DL_TM); LAS bf16_t* RT = (LAS bf16_t*)(lds + DL_RT);
    LAS float* GT = (LAS float*)(lds + DL_GATE);
    LAS bf16_t* VNT = (LAS bf16_t*)(lds + DL_VNT); LAS bf16_t* VNST = (LAS bf16_t*)(lds + DL_VNST);
    f32x16 Sacc[2];
    {
        const int lane = tid0 & 63, r = lane & 31, hh = lane >> 5, kb = w0 >> 1, vb0 = 2 * (w0 & 1);
#pragma unroll
        for (int e = 0; e < 2; ++e)
#pragma unroll
            for (int i = 0; i < 16; ++i) Sacc[e][i] = s0 ? s0[(size_t)(32 * kb + crow_(i, hh)) * 128 + 32 * (vb0 + e) + r] : 0.f;
    }
    const int nch = T / 64;
    u32x4 pre[8];
#define DSCAN_LOAD(T0) do { const int tlo_ = (T0) + 2 * (tid0 >> 4), cg_ = tid0 & 15; \
        _Pragma("unroll") for (int pass = 0; pass < 2; ++pass) _Pragma("unroll") for (int part = 0; part < 3; ++part) \
            pre[pass * 3 + part] = *(const u32x4*)(QKV + (size_t)(m0 + tlo_ + pass) * 3072 + part * 1024 + h * 128 + cg_ * 8); \
        _Pragma("unroll") for (int k2 = 0; k2 < 2; ++k2) { const int pc_ = tid0 + 512 * k2; \
            pre[6 + k2] = *(const u32x4*)(OUT + (size_t)(m0 + (T0) + (pc_ >> 4)) * 1024 + h * 128 + (pc_ & 15) * 8); } } while (0)
    DSCAN_LOAD((dir ? nch - 1 : 0) * 64);
    float gxa = 0.f, gxb = 0.f;
    if (w0 == 0) delta_gates_load(AB, m0, (dir ? nch - 1 : 0) * 64, h, dir, tid0 & 63, gxa, gxb);
#pragma unroll 1
    for (int ci = 0; ci < nch; ++ci) {
        const int tid = opq(threadIdx.x), w = __builtin_amdgcn_readfirstlane(tid >> 6), lane = tid & 63, r = lane & 31, hh = lane >> 5;
        const int kb = w >> 1, vb0 = 2 * (w & 1);
        const int t0 = (dir ? nch - 1 - ci : ci) * 64;
        {
            const int cg = tid & 15, tlo = t0 + 2 * (tid >> 4);
#pragma unroll
            for (int pass = 0; pass < 2; ++pass) {
                const int loc = tlo + pass - t0, i = dir ? 63 - loc : loc;
                *(LAS u32x4*)(QN + i * DP128 + cg * 8) = pre[pass * 3 + 0];
                *(LAS u32x4*)(KN + i * DP128 + cg * 8) = pre[pass * 3 + 1];
                const int ci_ = (((i >> 3) ^ (cg & 7)) << 3) + (i & 7);
#pragma unroll
                for (int e = 0; e < 4; ++e) {
                    KNT[(cg * 8 + 2 * e) * DP64 + ci_] = (bf16_t)(pre[pass * 3 + 1][e] & 0xffffu); KNT[(cg * 8 + 2 * e + 1) * DP64 + ci_] = (bf16_t)(pre[pass * 3 + 1][e] >> 16);
                    VT[(cg * 8 + 2 * e) * DP64 + ci_] = (bf16_t)(pre[pass * 3 + 2][e] & 0xffffu); VT[(cg * 8 + 2 * e + 1) * DP64 + ci_] = (bf16_t)(pre[pass * 3 + 2][e] >> 16);
                }
            }
#pragma unroll
            for (int k2 = 0; k2 < 2; ++k2) {
                const int pc_ = tid + 512 * k2, row = pc_ >> 4, pc = pc_ & 15;
                *(LAS u32x4*)((pc < 8 ? TM : ATT) + row * DP64 + (pc & 7) * 8) = pre[6 + k2];
            }
#pragma unroll
            for (int e = 0; e < 2; ++e) store_tileT(ST, DP128, 32 * (vb0 + e) + r, 32 * kb, hh, Sacc[e], 1.0f);
        }
        if (w == 0) { delta_gates_compute(GT, gxa, gxb, Aexp, dtb, lane);
            if (ci + 1 < nch) delta_gates_load(AB, m0, (dir ? nch - 2 - ci : ci + 1) * 64, h, dir, lane, gxa, gxb); }
        if (ci + 1 < nch) DSCAN_LOAD((dir ? nch - 2 - ci : ci + 1) * 64);
        __syncthreads();
        f32x16 zero16;
#pragma unroll
        for (int i = 0; i < 16; ++i) zero16[i] = 0.f;
        const int cb = w >> 2, vb = w & 3;
        f32x16 O0;
        {
            f32x16 ks = zero16, qs = zero16;
#pragma unroll
            for (int s = 0; s < 8; ++s) {
                const bf16x8 sf = ldfrag(ST, 32 * vb + r, DP128, 16 * s + 8 * hh);
                ks = MFMA32(ldfrag(KN, 32 * cb + r, DP128, 16 * s + 8 * hh), sf, ks);
                qs = MFMA32(ldfrag(QN, 32 * cb + r, DP128, 16 * s + 8 * hh), sf, qs);
            }
            f32x16 rr;
#pragma unroll
            for (int g = 0; g < 4; ++g) {
                const u32x2 vv = *(const LAS u32x2*)(VT + (32 * vb + r) * DP64 + (((4 * cb + g) ^ ((r >> 3) & 3) ^ ((vb & 1) << 2)) << 3) + 4 * hh);
                const float v4[4] = {bflo(vv.x), bfhi(vv.x), bflo(vv.y), bfhi(vv.y)};
#pragma unroll
                for (int j = 0; j < 4; ++j) {
                    const int c = 32 * cb + 8 * g + 4 * hh + j; const float eg = GT[128 + c];
                    rr[4 * g + j] = GT[64 + c] * (v4[j] - eg * ks[4 * g + j]);
                    O0[4 * g + j] = eg * qs[4 * g + j];
                }
            }
            store_tileT(RT, DP64, 32 * vb + r, 32 * cb, hh, rr, 1.0f);
        }
        __syncthreads();
        {
            const f32x16 vn = mm64_tile(TM, RT, cb, vb, r, hh, zero16);
            f32x16 vs;
#pragma unroll
            for (int i = 0; i < 16; ++i) vs[i] = vn[i] * GT[192 + 32 * cb + crow_(i, hh)];
            store_tileT(VNT, DP64, 32 * vb + r, 32 * cb, hh, vn, 1.0f);
            store_tileT(VNST, DP64, 32 * vb + r, 32 * cb, hh, vs, 1.0f);
        }
        __syncthreads();
        {
            const f32x16 o = mm64_tile(ATT, VNT, cb, vb, r, hh, O0);
#pragma unroll
            for (int i = 0; i < 16; ++i) {
                const int c = 32 * cb + crow_(i, hh), t = dir ? t0 + 63 - c : t0 + c;
                OUT[(size_t)(m0 + t) * 1024 + h * 128 + 32 * vb + r] = (bf16_t)(pk2(o[i], 0.f) & 0xffffu);
            }
            const float egl = GT[256];
#pragma unroll
            for (int e = 0; e < 2; ++e) {
                f32x16 a = Sacc[e] * egl;
#pragma unroll
                for (int s2 = 0; s2 < 4; ++s2) {
                    const int row = 32 * kb + r, blk = (2 * s2 + hh) ^ ((row >> 3) & 7);
                    a = MFMA32(ldfrag(KNT, row, DP64, 8 * blk), ldfrag(VNST, 32 * (vb0 + e) + r, DP64, 16 * s2 + 8 * hh), a);
                }
                Sacc[e] = a;
            }
        }
        __syncthreads();
    }
    if (sfin) {
        const int lane = tid0 & 63, r = lane & 31, hh = lane >> 5, kb = w0 >> 1, vb0 = 2 * (w0 & 1);
#pragma unroll
        for (int e = 0; e < 2; ++e)
#pragma unroll
            for (int i = 0; i < 16; ++i) sfin[(size_t)(32 * kb + crow_(i, hh)) * 128 + 32 * (vb0 + e) + r] = Sacc[e][i];
    }
#undef DSCAN_LOAD
}
DI void delta_dispatch(LAS unsigned char* lds, int U, const bf16_t* QKV, const float* AB, const float* conv_w, const float* a_log, const float* dt_bias,
                       const float* state, float* news, bf16_t* OF, bf16_t* OB) {
    int b, h, dir, m0, T; const float* s0 = nullptr; float* sf = nullptr;
    if (U < 128) { b = U >> 4; h = (U >> 1) & 7; dir = U & 1; m0 = NPR + b * 2048; T = 2048; s0 = state + (size_t)((b * 2 + dir) * 8 + h) * 16384; }
    else { const int u = U - 128; b = u >> 4; h = (u >> 1) & 7; dir = u & 1; m0 = b * 256; T = 256; sf = news + (size_t)((b * 2 + dir) * 8 + h) * 16384; }
    const float Aexp = __expf(a_log[dir * 8 + h]), dtb = dt_bias[dir * 8 + h];
#ifdef DELTA_SEQ
    delta_unit(lds, QKV, AB, conv_w, Aexp, dtb, m0, T, h, dir, s0, sf, dir ? OB : OF);
#else
    delta_scan_unit(lds, QKV, AB, Aexp, dtb, m0, T, h, dir, s0, sf, dir ? OB : OF);
#endif
}

DI void y_phase(bf16_t* OF, const bf16_t* OB, const bf16_t* Z, int zp, const float* out_norm, int gw, int NGW, int lane) {
    for (int m = gw; m < NTOK; m += NGW) {
        const size_t off = (size_t)m * 1024 + 16 * lane;
        const u32x4 f0 = *(const u32x4*)(OF + off), f1 = *(const u32x4*)(OF + off + 8);
        const u32x4 b0 = *(const u32x4*)(OB + off), b1 = *(const u32x4*)(OB + off + 8);
        const size_t zoff = (size_t)m * zp + 16 * lane;
        const u32x4 z0 = *(const u32x4*)(Z + zoff), z1 = *(const u32x4*)(Z + zoff + 8);
        float o[16], z[16]; float ss = 0.f;
#pragma unroll
        for (int e = 0; e < 4; ++e) {
            o[2 * e] = bflo(f0[e]) + bflo(b0[e]); o[2 * e + 1] = bfhi(f0[e]) + bfhi(b0[e]);
            o[8 + 2 * e] = bflo(f1[e]) + bflo(b1[e]); o[8 + 2 * e + 1] = bfhi(f1[e]) + bfhi(b1[e]);
            z[2 * e] = bflo(z0[e]); z[2 * e + 1] = bfhi(z0[e]); z[8 + 2 * e] = bflo(z1[e]); z[8 + 2 * e + 1] = bfhi(z1[e]);
        }
#pragma unroll
        for (int e = 0; e < 16; ++e) ss += o[e] * o[e];
        ss += __shfl_xor(ss, 1); ss += __shfl_xor(ss, 2); ss += __shfl_xor(ss, 4);
        const float rstd = __builtin_amdgcn_rsqf(ss * (1.0f / 128.0f) + 1e-6f);
        const float* gn = out_norm + ((16 * lane) & 127);
        float y[16];
#pragma unroll
        for (int e = 0; e < 16; ++e) y[e] = o[e] * rstd * gn[e] * siluf_(z[e]);
        u32x4 w0, w1;
        w0.x = pk2(y[0], y[1]); w0.y = pk2(y[2], y[3]); w0.z = pk2(y[4], y[5]); w0.w = pk2(y[6], y[7]);
        w1.x = pk2(y[8], y[9]); w1.y = pk2(y[10], y[11]); w1.z = pk2(y[12], y[13]); w1.w = pk2(y[14], y[15]);
        *(u32x4*)(OF + off) = w0; *(u32x4*)(OF + off + 8) = w1;
    }
}

__global__ void __launch_bounds__(512, 2) fwd_megakernel(Params p) {
    extern __shared__ __attribute__((aligned(16))) unsigned char lds_raw[];
    LAS unsigned char* lds = (LAS unsigned char*)lds_raw;
    cg::grid_group grid = cg::this_grid();
    const int G = gridDim.x, bid = blockIdx.x, NGW = G * 8;
#define IDS() const int tid = opq(threadIdx.x), lane = tid & 63, wave = __builtin_amdgcn_readfirstlane(tid >> 6), gw = bid * 8 + wave; (void)gw; (void)lane; (void)tid
    unsigned char* ws = p.ws;
    float* mod = (float*)(ws + WS_MOD);
    float* Y = p.out + OUT_Y;
    bf16_t* XB = (bf16_t*)(p.out + OUT_Y) + 1024;
    bf16_t* WQKV1 = (bf16_t*)(ws + WS_WQKV1); bf16_t* WZ1 = (bf16_t*)(ws + WS_WZ1); bf16_t* WOUT1 = (bf16_t*)(ws + WS_WOUT1);
    bf16_t* WIN0 = (bf16_t*)(ws + B_WIN0); bf16_t* WOUT0 = (bf16_t*)(ws + B_WOUT0); bf16_t* W1_0 = (bf16_t*)(ws + B_W1_0); bf16_t* W2_0 = (bf16_t*)(ws + B_W2_0);
    bf16_t* H0 = (bf16_t*)(ws + B_H0); bf16_t* Qb = (bf16_t*)(ws + B_Q); bf16_t* KS = (bf16_t*)(ws + B_KS); bf16_t* VTS = (bf16_t*)(ws + B_VTS);
    bf16_t* KP = (bf16_t*)(ws + B_KP); bf16_t* VTP = (bf16_t*)(ws + B_VTP); bf16_t* FF0 = (bf16_t*)(ws + B_FF0);
    bf16_t* QKV1 = (bf16_t*)(ws + B_QKV1); float* AB = (float*)(ws + B_AB); bf16_t* OF = (bf16_t*)(ws + B_OF); bf16_t* OB = (bf16_t*)(ws + B_OB);
    bf16_t* H1 = (bf16_t*)(ws + B_H1); bf16_t* W1_1 = (bf16_t*)(ws + B_W1_1); bf16_t* W2_1 = (bf16_t*)(ws + B_W2_1); bf16_t* H1B = (bf16_t*)(ws + B_H1B);
    bf16_t* Zb = (bf16_t*)(ws + B_Z); bf16_t* FF1 = (bf16_t*)(ws + B_FF1);
    float* Pside = (float*)(ws + B_PS);
    bf16_t* HL = (bf16_t*)(p.out + OUT_Y);
    bf16_t* FFL0 = (bf16_t*)(ws + B_FFL0); bf16_t* FFL1 = (bf16_t*)(ws + B_FFL1);

    unsigned* barw = (unsigned*)(ws + 524288);
    volatile LAS unsigned* bar_st = (volatile LAS unsigned*)(lds + LDS_BYTES - 512);
    if (threadIdx.x < 2) bar_st[threadIdx.x] = 0u;
    if (p.ws == nullptr) grid.sync();
    __syncthreads();
    const XcdBarrier xbar = xcd_barrier_post(barw, bar_st);
#define GSYNC() xcd_barrier(xbar)
#define W2_GEMM(FFb, W2b, modl) do { \
        pg8::Gemm g{FFb, W2b, 4096, 4096, NTOK, 1024, 4096}; \
        EpiRes E{nullptr, nullptr, XB, modl + 5120, Pside, 0}; \
        if (G == 256) { pg8::W2Order S; S.c = bid; S.ntf = 64; pg8::gemm_phase(lds, g, S, E); } \
        else { pg8::StaticOrder S; S.init(NTOK, 1024, G, bid); pg8::gemm_phase(lds, g, S, E); } } while (0)
    {
        IDS();
        LAS float* scr = (LAS float*)(lds + wave * 8704);
        transpose_matrix(p.in[10], 1024, 2304, WIN0, scr, gw, NGW, lane);
        const bool later = (G == 256);
        if (!later) {
        transpose_matrix(p.in[16], 1024, 1024, WOUT0, scr, gw, NGW, lane);
        transpose_matrix(p.in[18], 1024, 4096, W1_0, scr, gw, NGW, lane);
        transpose_matrix(p.in[19], 4096, 1024, W2_0, scr, gw, NGW, lane);
        transpose_matrix(p.in[28], 1024, 1024, WOUT1, scr, gw, NGW, lane);
        }
        if (!later) {
            const float* W = p.in[23]; const int nblk = 129, nitems = 16 * nblk;
            for (int it = gw; it < nitems; it += NGW) { const int kb = it / nblk, nb = it % nblk, n0 = nb * 32;
                if (n0 < 3072) transpose_item(W, 4128, kb * 64, n0, WQKV1, 1024, perm_row32(n0), scr, lane);
                else if (n0 < 4096) transpose_item(W, 4128, kb * 64, n0, WZ1, 1024, perm_row32(n0 - 3072), scr, lane);
                else transpose_item(W, 4128, kb * 64, n0, WQKV1, 1024, 3072, scr, lane); }
            u32x4* zp = (u32x4*)(WQKV1 + (size_t)3104 * 1024); const int nz = 224 * 1024 * 2 / 16;
            for (int i = bid * 512 + tid; i < nz; i += G * 512) zp[i] = (u32x4){0u, 0u, 0u, 0u};
        }
        {
            const float* ck = p.in[3]; const float* cv = p.in[4];
            for (int e = bid * 512 + tid; e < 8 * 256 * 640; e += G * 512) {
                const int b = e / (256 * 640), rem = e % (256 * 640), pp = rem / 640, hd = rem % 640, head = hd >> 6, d = hd & 63, kk = pp & 31;
                const size_t tbase = ((size_t)(b * 10 + head) * 72 + 64 + (pp >> 5)) * 2048;
                KS[tbase + ((d >> 3) * 32 + kk) * 8 + (d & 7)] = (bf16_t)(pk2(ck[e], 0.f) & 0xffffu);
                VTS[tbase + ((((((d >> 5) * 2 + (kk >> 4)) * 2 + ((kk >> 3) & 1)) * 2 + ((kk >> 2) & 1)) * 32 + (d & 31)) << 2) + (kk & 3)] = (bf16_t)(pk2(cv[e], 0.f) & 0xffffu);
            }
        }
        __syncthreads();
        LAS float* sv = (LAS float*)lds;
        LAS float* red = sv + 1024 * 12;
        bool sv_ready = false;
        for (int U = bid; U < 192; U += G) {
            if (!sv_ready) {
                for (int i = tid; i < 9 * 1024; i += 512) { const int r = i >> 10, k = i & 1023; const float x = (r == 0) ? p.in[6][k] : p.in[2][(r - 1) * 1024 + k]; sv[k * 12 + r] = siluf_(x); }
                sv_ready = true; __syncthreads();
            }
            const int l = U / 96, j0 = (U % 96) * 64;
            const float* W = p.in[l ? 20 : 7]; const float* bias = p.in[l ? 21 : 8];
            float a[9];
#pragma unroll
            for (int r = 0; r < 9; ++r) a[r] = 0.f;
            const int kbeg = wave * 128;
#pragma unroll 16
            for (int k = kbeg; k < kbeg + 128; ++k) {
                const float w = W[(size_t)k * MODW + j0 + lane];
                const f32x4 s0 = *(const LAS f32x4*)(sv + k * 12), s1 = *(const LAS f32x4*)(sv + k * 12 + 4); const float s8 = sv[k * 12 + 8];
                a[0] += w * s0.x; a[1] += w * s0.y; a[2] += w * s0.z; a[3] += w * s0.w; a[4] += w * s1.x; a[5] += w * s1.y; a[6] += w * s1.z; a[7] += w * s1.w; a[8] += w * s8;
            }
#pragma unroll
            for (int r = 0; r < 9; ++r) red[(wave * 9 + r) * 64 + lane] = a[r];
            __syncthreads();
            for (int i = tid; i < 576; i += 512) { const int r = i >> 6, c = i & 63; float s = bias[j0 + c];
#pragma unroll
                for (int w = 0; w < 8; ++w) s += red[(w * 9 + r) * 64 + c];
                mod[(size_t)(l * 9 + r) * MODW + j0 + c] = s; }
            __syncthreads();
        }
    }
    GSYNC();

    const float* mod0 = mod; const float* mod1 = mod + 9 * MODW;
    { IDS(); norm_phase(p.in[0], p.in[1], nullptr, p.in[9], mod0 + 0, mod0 + 1024, H0, DM, gw, NGW, lane); }
    GSYNC();
    {
        pg8::Gemm g{H0, WIN0, 1024, 1024, NTOK, 2304, 1024}; pg8::StaticOrder S; S.init(NTOK, 2304, G, bid);
        EpiQKV0 E{Qb, KS, VTS, KP, VTP, p.out + OUT_NEWK, p.out + OUT_NEWV, p.in[11], p.in[12], p.in[13], p.in[14]};
        pg8::gemm_phase(lds, g, S, E);
        if (G == 256 && bid >= 96) {
            IDS();
            LAS float* scr = (LAS float*)(lds + wave * 8704);
            const int gw2 = (bid - 96) * 8 + wave, NGW2 = 160 * 8;
            transpose_matrix(p.in[16], 1024, 1024, WOUT0, scr, gw2, NGW2, lane);
            transpose_matrix(p.in[18], 1024, 4096, W1_0, scr, gw2, NGW2, lane);
            transpose_matrix(p.in[19], 4096, 1024, W2_0, scr, gw2, NGW2, lane);
            transpose_matrix(p.in[28], 1024, 1024, WOUT1, scr, gw2, NGW2, lane);
            const float* W = p.in[23]; const int nblk = 129, nitems = 16 * nblk;
            for (int it = gw2; it < nitems; it += NGW2) { const int kb = it / nblk, nb = it % nblk, n0 = nb * 32;
                if (n0 < 3072) transpose_item(W, 4128, kb * 64, n0, WQKV1, 1024, perm_row32(n0), scr, lane);
                else if (n0 < 4096) transpose_item(W, 4128, kb * 64, n0, WZ1, 1024, perm_row32(n0 - 3072), scr, lane);
                else transpose_item(W, 4128, kb * 64, n0, WQKV1, 1024, 3072, scr, lane); }
            u32x4* zp = (u32x4*)(WQKV1 + (size_t)3104 * 1024); const int nz = 224 * 1024 * 2 / 16;
            for (int i = (bid - 96) * 512 + tid; i < nz; i += 160 * 512) zp[i] = (u32x4){0u, 0u, 0u, 0u};
        }
    }
    GSYNC();
    { IDS();
      LAS float* sbias = (LAS float*)lds;
      for (int i = tid; i < 3720; i += 512) sbias[i] = p.in[15][i];
      __syncthreads();
      attention_phase(Qb, KS, VTS, KP, VTP, sbias, p.in[11], p.in[12], p.in[13], p.in[14], H0, gw, NGW, lane); }
#ifdef PROBE_ATTN
    GSYNC();
    { IDS(); attention_phase(Qb, KS, VTS, KP, VTP, (const LAS float*)lds, p.in[11], p.in[12], p.in[13], p.in[14], H0, gw, NGW, lane); }
#endif
    GSYNC();
    {
        pg8::Gemm g{H0, WOUT0, 1024, 1024, NTOK, 1024, 1024}; pg8::StaticOrder S; S.init(NTOK, 1024, G, bid);
        EpiRes E{p.in[0], p.in[1], XB, mod0 + 2048, nullptr, 0};
        pg8::gemm_phase(lds, g, S, E);
    }
    GSYNC();
    { IDS(); norm_phase(nullptr, nullptr, XB, p.in[17], mod0 + 3072, mod0 + 4096, HL, XBP, gw, NGW, lane); }
    GSYNC();
    {
        pg8::Gemm g{HL, W1_0, XBP, 1024, NTOK, 4096, 1024}; pg8::StaticOrder S; S.init(NTOK, 4096, G, bid);
        EpiBf16<1> E{FFL0, 4096};
        pg8::gemm_phase(lds, g, S, E);
    }
    GSYNC();
    W2_GEMM(FFL0, W2_0, mod0);
    GSYNC();
    { IDS(); norm_phase(nullptr, nullptr, XB, p.in[22], mod1 + 0, mod1 + 1024, H1, DM, gw, NGW, lane, (G == 256) ? Pside : nullptr); }
    GSYNC();
    {
        pg8::Gemm g{H1, WQKV1, 1024, 1024, NTOK, 4352, 1024}; pg8::StaticOrder S; S.init(NTOK, 4352, G, bid);
        EpiQKV1 E{QKV1, AB, HL, XBP, (bf16_t*)(ws + B_HALO)};
        pg8::gemm_phase(lds, g, S, E);
    }
    GSYNC();
    {
#pragma unroll 1
        for (int U = bid; U < 3072; U += G) {
            const int ch = U >> 3, h = U & 7, mrow = ch * 64;
            const int m0 = (mrow < NPR) ? (mrow & ~255) : NPR + ((mrow - NPR) & ~2047), T = (mrow < NPR) ? 256 : 2048;
            delta_prep_unit(lds, QKV1, (const bf16_t*)(ws + B_HALO), AB, p.in[24], p.in[25], p.in[26], m0, T, mrow - m0, h, OF, OB);
        }
    }
    GSYNC();
#ifdef PROBE_DELTA
    for (int rep = 0; rep < 2; ++rep)
#endif
    {
        float* news = p.out + OUT_NEWS;
#ifdef PROBE_DELTA
        if (rep) GSYNC();
#endif
        const bool bal = (G == 256);
        const int nun = bal ? (bid < 128 ? 1 : 4) : (640 - bid + G - 1) / G;
#pragma unroll 1
        for (int i = 0; i < nun; ++i) {
            const int U = bal ? (bid < 128 ? bid : 128 + (bid - 128) * 4 + i) : bid + i * G;
            delta_dispatch(lds, U, QKV1, AB, p.in[24], p.in[25], p.in[26], p.in[5], news, OF, OB);
        }
    }
    GSYNC();
    if (G != 256) {
        IDS();
        LAS float* scr = (LAS float*)(lds + wave * 8704);
        transpose_matrix(p.in[30], 1024, 4096, W1_1, scr, gw, NGW, lane);
        transpose_matrix(p.in[31], 4096, 1024, W2_1, scr, gw, NGW, lane);
    }
    { IDS(); y_phase(OF, OB, HL, XBP, p.in[27], gw, NGW, lane); }
    GSYNC();
    {
        pg8::Gemm g{OF, WOUT1, 1024, 1024, NTOK, 1024, 1024}; pg8::StaticOrder S; S.init(NTOK, 1024, G, bid);
        EpiRes E{nullptr, nullptr, XB, mod1 + 2048, nullptr, 0};
        pg8::gemm_phase(lds, g, S, E);
        if (G == 256 && bid >= 128) {
            IDS();
            LAS float* scr = (LAS float*)(lds + wave * 8704);
            const int gw2 = (bid - 128) * 8 + wave, NGW2 = 128 * 8;
            transpose_matrix(p.in[30], 1024, 4096, W1_1, scr, gw2, NGW2, lane);
            transpose_matrix(p.in[31], 4096, 1024, W2_1, scr, gw2, NGW2, lane);
        }
    }
    GSYNC();
    { IDS(); norm_phase(nullptr, nullptr, XB, p.in[29], mod1 + 3072, mod1 + 4096, HL, XBP, gw, NGW, lane); }
    GSYNC();
    {
        pg8::Gemm g{HL, W1_1, XBP, 1024, NTOK, 4096, 1024}; pg8::StaticOrder S; S.init(NTOK, 4096, G, bid);
        EpiBf16<1> E{FFL1, 4096};
        pg8::gemm_phase(lds, g, S, E);
    }
    GSYNC();
    W2_GEMM(FFL1, W2_1, mod1);
    {
        GSYNC();
        IDS();
        const bool fold = (G == 256);
        for (int m = gw; m < NTOK; m += NGW) {
            const bf16_t* xr = XB + (size_t)m * XBP + 16 * lane;
            const u32x4 w0 = *(const u32x4*)xr, w1 = *(const u32x4*)(xr + 8);
            f32x4 o[4] = {(f32x4){bflo(w0.x), bfhi(w0.x), bflo(w0.y), bfhi(w0.y)}, (f32x4){bflo(w0.z), bfhi(w0.z), bflo(w0.w), bfhi(w0.w)},
                          (f32x4){bflo(w1.x), bfhi(w1.x), bflo(w1.y), bfhi(w1.y)}, (f32x4){bflo(w1.z), bfhi(w1.z), bflo(w1.w), bfhi(w1.w)}};
            if (fold && m >= 16384) {
#pragma unroll
                for (int j = 0; j < 4; ++j) o[j] = o[j] + *(const f32x4*)(Pside + (size_t)(m - 16384) * DM + 16 * lane + 4 * j);
            }
            asm volatile("s_waitcnt vmcnt(0)" ::: "memory");
#pragma unroll
            for (int j = 0; j < 4; ++j) *(f32x4*)(Y + (size_t)m * DM + 16 * lane + 4 * j) = o[j];
        }
    }
}

extern "C" void kernel_launch(void* const* d_in, const int* in_sizes, int n_in, void* d_out, int out_size, void* d_ws, size_t ws_size, hipStream_t stream) {
    static int grid_blocks = 0;
    if (!grid_blocks) {
        if (n_in != 32 || ws_size < WS_NEED) { fprintf(stderr, "kernel_launch: unexpected n_in %d / ws_size %zu (need %zu)\n", n_in, ws_size, (size_t)WS_NEED); grid_blocks = -1; return; }
        int dev = 0, cus = 0, per_cu = 0;
        hipGetDevice(&dev);
        hipDeviceGetAttribute(&cus, hipDeviceAttributeMultiprocessorCount, dev);
        hipFuncSetAttribute((const void*)fwd_megakernel, hipFuncAttributeMaxDynamicSharedMemorySize, LDS_BYTES);
        hipOccupancyMaxActiveBlocksPerMultiprocessor(&per_cu, (const void*)fwd_megakernel, 512, LDS_BYTES);
        if (per_cu < 1) { fprintf(stderr, "kernel_launch: occupancy query returned %d\n", per_cu); per_cu = 1; }
        grid_blocks = cus * per_cu;
    }
    if (grid_blocks < 0) return;
    Params p{};
    for (int i = 0; i < 32; ++i) p.in[i] = (const float*)d_in[i];
    p.out = (float*)d_out; p.ws = (unsigned char*)d_ws;
    if (hipMemsetAsync((char*)d_ws + 524288, 0, XCD_BAR_WORDS * 4, stream) != hipSuccess) { fprintf(stderr, "kernel_launch: memset of barrier words failed\n"); return; }
    void* args[] = {&p};
    hipError_t e = hipLaunchCooperativeKernel((const void*)fwd_megakernel, dim3(grid_blocks), dim3(512), args, LDS_BYTES, stream);
    if (e != hipSuccess) fprintf(stderr, "cooperative launch failed: %s (grid %d)\n", hipGetErrorString(e), grid_blocks);
}
```

```cpp
#include <hip/hip_runtime.h>
#include <hip/hip_cooperative_groups.h>
#include <cstdio>
namespace cg = cooperative_groups;

#define LAS __attribute__((address_space(3)))
#define DI __device__ __forceinline__
typedef unsigned short bf16_t;
typedef short bf16x8 __attribute__((ext_vector_type(8)));
typedef short s16x4 __attribute__((ext_vector_type(4)));
typedef float f32x2 __attribute__((ext_vector_type(2)));
typedef float f32x4 __attribute__((ext_vector_type(4)));
typedef float f32x16 __attribute__((ext_vector_type(16)));
typedef unsigned u32x2 __attribute__((ext_vector_type(2)));
typedef unsigned u32x4 __attribute__((ext_vector_type(4)));
typedef __bf16 nbf16x2 __attribute__((ext_vector_type(2)));

DI unsigned pk2(float a, float b) { f32x2 v = {a, b}; nbf16x2 r = __builtin_convertvector(v, nbf16x2); return __builtin_bit_cast(unsigned, r); }
DI float bf2f(unsigned short h) { return __builtin_bit_cast(float, (unsigned)h << 16); }
DI float bflo(unsigned w) { return __builtin_bit_cast(float, w << 16); }
DI float bfhi(unsigned w) { return __builtin_bit_cast(float, w & 0xffff0000u); }
DI float sigmoidf_(float x) { return __builtin_amdgcn_rcpf(1.0f + __expf(-x)); }
DI float siluf_(float x) { return x * __builtin_amdgcn_rcpf(1.0f + __expf(-x)); }
DI int opq(int x) { asm volatile("" : "+v"(x)); return x; }

constexpr int NTOK = 24576, NPR = 8192, DM = 1024;
constexpr int MODW = 6144;
constexpr size_t OUT_Y = 0, OUT_NEWK = 25165824, OUT_NEWV = OUT_NEWK + 5242880, OUT_NEWS = OUT_NEWV + 5242880;
constexpr size_t WS_MOD = 0;
constexpr size_t WS_WQKV1 = 1048576;
constexpr size_t WS_WZ1 = WS_WQKV1 + 3328ull * 1024 * 2;
constexpr size_t WS_WOUT1 = WS_WZ1 + 1024ull * 1024 * 2;
constexpr size_t WS_BIG = WS_WOUT1 + 1024ull * 1024 * 2;
constexpr size_t B_WIN0 = WS_BIG, B_WOUT0 = B_WIN0 + 2304ull * 1024 * 2, B_W1_0 = B_WOUT0 + 1024ull * 1024 * 2, B_W2_0 = B_W1_0 + 4096ull * 1024 * 2;
constexpr size_t B_H0 = B_W2_0 + 4096ull * 1024 * 2;
constexpr size_t B_Q = B_H0 + (size_t)NTOK * 1024 * 2;
constexpr size_t B_KS = B_Q + (size_t)NTOK * 1024 * 2;
constexpr size_t B_VTS = B_KS + 8ull * 2304 * 640 * 2;
constexpr size_t B_KP = B_VTS + 8ull * 2304 * 640 * 2;
constexpr size_t B_VTP = B_KP + 8192ull * 640 * 2;
constexpr size_t B_FF0 = B_Q;
constexpr size_t B_QKV1 = WS_BIG;
constexpr size_t B_AB = B_QKV1 + (size_t)NTOK * 3072 * 2;
constexpr size_t B_OF = B_AB + (size_t)NTOK * 32 * 4;
constexpr size_t B_OB = B_OF + (size_t)NTOK * 1024 * 2;
constexpr size_t B_H1 = B_OF;
constexpr size_t B_W1_1 = WS_BIG, B_W2_1 = B_W1_1 + 4096ull * 1024 * 2;
constexpr size_t B_H1B = B_W2_1 + 4096ull * 1024 * 2;
constexpr size_t B_Z = B_H1B + (size_t)NTOK * 1024 * 2;
constexpr size_t B_FF1 = B_Z;
constexpr size_t B_FFL0 = B_H0, B_FFL1 = B_H1B;
constexpr size_t B_PS = B_FFL0 + (size_t)NTOK * 4096 * 2;
constexpr size_t B_HALO = B_OB + (size_t)NTOK * 1024 * 2;
constexpr size_t WS_NEED = (B_PS + 8192ull * 1024 * 4 > B_HALO + 384ull * 2 * 3072 * 2) ? B_PS + 8192ull * 1024 * 4 : B_HALO + 384ull * 2 * 3072 * 2;
static_assert(WS_NEED <= 271868064ull, "ws budget (halo)");
static_assert(B_FFL1 + (size_t)NTOK * 4096 * 2 <= B_PS && B_OB + (size_t)NTOK * 1024 * 2 <= WS_NEED, "ws map (mlp)");
static_assert(B_VTP + 8192ull * 640 * 2 <= WS_NEED && B_FF0 + (size_t)NTOK * 2048 * 2 <= WS_NEED && B_FF1 + (size_t)NTOK * 2048 * 2 <= WS_NEED, "ws map");
static_assert(B_Z + (size_t)NTOK * 1024 * 2 <= B_AB, "z inside dead qkv region");
static_assert(WS_NEED <= 271868064ull, "ws budget");

constexpr int LDS_BYTES = 151552;

struct Params { const float* in[32]; float* out; unsigned char* ws; };

namespace pg8 {
constexpr int BM = 256, BK = 64, HALF = 128, HTB = HALF * BK * 2, STAGE_BYTES = 8 * HTB, NXCD = 8, WGM = 8;
DI int lds_byte(int r, int c) { const int st = (r >> 4) * 2 + (c >> 5), rr = r & 15, cc = c & 31, ob = rr * 64 + cc * 2; return st * 1024 + (ob ^ (((ob >> 9) & 1) << 5)); }
DI void stage_rc(int b, int& R, int& C) { const int st = b / 1024, sb = b % 1024, swz = sb ^ (((sb >> 9) & 1) << 5); R = (st >> 1) * 16 + swz / 64; C = (st & 1) * 32 + (swz % 64) / 2; }
struct Unit { int pm, pn, kofs, nt, mode; };
struct Gemm { const bf16_t* A; const bf16_t* Bt; int lda, ldb, M, N, K; };
struct StaticOrder {
    int nM, nN, nwg, G, c;
    DI void init(int M, int N, int G_, int c_) { nM = M / BM; nN = N / BM; nwg = nM * nN; G = G_; c = c_; }
    DI bool next(int i, Unit& u) const {
        const long L = (long)i * G + c; if (L >= nwg) return false;
        int wgid = (int)L; { const int q = nwg / NXCD, r = nwg % NXCD, xcd = wgid % NXCD, off = wgid / NXCD; wgid = (xcd < r ? xcd * (q + 1) : r * (q + 1) + (xcd - r) * q) + off; }
        const int nig = WGM * nN, gid = wgid / nig, fm = gid * WGM, gsz = (nM - fm) < WGM ? (nM - fm) : WGM;
        u.pm = fm + ((wgid % nig) % gsz); u.pn = (wgid % nig) / gsz; u.kofs = 0; u.nt = 0; u.mode = 0; return true;
    }
};

struct W2Order { int c, ntf;
    DI bool next(int i, Unit& u) const {
        const int x = c & 7, j = c >> 3;
        if (i == 0) { u.pm = 8 * x + (j >> 2); u.pn = j & 3; u.kofs = 0; u.nt = ntf; u.mode = 0; return true; }
        if (i == 1) { const int st = j >> 1; u.pm = 64 + 4 * x + (st >> 2); u.pn = st & 3; u.kofs = (j & 1) * (ntf * 32); u.nt = ntf / 2; u.mode = j & 1; return true; }
        return false; } };

template <class Epi, class Sched>
DI void gemm_phase(LAS unsigned char* lds, const Gemm g, const Sched& S, const Epi& E) {
    const int tid = opq(threadIdx.x), wid = __builtin_amdgcn_readfirstlane(tid >> 6), lane = tid & 63, wr = wid >> 2, wc = wid & 3, fr = lane & 15, fq = lane >> 4;
    const int K = g.K;
    unsigned voffA[2], voffB[2];
#pragma unroll
    for (int i = 0; i < 2; ++i) { int R, C; stage_rc(tid * 16 + i * 8192, R, C);
        voffA[i] = (unsigned)(R * g.lda + C) * 2u; voffB[i] = (unsigned)(R * g.ldb + C) * 2u; }
    const size_t kstep = (size_t)(BK * 2);
    const size_t hstepA = (size_t)HALF * g.lda * 2, hstepB = (size_t)HALF * g.ldb * 2;
    const size_t tstepA = 2 * hstepA, tstepB = 2 * hstepB;
    const unsigned ldsw = (unsigned)wid * 1024u;
    const int aoff = lds_byte(wr * 64 + fr, fq * 8), boff = lds_byte(wc * 32 + fr, fq * 8);
#define PG8_SA(b, h) (((b) * 2 + (h)) * HTB)
#define PG8_SB(b, h) ((4 + (b) * 2 + (h)) * HTB)
#define PG8_STAGE(bufoff, gbase, voff) do { _Pragma("unroll") for (int _i = 0; _i < 2; ++_i) \
        __builtin_amdgcn_global_load_lds((const unsigned*)((const char*)(gbase) + (voff)[_i]), (LAS unsigned*)(lds + (bufoff) + ldsw + _i * 8192), 16, 0, 0); } while (0)
#define PG8_LDA(dst, b, h) do { _Pragma("unroll") for (int m = 0; m < 4; ++m) _Pragma("unroll") for (int k = 0; k < 2; ++k) dst[m][k] = *(const LAS bf16x8*)(lds + PG8_SA(b, h) + aoff + m * 2048 + k * 1024); } while (0)
#define PG8_LDB(dst, b, h) do { _Pragma("unroll") for (int n = 0; n < 2; ++n) _Pragma("unroll") for (int k = 0; k < 2; ++k) dst[n][k] = *(const LAS bf16x8*)(lds + PG8_SB(b, h) + boff + n * 2048 + k * 1024); } while (0)
#define PG8_MMA(ai, bj, At, Bt) do { __builtin_amdgcn_s_setprio(1); _Pragma("unroll") for (int m = 0; m < 4; ++m) _Pragma("unroll") for (int n = 0; n < 2; ++n) _Pragma("unroll") for (int k = 0; k < 2; ++k) \
        acc[ai][bj][m][n] = __builtin_amdgcn_mfma_f32_16x16x32_bf16(Bt[n][k], At[m][k], acc[ai][bj][m][n], 0, 0, 0); __builtin_amdgcn_s_setprio(0); } while (0)
#define PG8_WAIT_V(n) asm volatile("s_waitcnt vmcnt(" #n ")" ::: "memory")
#define PG8_WAIT_L(n) asm volatile("s_waitcnt lgkmcnt(" #n ")" ::: "memory")
#define PG8_BAR __builtin_amdgcn_s_barrier()
#define PG8_SCHED __builtin_amdgcn_sched_barrier(0)
    Unit cur, nxt; int ui = 0;
    if (!S.next(0, cur)) return;
    if (cur.nt == 0) cur.nt = K / BK;
    f32x4 acc[2][2][4][2];
#pragma unroll
    for (int a = 0; a < 2; ++a)
#pragma unroll
        for (int b = 0; b < 2; ++b)
#pragma unroll
            for (int m = 0; m < 4; ++m)
#pragma unroll
                for (int n = 0; n < 2; ++n) acc[a][b][m][n] = (f32x4){0.f, 0.f, 0.f, 0.f};
    bf16x8 At[4][2], B0[2][2], B1[2][2];
    const char* cA = (const char*)g.A + (size_t)cur.pm * tstepA + (size_t)cur.kofs * 2; const char* cB = (const char*)g.Bt + (size_t)cur.pn * tstepB + (size_t)cur.kofs * 2;
    PG8_STAGE(PG8_SB(0, 0), cB, voffB); PG8_STAGE(PG8_SB(0, 1), cB + hstepB, voffB); PG8_STAGE(PG8_SA(0, 0), cA, voffA); PG8_STAGE(PG8_SA(0, 1), cA + hstepA, voffA);
    if (wr == 1) PG8_BAR;
    PG8_WAIT_V(2); PG8_BAR;
    PG8_STAGE(PG8_SB(1, 0), cB + kstep, voffB); PG8_STAGE(PG8_SA(1, 0), cA + kstep, voffA); PG8_STAGE(PG8_SB(1, 1), cB + hstepB + kstep, voffB);
    PG8_WAIT_V(6); PG8_BAR;
    for (;;) {
        const bool has_next = S.next(ui + 1, nxt);
        if (has_next && nxt.nt == 0) nxt.nt = K / BK;
        const char* nA = has_next ? (const char*)g.A + (size_t)nxt.pm * tstepA + (size_t)nxt.kofs * 2 : cA; const char* nB = has_next ? (const char*)g.Bt + (size_t)nxt.pn * tstepB + (size_t)nxt.kofs * 2 : cB;
        const int nt = cur.nt;
        for (int t = 0; t < nt; t += 2) {
            const bool last = (t == nt - 2);
            const char* a1 = cA + (size_t)(t + 1) * kstep;
            const char* a2 = last ? nA : cA + (size_t)(t + 2) * kstep; const char* b2 = last ? nB : cB + (size_t)(t + 2) * kstep;
            const char* a3 = a2 + kstep; const char* b3 = b2 + kstep;
            PG8_LDB(B0, 0, 0); PG8_LDB(B1, 0, 1); PG8_SCHED; PG8_LDA(At, 0, 0); PG8_STAGE(PG8_SA(1, 1), a1 + hstepA, voffA);
            PG8_WAIT_V(8); PG8_WAIT_L(0); PG8_BAR; PG8_MMA(0, 0, At, B0); PG8_MMA(0, 1, At, B1); PG8_BAR; PG8_SCHED;
            PG8_LDA(At, 0, 1); PG8_STAGE(PG8_SB(0, 0), b2, voffB); PG8_STAGE(PG8_SB(0, 1), b2 + hstepB, voffB); PG8_STAGE(PG8_SA(0, 0), a2, voffA);
            PG8_WAIT_V(8); PG8_WAIT_L(0); PG8_BAR; PG8_MMA(1, 0, At, B0); PG8_MMA(1, 1, At, B1); PG8_BAR; PG8_SCHED;
            PG8_LDB(B0, 1, 0); PG8_LDB(B1, 1, 1); PG8_SCHED; PG8_LDA(At, 1, 0); PG8_STAGE(PG8_SA(0, 1), a2 + hstepA, voffA);
            PG8_WAIT_V(8); PG8_WAIT_L(0); PG8_BAR; PG8_MMA(0, 0, At, B0); PG8_MMA(0, 1, At, B1); PG8_BAR; PG8_SCHED;
            PG8_LDA(At, 1, 1); PG8_STAGE(PG8_SB(1, 0), b3, voffB); PG8_STAGE(PG8_SB(1, 1), b3 + hstepB, voffB); PG8_STAGE(PG8_SA(1, 0), a3, voffA);
            PG8_WAIT_V(8); PG8_WAIT_L(0); PG8_BAR; PG8_MMA(1, 0, At, B0); PG8_MMA(1, 1, At, B1); PG8_BAR; PG8_SCHED;
        }
        if (wr == 0) PG8_BAR;
        E(acc, cur, wr, wc, fr, fq);
        if (!has_next) break;
#pragma unroll
        for (int a = 0; a < 2; ++a)
#pragma unroll
            for (int b = 0; b < 2; ++b)
#pragma unroll
                for (int m = 0; m < 4; ++m)
#pragma unroll
                    for (int n = 0; n < 2; ++n) acc[a][b][m][n] = (f32x4){0.f, 0.f, 0.f, 0.f};
        cur = nxt; cA = nA; cB = nB; ++ui;
        if (wr == 1) PG8_BAR;
    }
    PG8_WAIT_V(0);
    PG8_BAR;
#undef PG8_SA
#undef PG8_SB
#undef PG8_STAGE
#undef PG8_LDA
#undef PG8_LDB
#undef PG8_MMA
#undef PG8_WAIT_V
#undef PG8_WAIT_L
#undef PG8_BAR
#undef PG8_SCHED
}
}
using pg8::Unit;

#define XB_TMO      128
#define XB_XCNT(j)  (256  + 64 * (j))
#define XB_XSUB(j)  (1280 + 64 * (j))
#define XB_XGEN(j)  (2304 + 64 * (j))
#define XB_TOP      3328
#define XB_TOPGEN   3392
#define XCD_BAR_WORDS 3456
#define XB_SPIN_CAP (1u << 18)

__device__ __forceinline__ unsigned xb_ld(unsigned* p)              { return __hip_atomic_load(p, __ATOMIC_RELAXED, __HIP_MEMORY_SCOPE_AGENT); }
__device__ __forceinline__ unsigned xb_add(unsigned* p, unsigned v) { return __hip_atomic_fetch_add(p, v, __ATOMIC_RELAXED, __HIP_MEMORY_SCOPE_AGENT); }
__device__ __forceinline__ unsigned xb_xcc_id() { return (unsigned)__builtin_amdgcn_s_getreg((3 << 11) | 20) & 0xFu; }
#define XB_SPIN(cond, bar) do { unsigned _sp = 0; while (cond) { __builtin_amdgcn_s_sleep(1); \
    if ((++_sp & 255u) == 0u) { if (xb_ld(&(bar)[XB_TMO])) break; if (_sp > XB_SPIN_CAP) { atomicAdd(&(bar)[XB_TMO], 1u); break; } } } } while (0)

struct XcdBarrier {
    unsigned* bar; unsigned x;
    volatile LAS unsigned* st;
};

__device__ __forceinline__ XcdBarrier xcd_barrier_post(unsigned* bar, volatile LAS unsigned* st) {
    XcdBarrier b; b.bar = bar; b.x = xb_xcc_id(); b.st = st;
    if (threadIdx.x == 0) (void)xb_add(&bar[XB_XCNT(b.x)], 1u);
    return b;
}
__device__ __forceinline__ void xcd_barrier_complete(unsigned* bar, unsigned x, unsigned& nloc, unsigned& nx) {
    const unsigned G = gridDim.x * gridDim.y * gridDim.z;
    unsigned sum, cnt, mine, sp = 0u;
    for (;;) {
        sum = 0u; cnt = 0u; mine = 0u;
#pragma unroll
        for (unsigned j = 0; j < 16; ++j) { const unsigned c = xb_ld(&bar[XB_XCNT(j)]); sum += c; cnt += (c > 0u) ? 1u : 0u; mine = (j == x) ? c : mine; }
        if (sum == G) break;
        __builtin_amdgcn_s_sleep(1);
        if ((++sp & 255u) == 0u) { if (xb_ld(&bar[XB_TMO])) break; if (sp > XB_SPIN_CAP) { atomicAdd(&bar[XB_TMO], 1u); break; } }
    }
    nloc = mine > 0u ? mine : 1u; nx = cnt > 0u ? cnt : 1u;
}

__device__ __forceinline__ void xcd_barrier(const XcdBarrier& b) {
    asm volatile("s_waitcnt vmcnt(0)" ::: "memory");
    __syncthreads();
    if (threadIdx.x == 0) {
        unsigned* bar = b.bar;
        __builtin_amdgcn_s_waitcnt(0);
        unsigned nloc = b.st[0], nx = b.st[1];
        if (nloc == 0u) { xcd_barrier_complete(bar, b.x, nloc, nx); b.st[0] = nloc; b.st[1] = nx; }
        const unsigned old = xb_add(&bar[XB_XSUB(b.x)], 1u);
        const unsigned gen = old / nloc;
        if (old + 1u == (gen + 1u) * nloc) {
            __builtin_amdgcn_fence(__ATOMIC_RELEASE, "agent");
            asm volatile("s_waitcnt vmcnt(0)" ::: "memory");
            const unsigned og = xb_add(&bar[XB_TOP], 1u);
            const unsigned tg = og / nx;
            if (og + 1u == (tg + 1u) * nx) xb_add(&bar[XB_TOPGEN], 1u);
            else XB_SPIN(xb_ld(&bar[XB_TOPGEN]) == tg, bar);
            __builtin_amdgcn_fence(__ATOMIC_ACQUIRE, "agent");
            xb_add(&bar[XB_XGEN(b.x)], 1u);
            asm volatile("s_waitcnt vmcnt(0)" ::: "memory");
        } else {
            XB_SPIN(xb_ld(&bar[XB_XGEN(b.x)]) == gen, bar);
            __builtin_amdgcn_fence(__ATOMIC_ACQUIRE, "agent");
            asm volatile("s_waitcnt vmcnt(0)" ::: "memory");
        }
    }
    __syncthreads();
}


DI int mod_row(int pm) { return pm < 32 ? 0 : 1 + ((pm - 32) >> 3); }

constexpr int XBP = 2048;
struct EpiRes {
    const float* inA; const float* inB; bf16_t* XB; const float* gate;
    float* P; int accum;
    DI void operator()(const f32x4 (&acc)[2][2][4][2], const Unit& u, int wr, int wc, int fr, int fq) const {
        const int col0 = u.pn * 256 + wc * 64 + 4 * fq;
        const float* gp = gate + mod_row(u.pm) * MODW + col0;
        f32x4 gv[2][2];
#pragma unroll
        for (int bj = 0; bj < 2; ++bj)
#pragma unroll
            for (int n = 0; n < 2; ++n) gv[bj][n] = *(const f32x4*)(gp + 32 * bj + 16 * n);
        const int row0 = u.pm * 256 + wr * 64 + fr;
        const float* xin = inA ? ((u.pm < 32) ? inA + (size_t)row0 * DM : inB + (size_t)(row0 - NPR) * DM) : nullptr;
#pragma unroll
        for (int ai = 0; ai < 2; ++ai)
#pragma unroll
            for (int m = 0; m < 4; ++m) {
                const size_t ro = (size_t)(ai * 128 + m * 16) * DM + col0;
                bf16_t* xp = XB + (size_t)(row0 + ai * 128 + m * 16) * XBP + col0;
#pragma unroll
                for (int bj = 0; bj < 2; ++bj)
#pragma unroll
                    for (int n = 0; n < 2; ++n) {
                        if (u.mode == 0) {
                            f32x4 x;
                            if (xin) x = *(const f32x4*)(xin + ro + 32 * bj + 16 * n);
                            else { const u32x2 w = *(const u32x2*)(xp + 32 * bj + 16 * n); x = (f32x4){bflo(w.x), bfhi(w.x), bflo(w.y), bfhi(w.y)}; }
                            x = x + gv[bj][n] * acc[ai][bj][m][n];
                            u32x2 o; o.x = pk2(x.x, x.y); o.y = pk2(x.z, x.w);
                            *(u32x2*)(xp + 32 * bj + 16 * n) = o;
                        } else {
                            f32x4* pp = (f32x4*)(P + (size_t)(row0 - 16384) * DM + ro + 32 * bj + 16 * n);
                            f32x4 v = gv[bj][n] * acc[ai][bj][m][n];
                            if (accum) v = v + *pp;
                            *pp = v;
                        }
                    }
            }
    }
};

template <int ACT> struct EpiBf16 {
    bf16_t* O; int ldc;
    DI void operator()(const f32x4 (&acc)[2][2][4][2], const Unit& u, int wr, int wc, int fr, int fq) const {
        const int col0 = u.pn * 256 + wc * 64 + 4 * fq;
        const int row0 = u.pm * 256 + wr * 64 + fr;
#pragma unroll
        for (int ai = 0; ai < 2; ++ai)
#pragma unroll
            for (int m = 0; m < 4; ++m) {
                bf16_t* op = O + (size_t)(row0 + ai * 128 + m * 16) * ldc + col0;
#pragma unroll
                for (int bj = 0; bj < 2; ++bj)
#pragma unroll
                    for (int n = 0; n < 2; ++n) {
                        f32x4 v = acc[ai][bj][m][n];
                        if (ACT == 1) { v.x = fmaxf(v.x, 0.f); v.y = fmaxf(v.y, 0.f); v.z = fmaxf(v.z, 0.f); v.w = fmaxf(v.w, 0.f); v = v * v; }
                        u32x2 w; w.x = pk2(v.x, v.y); w.y = pk2(v.z, v.w);
                        *(u32x2*)(op + 32 * bj + 16 * n) = w;
                    }
            }
    }
};

struct EpiQKV1 {
    bf16_t* QKV; float* AB; bf16_t* ZL; int zp; bf16_t* HALO;
    DI void operator()(const f32x4 (&acc)[2][2][4][2], const Unit& u, int wr, int wc, int fr, int fq) const {
        asm volatile("" : "+v"(fr), "+v"(fq));
        const int row0 = u.pm * 256 + wr * 64 + fr;
        if (u.pn < 12) {
            const int col0 = u.pn * 256 + wc * 64 + 4 * fq;
#pragma unroll
            for (int ai = 0; ai < 2; ++ai)
#pragma unroll
                for (int m = 0; m < 4; ++m) {
                    bf16_t* op = QKV + (size_t)(row0 + ai * 128 + m * 16) * 3072 + col0;
#pragma unroll
                    for (int bj = 0; bj < 2; ++bj)
#pragma unroll
                        for (int n = 0; n < 2; ++n) {
                            const f32x4 v = acc[ai][bj][m][n];
                            u32x2 w; w.x = pk2(v.x, v.y); w.y = pk2(v.z, v.w);
                            *(u32x2*)(op + 32 * bj + 16 * n) = w;
                            if ((m == 0 && fr == 0) || (m == 3 && fr == 15))
                                *(u32x2*)(HALO + ((size_t)((row0 + ai * 128 + m * 16) >> 6) * 2 + (m == 3 ? 1 : 0)) * 3072 + col0 + 32 * bj + 16 * n) = w;
                        }
                }
        } else if (u.pn > 12) {
            const int col0 = (u.pn - 13) * 256 + wc * 64 + 4 * fq;
#pragma unroll
            for (int ai = 0; ai < 2; ++ai)
#pragma unroll
                for (int m = 0; m < 4; ++m) {
                    bf16_t* op = ZL + (size_t)(row0 + ai * 128 + m * 16) * zp + col0;
#pragma unroll
                    for (int bj = 0; bj < 2; ++bj)
#pragma unroll
                        for (int n = 0; n < 2; ++n) {
                            const f32x4 v = acc[ai][bj][m][n];
                            u32x2 w; w.x = pk2(v.x, v.y); w.y = pk2(v.z, v.w);
                            *(u32x2*)(op + 32 * bj + 16 * n) = w;
                        }
                }
        } else if (wc == 0) {
#pragma unroll
            for (int ai = 0; ai < 2; ++ai)
#pragma unroll
                for (int m = 0; m < 4; ++m) {
                    float* op = AB + (size_t)(row0 + ai * 128 + m * 16) * 32 + 4 * fq;
#pragma unroll
                    for (int n = 0; n < 2; ++n) *(f32x4*)(op + 16 * n) = acc[ai][0][m][n];
                }
        }
    }
};

struct EpiQKV0 {
    bf16_t *Q, *KS, *VTS, *KP, *VTP; float *newk, *newv;
    const float *qna, *kna, *qnb, *knb;
    DI void operator()(const f32x4 (&acc)[2][2][4][2], const Unit& u, int wr, int wc, int fr, int fq) const {
        asm volatile("" : "+v"(fr), "+v"(fq));
        const int pn = u.pn; const bool prompt = u.pm < 32;
        int type, head; const float* gain = qna; bool rope = false;
        if (pn < 2) { type = 0; head = 4 * pn + wc; gain = qna; rope = true; }
        else if (pn == 2) { if (wc < 2) { type = 1; head = wc; gain = kna; rope = true; } else { type = 2; head = wc - 2; } }
        else if (pn < 5) { type = 0; head = 8 + 4 * (pn - 3) + wc; gain = qnb; }
        else if (pn < 7) { type = 1; head = 2 + 4 * (pn - 5) + wc; gain = knb; }
        else { type = 2; head = 2 + 4 * (pn - 7) + wc; }
        rope = rope && !prompt;
        float invf[4];
#pragma unroll
        for (int j = 0; j < 4; ++j) invf[j] = __builtin_amdgcn_exp2f(-(float)(4 * fq + j) * 0.83048202372184059f);
        const int row0 = u.pm * 256 + wr * 64 + fr;
#pragma unroll
        for (int ai = 0; ai < 2; ++ai)
#pragma unroll
            for (int m = 0; m < 4; ++m) {
                const int mg = row0 + ai * 128 + m * 16;
                f32x4 v[2][2];
#pragma unroll
                for (int bj = 0; bj < 2; ++bj)
#pragma unroll
                    for (int n = 0; n < 2; ++n) v[bj][n] = acc[ai][bj][m][n];
                if (type != 2) {
                    float ss = 0.f;
#pragma unroll
                    for (int bj = 0; bj < 2; ++bj)
#pragma unroll
                        for (int n = 0; n < 2; ++n) { const f32x4 x = v[bj][n]; ss += (x.x * x.x + x.y * x.y) + (x.z * x.z + x.w * x.w); }
                    ss += __shfl_xor(ss, 16); ss += __shfl_xor(ss, 32);
                    const float rinv = __builtin_amdgcn_rsqf(ss * (1.0f / 64.0f) + 1e-6f);
#pragma unroll
                    for (int bj = 0; bj < 2; ++bj)
#pragma unroll
                        for (int n = 0; n < 2; ++n) v[bj][n] = v[bj][n] * rinv * *(const f32x4*)(gain + 32 * bj + 16 * n + 4 * fq);
                    if (rope) {
                        const int t = (mg - NPR) & 2047;
                        const float pos[2] = {(float)(t >> 6), (float)(t & 63)};
#pragma unroll
                        for (int bj = 0; bj < 2; ++bj)
#pragma unroll
                            for (int j = 0; j < 4; ++j) {
                                const float ang = pos[bj] * invf[j];
                                const float cs = __cosf(ang), sn = __sinf(ang);
                                const float x1 = v[bj][0][j], x2 = v[bj][1][j];
                                v[bj][0][j] = x1 * cs - x2 * sn; v[bj][1][j] = x2 * cs + x1 * sn;
                            }
                    }
                }
                int b, t, ntile; bf16_t* kbase; bf16_t* vbase;
                if (prompt) { b = mg >> 8; t = mg & 255; ntile = 8; kbase = KP; vbase = VTP; }
                else { b = (mg - NPR) >> 11; t = (mg - NPR) & 2047; ntile = 72; kbase = KS; vbase = VTS; }
                const size_t tbase = ((size_t)(b * 10 + head) * ntile + (t >> 5)) * 2048; const int kk = t & 31;
#pragma unroll
                for (int bj = 0; bj < 2; ++bj)
#pragma unroll
                    for (int n = 0; n < 2; ++n) {
                        const int d0 = 32 * bj + 16 * n + 4 * fq;
                        const f32x4 x = v[bj][n];
                        if (type == 0) { u32x2 w; w.x = pk2(x.x, x.y); w.y = pk2(x.z, x.w); *(u32x2*)(Q + (size_t)mg * 1024 + head * 64 + d0) = w; }
                        else if (type == 1) {
                            u32x2 w; w.x = pk2(x.x, x.y); w.y = pk2(x.z, x.w); *(u32x2*)(kbase + tbase + ((d0 >> 3) * 32 + kk) * 8 + (d0 & 7)) = w;
                            if (prompt) *(f32x4*)(newk + (size_t)mg * 640 + head * 64 + d0) = x;
                        } else {
                            bf16_t* vp = vbase + tbase + ((((((d0 >> 5) * 2 + (kk >> 4)) * 2 + ((kk >> 3) & 1)) * 2 + ((kk >> 2) & 1)) * 32 + (d0 & 31)) << 2) + (kk & 3);
                            const unsigned w0 = pk2(x.x, x.y), w1 = pk2(x.z, x.w);
                            vp[0] = (bf16_t)(w0 & 0xffffu); vp[4] = (bf16_t)(w0 >> 16); vp[8] = (bf16_t)(w1 & 0xffffu); vp[12] = (bf16_t)(w1 >> 16);
                            if (prompt) *(f32x4*)(newv + (size_t)mg * 640 + head * 64 + d0) = x;
                        }
                    }
                asm volatile("" ::: "memory");
            }
    }
};

DI float wave_sum(float v) {
#pragma unroll
    for (int o = 1; o < 64; o <<= 1) v += __shfl_xor(v, o);
    return v;
}
DI int perm_row32(int n0) { return (n0 & ~255) + 128 * ((n0 >> 5) & 1) + 32 * ((n0 >> 6) & 3); }

DI void transpose_item(const float* W, int N, int k0, int n0, bf16_t* WT, int ldt, int row0, LAS float* scr, int lane) {
#pragma unroll 8
    for (int i = 0; i < 32; ++i) { const int kk = 2 * i + (lane >> 5); scr[kk * 33 + (lane & 31)] = W[(size_t)(k0 + kk) * N + n0 + (lane & 31)]; }
    asm volatile("s_waitcnt lgkmcnt(0)" ::: "memory");
    const int c = lane & 7;
#pragma unroll
    for (int j = 0; j < 4; ++j) { const int n = (lane >> 3) + 8 * j; const LAS float* s = scr + (8 * c) * 33 + n;
        u32x4 o; o.x = pk2(s[0 * 33], s[1 * 33]); o.y = pk2(s[2 * 33], s[3 * 33]); o.z = pk2(s[4 * 33], s[5 * 33]); o.w = pk2(s[6 * 33], s[7 * 33]);
        *(u32x4*)(WT + (size_t)(row0 + n) * ldt + k0 + 8 * c) = o; }
    asm volatile("s_waitcnt lgkmcnt(0)" ::: "memory");
}
DI void transpose_matrix(const float* W, int K, int N, bf16_t* WT, LAS float* scr, int gw, int NGW, int lane) {
    const int nblk = N / 32, nitems = (K / 64) * nblk;
    for (int it = gw; it < nitems; it += NGW) { const int kb = it / nblk, nb = it % nblk; transpose_item(W, N, kb * 64, nb * 32, WT, K, perm_row32(nb * 32), scr, lane); }
}

DI void norm_phase(const float* xa, const float* xb, bf16_t* XB, const float* gain, const float* sh, const float* sc, bf16_t* H, int hp, int gw, int NGW, int lane, const float* P = nullptr) {
    for (int m0 = gw; m0 < NTOK; m0 += 2 * NGW) {
        const int m1 = m0 + NGW; const bool has1 = m1 < NTOK; const int m1c = has1 ? m1 : m0;
        f32x4 v0[4], v1[4];
        if (XB) {
#pragma unroll
            for (int j = 0; j < 4; ++j) {
                const u32x2 w0 = *(const u32x2*)(XB + (size_t)m0 * XBP + 4 * lane + 256 * j), w1 = *(const u32x2*)(XB + (size_t)m1c * XBP + 4 * lane + 256 * j);
                v0[j] = (f32x4){bflo(w0.x), bfhi(w0.x), bflo(w0.y), bfhi(w0.y)}; v1[j] = (f32x4){bflo(w1.x), bfhi(w1.x), bflo(w1.y), bfhi(w1.y)};
            }
        } else {
            const float* xr0 = (m0 < NPR) ? xa + (size_t)m0 * DM : xb + (size_t)(m0 - NPR) * DM;
            const float* xr1 = (m1c < NPR) ? xa + (size_t)m1c * DM : xb + (size_t)(m1c - NPR) * DM;
#pragma unroll
            for (int j = 0; j < 4; ++j) { v0[j] = *(const f32x4*)(xr0 + 4 * lane + 256 * j); v1[j] = *(const f32x4*)(xr1 + 4 * lane + 256 * j); }
        }
        if (P) {
#pragma unroll
            for (int j = 0; j < 4; ++j) {
                if (m0 >= 16384) { v0[j] = v0[j] + *(const f32x4*)(P + (size_t)(m0 - 16384) * DM + 4 * lane + 256 * j);
                    u32x2 o; o.x = pk2(v0[j].x, v0[j].y); o.y = pk2(v0[j].z, v0[j].w); *(u32x2*)(XB + (size_t)m0 * XBP + 4 * lane + 256 * j) = o; }
                if (has1 && m1 >= 16384) { v1[j] = v1[j] + *(const f32x4*)(P + (size_t)(m1 - 16384) * DM + 4 * lane + 256 * j);
                    u32x2 o; o.x = pk2(v1[j].x, v1[j].y); o.y = pk2(v1[j].z, v1[j].w); *(u32x2*)(XB + (size_t)m1 * XBP + 4 * lane + 256 * j) = o; }
            }
        }
        float s0 = 0.f, s1 = 0.f;
#pragma unroll
        for (int j = 0; j < 4; ++j) { s0 += (v0[j].x * v0[j].x + v0[j].y * v0[j].y) + (v0[j].z * v0[j].z + v0[j].w * v0[j].w); s1 += (v1[j].x * v1[j].x + v1[j].y * v1[j].y) + (v1[j].z * v1[j].z + v1[j].w * v1[j].w); }
        const float r0 = __builtin_amdgcn_rsqf(wave_sum(s0) * (1.0f / DM) + 1e-6f), r1 = __builtin_amdgcn_rsqf(wave_sum(s1) * (1.0f / DM) + 1e-6f);
        const int mr0 = (m0 < NPR) ? 0 : 1 + ((m0 - NPR) >> 11), mr1 = (m1c < NPR) ? 0 : 1 + ((m1c - NPR) >> 11);
#pragma unroll
        for (int j = 0; j < 4; ++j) {
            const int c = 4 * lane + 256 * j;
            const f32x4 g = *(const f32x4*)(gain + c);
            { const f32x4 a = *(const f32x4*)(sc + mr0 * MODW + c), b = *(const f32x4*)(sh + mr0 * MODW + c);
              const f32x4 o = v0[j] * r0 * g * (a + 1.0f) + b; u32x2 w; w.x = pk2(o.x, o.y); w.y = pk2(o.z, o.w); *(u32x2*)(H + (size_t)m0 * hp + c) = w; }
            if (has1) { const f32x4 a = *(const f32x4*)(sc + mr1 * MODW + c), b = *(const f32x4*)(sh + mr1 * MODW + c);
              const f32x4 o = v1[j] * r1 * g * (a + 1.0f) + b; u32x2 w; w.x = pk2(o.x, o.y); w.y = pk2(o.z, o.w); *(u32x2*)(H + (size_t)m1 * hp + c) = w; }
        }
    }
}

#define MFMA32(a, b, c) __builtin_amdgcn_mfma_f32_32x32x16_bf16((a), (b), (c), 0, 0, 0)
template <int NH, bool NA>
DI void attn_unit(const bf16_t* Qrow, const bf16_t* Kp, const bf16_t* VTp, int vstride,
                  int seg0_start, int seg0_tiles, int seg1_start, int seg1_tiles,
                  const LAS float* biasH, int qr, int c0, float shift, bf16_t* Orow, int lane) {
    const int r = lane & 31, hh = lane >> 5;
    bf16x8 Qf[NH][4];
#pragma unroll
    for (int h = 0; h < NH; ++h)
#pragma unroll
        for (int s = 0; s < 4; ++s) Qf[h][s] = *(const bf16x8*)(Qrow + (size_t)r * 1024 + (NA ? 32 * 1024 : 64) * h + 16 * s + 8 * hh);
    f32x16 O[NH][2]; float mrun[NH], lrun[NH];
#pragma unroll
    for (int h = 0; h < NH; ++h) { mrun[h] = -1e30f; lrun[h] = 0.f;
#pragma unroll
        for (int b = 0; b < 2; ++b)
#pragma unroll
            for (int i = 0; i < 16; ++i) O[h][b][i] = 0.f; }
    const float SC = 0.125f * 1.4426950408889634f;
    const int ntiles = seg0_tiles + seg1_tiles;
    bf16x8 Kn[4]; s16x4 Vln[2][2], Vhn[2][2];
    {
        const int k0 = seg0_tiles > 0 ? seg0_start : seg1_start;
        const bf16_t* kt = Kp + (size_t)(k0 >> 5) * 2048; const bf16_t* vt = VTp + (size_t)(k0 >> 5) * 2048;
#pragma unroll
        for (int s = 0; s < 4; ++s) Kn[s] = *(const bf16x8*)(kt + (s * 64 + lane) * 8);
#pragma unroll
        for (int b = 0; b < 2; ++b)
#pragma unroll
            for (int s = 0; s < 2; ++s) { Vln[b][s] = *(const s16x4*)(vt + (((b * 2 + s) * 2 + 0) * 64 + lane) * 4); Vhn[b][s] = *(const s16x4*)(vt + (((b * 2 + s) * 2 + 1) * 64 + lane) * 4); }
    }
    for (int ti = 0; ti < ntiles; ++ti) {
        const bool loc = ti < seg0_tiles;
        const int k0 = loc ? seg0_start + 32 * ti : seg1_start + 32 * (ti - seg0_tiles);
        bf16x8 Kf[4]; s16x4 Vlo[2][2], Vhi[2][2];
#pragma unroll
        for (int s = 0; s < 4; ++s) Kf[s] = Kn[s];
#pragma unroll
        for (int b = 0; b < 2; ++b)
#pragma unroll
            for (int s = 0; s < 2; ++s) { Vlo[b][s] = Vln[b][s]; Vhi[b][s] = Vhn[b][s]; }
        {
            const int tn = min(ti + 1, ntiles - 1);
            const int k1 = (tn < seg0_tiles) ? seg0_start + 32 * tn : seg1_start + 32 * (tn - seg0_tiles);
            const bf16_t* kt = Kp + (size_t)(k1 >> 5) * 2048; const bf16_t* vt = VTp + (size_t)(k1 >> 5) * 2048;
#pragma unroll
            for (int s = 0; s < 4; ++s) Kn[s] = *(const bf16x8*)(kt + (s * 64 + lane) * 8);
#pragma unroll
            for (int b = 0; b < 2; ++b)
#pragma unroll
                for (int s = 0; s < 2; ++s) { Vln[b][s] = *(const s16x4*)(vt + (((b * 2 + s) * 2 + 0) * 64 + lane) * 4); Vhn[b][s] = *(const s16x4*)(vt + (((b * 2 + s) * 2 + 1) * 64 + lane) * 4); }
        }
#pragma unroll
        for (int h = 0; h < NH; ++h) {
            f32x16 st;
#pragma unroll
            for (int i = 0; i < 16; ++i) st[i] = 0.f;
#pragma unroll
            for (int s = 0; s < 4; ++s) st = MFMA32(Kf[s], Qf[h][s], st);
            float ps = 0.f;
            if (NA && loc) {
                const int c = c0 + 32 * h + r, cs = min(max(c - 8, 0), 48);
                const int d0 = (k0 & 63) + 4 * hh - cs;
                const int b0 = ((k0 >> 6) - qr + 7) * 31 + (cs - c + 15);
#pragma unroll
                for (int i = 0; i < 16; ++i) {
                    const int d = d0 + (i & 3) + 8 * (i >> 2);
                    const bool valid = (unsigned)d < 16u;
                    const float bv = biasH[valid ? b0 + d : 0];
                    const float x = valid ? st[i] * SC - shift + bv * 1.4426950408889634f : -1e30f;
                    const float p = __builtin_amdgcn_exp2f(x); st[i] = p; ps += p;
                }
            } else {
#pragma unroll
                for (int i = 0; i < 16; ++i) { const float p = __builtin_amdgcn_exp2f(st[i] * SC - shift); st[i] = p; ps += p; }
            }
            lrun[h] += ps;
#pragma unroll
            for (int s = 0; s < 2; ++s) {
                u32x4 pw; pw.x = pk2(st[8 * s + 0], st[8 * s + 1]); pw.y = pk2(st[8 * s + 2], st[8 * s + 3]); pw.z = pk2(st[8 * s + 4], st[8 * s + 5]); pw.w = pk2(st[8 * s + 6], st[8 * s + 7]);
                const bf16x8 Pf = __builtin_bit_cast(bf16x8, pw);
#pragma unroll
                for (int b = 0; b < 2; ++b) {
                    const bf16x8 Vf = __builtin_shufflevector(Vlo[b][s], Vhi[b][s], 0, 1, 2, 3, 4, 5, 6, 7);
                    O[h][b] = MFMA32(Vf, Pf, O[h][b]);
                }
            }
        }
    }
#pragma unroll
    for (int h = 0; h < NH; ++h) {
        const float lt = lrun[h] + __shfl_xor(lrun[h], 32);
        const float inv = 1.0f / lt;
#pragma unroll
        for (int b = 0; b < 2; ++b)
#pragma unroll
            for (int g = 0; g < 4; ++g) {
                u32x2 w; w.x = pk2(O[h][b][4 * g] * inv, O[h][b][4 * g + 1] * inv); w.y = pk2(O[h][b][4 * g + 2] * inv, O[h][b][4 * g + 3] * inv);
                *(u32x2*)(Orow + (size_t)r * 1024 + (NA ? 32 * 1024 : 64) * h + 32 * b + 8 * g + 4 * hh) = w;
            }
    }
}

DI float wave_max(float v) {
#pragma unroll
    for (int o = 1; o < 64; o <<= 1) v = fmaxf(v, __shfl_xor(v, o));
    return v;
}
DI void attention_phase(const bf16_t* Q, const bf16_t* KS, const bf16_t* VTS, const bf16_t* KP, const bf16_t* VTP, const LAS float* rel_bias, const float* qna, const float* kna, const float* qnb, const float* knb,
                        bf16_t* AO, int gw, int NGW, int lane) {
    const float L2E = 1.4426950408889634f;
    const float shiftA = 8.0f * wave_max(fabsf(qna[lane])) * wave_max(fabsf(kna[lane])) * L2E;
    const float boundB = 8.0f * wave_max(fabsf(qnb[lane])) * wave_max(fabsf(knb[lane]));
    float bm = 0.f;
    for (int i = lane; i < 3720; i += 64) bm = fmaxf(bm, fabsf(rel_bias[i]));
    const float shiftB = boundB * L2E, shiftN = (boundB + wave_max(bm)) * L2E;
    for (int U = gw; U < 7168; U += NGW) {
        if (U < 2048) {
            const int u = U, b = u >> 8, kv = (u >> 7) & 1, gp = (u >> 6) & 1, qt = u & 63;
            const int m0 = NPR + b * 2048 + qt * 32, qc = (kv * 4 + gp * 2) * 64;
            attn_unit<2, false>(Q + (size_t)m0 * 1024 + qc, KS + (size_t)(b * 10 + kv) * 72 * 2048, VTS + (size_t)(b * 10 + kv) * 72 * 2048, 2304, 0, 72, 0, 0, nullptr, 0, 0, shiftA, AO + (size_t)m0 * 1024 + qc, lane);
        } else if (U < 4096) {
            const int u = U - 2048, b = u >> 8, h = (u >> 5) & 7, qr = u & 31;
            const int m0 = NPR + b * 2048 + qr * 64, qc = 512 + h * 64;
            const int rs = min(max(qr - 4, 0), 24);
            attn_unit<2, true>(Q + (size_t)m0 * 1024 + qc, KS + (size_t)(b * 10 + 2 + h) * 72 * 2048, VTS + (size_t)(b * 10 + 2 + h) * 72 * 2048, 2304, rs * 64, 16, 2048, 8, rel_bias + h * 465, qr, 0, shiftN, AO + (size_t)m0 * 1024 + qc, lane);
        } else if (U < 5120) {
            const int u = U - 4096, b = u >> 5, kv = (u >> 4) & 1, gp = (u >> 3) & 1, qt = u & 7;
            const int m0 = b * 256 + qt * 32, qc = (kv * 4 + gp * 2) * 64;
            attn_unit<2, false>(Q + (size_t)m0 * 1024 + qc, KP + (size_t)(b * 10 + kv) * 8 * 2048, VTP + (size_t)(b * 10 + kv) * 8 * 2048, 256, 0, 8, 0, 0, nullptr, 0, 0, shiftA, AO + (size_t)m0 * 1024 + qc, lane);
        } else {
            const int u = U - 5120, b = u >> 6, h = (u >> 3) & 7, qt = u & 7;
            const int m0 = b * 256 + qt * 32, qc = 512 + h * 64;
            attn_unit<1, false>(Q + (size_t)m0 * 1024 + qc, KP + (size_t)(b * 10 + 2 + h) * 8 * 2048, VTP + (size_t)(b * 10 + 2 + h) * 8 * 2048, 256, 0, 8, 0, 0, nullptr, 0, 0, shiftB, AO + (size_t)m0 * 1024 + qc, lane);
        }
    }
}

DI float quad_sum(float x) {
    x += __builtin_bit_cast(float, __builtin_amdgcn_mov_dpp(__builtin_bit_cast(int, x), 0xB1, 0xF, 0xF, true));
    x += __builtin_bit_cast(float, __builtin_amdgcn_mov_dpp(__builtin_bit_cast(int, x), 0x4E, 0xF, 0xF, true));
    return x;
}
DI void delta_unit(LAS unsigned char* lds, const bf16_t* QKV, const float* AB, const float* conv_w, float Aexp, float dtb,
                   int m0, int T, int h, int dir, const float* s0  , float* sfin  , bf16_t* OUT) {
    const int tid = opq(threadIdx.x), wid = tid >> 6, lane = tid & 63, kq = lane & 3, vl = lane >> 2, v = 16 * wid + vl;
    LAS float* sQ = (LAS float*)lds; LAS float* sK = sQ + 32 * 128; LAS float* sV = sK + 32 * 128; LAS float* sA = sV + 32 * 128; LAS float* sB = sA + 32;
    float S[32];
#pragma unroll
    for (int i = 0; i < 32; ++i) S[i] = s0 ? s0[(size_t)(kq * 32 + i) * 128 + v] : 0.f;
    const int nblk = T / 32;
    for (int blk = 0; blk < nblk; ++blk) {
        const int t0 = (dir ? nblk - 1 - blk : blk) * 32;
        {
            const int tl = tid >> 4, cg = tid & 15, t = t0 + tl;
#pragma unroll
            for (int part = 0; part < 3; ++part) {
                const int col = part * 1024 + h * 128 + cg * 8;
                const bf16_t* base = QKV + (size_t)(m0 + t) * 3072 + col;
                u32x4 xm = {0u, 0u, 0u, 0u}, xp = {0u, 0u, 0u, 0u};
                const u32x4 x0 = *(const u32x4*)base;
                if (t > 0) xm = *(const u32x4*)(base - 3072);
                if (t < T - 1) xp = *(const u32x4*)(base + 3072);
                float o[8];
#pragma unroll
                for (int e = 0; e < 4; ++e) {
                    const f32x2 w0 = *(const f32x2*)(conv_w + col + 2 * e), w1 = *(const f32x2*)(conv_w + 3072 + col + 2 * e), w2 = *(const f32x2*)(conv_w + 6144 + col + 2 * e);
                    const float a0 = w0.x * bflo(xm[e]) + w1.x * bflo(x0[e]) + w2.x * bflo(xp[e]);
                    const float a1 = w0.y * bfhi(xm[e]) + w1.y * bfhi(x0[e]) + w2.y * bfhi(xp[e]);
                    o[2 * e] = siluf_(a0); o[2 * e + 1] = siluf_(a1);
                }
                LAS float* dst = (part == 0 ? sQ : (part == 1 ? sK : sV)) + tl * 128 + cg * 8;
                *(LAS f32x4*)dst = (f32x4){o[0], o[1], o[2], o[3]}; *(LAS f32x4*)(dst + 4) = (f32x4){o[4], o[5], o[6], o[7]};
            }
        }
        __syncthreads();
        {
            const int row = tid >> 3, sub = tid & 7;
            LAS float* p = (row < 32 ? sQ + row * 128 : sK + (row - 32) * 128) + sub * 16;
            f32x4 x[4]; float ss = 0.f;
#pragma unroll
            for (int i = 0; i < 4; ++i) { x[i] = *(LAS f32x4*)(p + 4 * i); ss += (x[i].x * x[i].x + x[i].y * x[i].y) + (x[i].z * x[i].z + x[i].w * x[i].w); }
            ss += __shfl_xor(ss, 1); ss += __shfl_xor(ss, 2); ss += __shfl_xor(ss, 4);
            const float sc = __builtin_amdgcn_rsqf(ss + 1e-6f) * (row < 32 ? 0.08838834764831845f : 1.0f);
#pragma unroll
            for (int i = 0; i < 4; ++i) *(LAS f32x4*)(p + 4 * i) = x[i] * sc;
            if (tid < 32) {
                const float* ab = AB + (size_t)(m0 + t0 + tid) * 32 + dir * 8 + h;
                const float xa = ab[0] + dtb, xb = ab[16];
                const float sp = xa > 20.f ? xa : log1pf(__expf(xa));
                sA[tid] = __expf(-Aexp * sp); sB[tid] = sigmoidf_(xb);
            }
        }
        __syncthreads();
        for (int i = 0; i < 32; ++i) {
            const int tl = dir ? 31 - i : i;
            const LAS float* kp = sK + tl * 128 + kq * 32; const LAS float* qp = sQ + tl * 128 + kq * 32;
            const float a = sA[tl], b = sB[tl], vt = sV[tl * 128 + v];
            f32x4 kk[8];
#pragma unroll
            for (int j = 0; j < 8; ++j) kk[j] = *(const LAS f32x4*)(kp + 4 * j);
            float ks = 0.f;
#pragma unroll
            for (int j = 0; j < 8; ++j) ks += (kk[j].x * S[4 * j] + kk[j].y * S[4 * j + 1]) + (kk[j].z * S[4 * j + 2] + kk[j].w * S[4 * j + 3]);
            ks = quad_sum(ks);
            const float d = b * (vt - a * ks);
            f32x4 qq[8];
#pragma unroll
            for (int j = 0; j < 8; ++j) qq[j] = *(const LAS f32x4*)(qp + 4 * j);
            float os = 0.f;
#pragma unroll
            for (int j = 0; j < 8; ++j) {
                S[4 * j] = a * S[4 * j] + kk[j].x * d; S[4 * j + 1] = a * S[4 * j + 1] + kk[j].y * d; S[4 * j + 2] = a * S[4 * j + 2] + kk[j].z * d; S[4 * j + 3] = a * S[4 * j + 3] + kk[j].w * d;
                os += (qq[j].x * S[4 * j] + qq[j].y * S[4 * j + 1]) + (qq[j].z * S[4 * j + 2] + qq[j].w * S[4 * j + 3]);
            }
            os = quad_sum(os);
            if (kq == 0) OUT[(size_t)(m0 + t0 + tl) * 1024 + h * 128 + v] = (bf16_t)(pk2(os, 0.f) & 0xffffu);
        }
        __syncthreads();
    }
    if (sfin) {
#pragma unroll
        for (int i = 0; i < 32; ++i) sfin[(size_t)(kq * 32 + i) * 128 + v] = S[i];
    }
}


constexpr int DP128 = 136, DP64 = 72;
constexpr int DL_QN = 0, DL_KN = 17408, DL_KNT = 34816, DL_VT = 53248, DL_ST = 71680, DL_ATT = 106496, DL_TM = 115712, DL_RT = 124928, DL_GATE = 143360;
constexpr int DL_AL1 = DL_KNT, DL_AL2 = DL_KNT + 9216, DL_TDT = DL_VT, DL_P1T = DL_VT + 9216, DL_T1 = DL_ST, DL_T1T = DL_ST + 9216, DL_AD = DL_ST + 18432;
constexpr int DL_VNT = DL_QN, DL_VNST = DL_VT, DL_CW = DL_GATE + 2048;
static_assert(DL_CW + 4608 <= LDS_BYTES, "delta LDS map");

DI int crow_(int i, int hh) { return (i & 3) + 8 * (i >> 2) + 4 * hh; }
DI bf16x8 ldfrag(const LAS bf16_t* base, int row, int pitch, int koff) { return *(const LAS bf16x8*)(base + row * pitch + koff); }
DI void store_tileT(LAS bf16_t* XT, int pitch, int col, int row0, int hh, const f32x16& a, float sc) {
#pragma unroll
    for (int g = 0; g < 4; ++g) { u32x2 w; w.x = pk2(a[4 * g] * sc, a[4 * g + 1] * sc); w.y = pk2(a[4 * g + 2] * sc, a[4 * g + 3] * sc);
        *(LAS u32x2*)(XT + col * pitch + row0 + 8 * g + 4 * hh) = w; }
}
DI void store_tileR(LAS bf16_t* X, int pitch, int col, int row0, int hh, const f32x16& a) {
#pragma unroll
    for (int i = 0; i < 16; ++i) X[(row0 + crow_(i, hh)) * pitch + col] = (bf16_t)(pk2(a[i], 0.f) & 0xffffu);
}
DI f32x16 mm64_tile(const LAS bf16_t* A, const LAS bf16_t* BT, int ib, int jb, int r, int hh, f32x16 acc) {
#pragma unroll
    for (int s = 0; s < 4; ++s) acc = MFMA32(ldfrag(A, 32 * ib + r, DP64, 16 * s + 8 * hh), ldfrag(BT, 32 * jb + r, DP64, 16 * s + 8 * hh), acc);
    return acc;
}

#ifdef PROBE_D1
#define REP_D1 _Pragma("unroll 1") for (int rep_ = 0; rep_ < 2; ++rep_)
#else
#define REP_D1
#endif
#ifdef PROBE_D3
#define REP_D3 _Pragma("unroll 1") for (int rep_ = 0; rep_ < 2; ++rep_)
#else
#define REP_D3
#endif
#ifdef PROBE_D6
#define REP_D6 _Pragma("unroll 1") for (int rep_ = 0; rep_ < 2; ++rep_)
#else
#define REP_D6
#endif
DI void delta_unit_chunked(LAS unsigned char* lds, const bf16_t* QKV, const float* AB, const float* conv_w, float Aexp, float dtb,
                           int m0, int T, int h, int dir, const float* s0, float* sfin, bf16_t* OUT) {
    const int tid0 = opq(threadIdx.x), w0 = __builtin_amdgcn_readfirstlane(tid0 >> 6);
    LAS bf16_t* QN = (LAS bf16_t*)(lds + DL_QN); LAS bf16_t* KN = (LAS bf16_t*)(lds + DL_KN); LAS bf16_t* KNT = (LAS bf16_t*)(lds + DL_KNT); LAS bf16_t* VT = (LAS bf16_t*)(lds + DL_VT);
    LAS bf16_t* ST = (LAS bf16_t*)(lds + DL_ST); LAS bf16_t* ATT = (LAS bf16_t*)(lds + DL_ATT); LAS bf16_t* TM = (LAS bf16_t*)(lds + DL_TM); LAS bf16_t* RT = (LAS bf16_t*)(lds + DL_RT);
    LAS float* GT = (LAS float*)(lds + DL_GATE);
    LAS bf16_t* AL1 = (LAS bf16_t*)(lds + DL_AL1); LAS bf16_t* AL2 = (LAS bf16_t*)(lds + DL_AL2); LAS bf16_t* TDT = (LAS bf16_t*)(lds + DL_TDT); LAS bf16_t* P1T = (LAS bf16_t*)(lds + DL_P1T);
    LAS bf16_t* T1 = (LAS bf16_t*)(lds + DL_T1); LAS bf16_t* T1T = (LAS bf16_t*)(lds + DL_T1T); LAS float* AD = (LAS float*)(lds + DL_AD);
    LAS bf16_t* VNT = (LAS bf16_t*)(lds + DL_VNT); LAS bf16_t* VNST = (LAS bf16_t*)(lds + DL_VNST);
    f32x16 Sacc[2];
    {
        const int lane = tid0 & 63, r = lane & 31, hh = lane >> 5, kb = w0 >> 1, vb0 = 2 * (w0 & 1);
#pragma unroll
        for (int e = 0; e < 2; ++e)
#pragma unroll
            for (int i = 0; i < 16; ++i) Sacc[e][i] = s0 ? s0[(size_t)(32 * kb + crow_(i, hh)) * 128 + 32 * (vb0 + e) + r] : 0.f;
    }
    LAS float* CW = (LAS float*)(lds + DL_CW);
    for (int i = tid0; i < 3 * 384; i += 512) { const int tap = i / 384, pc = i % 384; CW[i] = conv_w[tap * 3072 + (pc >> 7) * 1024 + h * 128 + (pc & 127)]; }
    __syncthreads();
    const int nch = T / 64;
    u32x4 xraw[3][4];
#define DELTA_LOAD_RAW(T0) do { const int tlo_ = (T0) + 2 * (tid0 >> 4), cg_ = tid0 & 15; \
        _Pragma("unroll") for (int part = 0; part < 3; ++part) _Pragma("unroll") for (int k = 0; k < 4; ++k) { \
            const int tt = tlo_ - 1 + k; const bool ok = (tt >= 0) && (tt < T); const int tc = min(max(tt, 0), T - 1); \
            u32x4 v_ = *(const u32x4*)(QKV + (size_t)(m0 + tc) * 3072 + part * 1024 + h * 128 + cg_ * 8); \
            if (!ok) v_ = (u32x4){0u, 0u, 0u, 0u}; xraw[part][k] = v_; } } while (0)
#ifdef DELTA_PREFETCH
    DELTA_LOAD_RAW((dir ? nch - 1 : 0) * 64);
#endif
#pragma unroll 1
    for (int ci = 0; ci < nch; ++ci) {
        const int tid = opq(threadIdx.x), w = __builtin_amdgcn_readfirstlane(tid >> 6), lane = tid & 63, r = lane & 31, hh = lane >> 5;
        const int kb = w >> 1, vb0 = 2 * (w & 1);
        const int t0 = (dir ? nch - 1 - ci : ci) * 64;
        u32x4 kpk[2], vpk[2];
        const int tlo = t0 + 2 * (tid >> 4);
#ifndef DELTA_PREFETCH
        DELTA_LOAD_RAW(t0);
#endif
        REP_D1 {
        {
            const int cg = tid & 15;
#pragma unroll
            for (int pass = 0; pass < 2; ++pass) {
                const int t = tlo + pass, i = dir ? t0 + 63 - t : t - t0;
                u32x4 pk[3];
#pragma unroll
                for (int part = 0; part < 3; ++part) {
                    const u32x4 xm = xraw[part][pass], x0 = xraw[part][pass + 1], xp = xraw[part][pass + 2];
                    float o[8]; float ss = 0.f;
#pragma unroll
                    for (int e = 0; e < 4; ++e) {
                        const f32x2 w0 = *(const LAS f32x2*)(CW + part * 128 + cg * 8 + 2 * e), w1 = *(const LAS f32x2*)(CW + 384 + part * 128 + cg * 8 + 2 * e), w2 = *(const LAS f32x2*)(CW + 768 + part * 128 + cg * 8 + 2 * e);
                        const float a0 = w0.x * bflo(xm[e]) + w1.x * bflo(x0[e]) + w2.x * bflo(xp[e]);
                        const float a1 = w0.y * bfhi(xm[e]) + w1.y * bfhi(x0[e]) + w2.y * bfhi(xp[e]);
                        o[2 * e] = siluf_(a0); o[2 * e + 1] = siluf_(a1);
                        ss += o[2 * e] * o[2 * e] + o[2 * e + 1] * o[2 * e + 1];
                    }
                    float sc = 1.0f;
                    if (part < 2) {
                        ss += __shfl_xor(ss, 1); ss += __shfl_xor(ss, 2); ss += __shfl_xor(ss, 4); ss += __shfl_xor(ss, 8);
                        sc = __builtin_amdgcn_rsqf(ss + 1e-6f) * (part == 0 ? 0.08838834764831845f : 1.0f);
                    }
                    pk[part].x = pk2(o[0] * sc, o[1] * sc); pk[part].y = pk2(o[2] * sc, o[3] * sc); pk[part].z = pk2(o[4] * sc, o[5] * sc); pk[part].w = pk2(o[6] * sc, o[7] * sc);
                }
                *(LAS u32x4*)(QN + i * DP128 + cg * 8) = pk[0];
                *(LAS u32x4*)(KN + i * DP128 + cg * 8) = pk[1];
                kpk[pass] = pk[1]; vpk[pass] = pk[2];
            }
        }
#ifdef DELTA_PREFETCH
        if (ci + 1 < nch) DELTA_LOAD_RAW((dir ? nch - 2 - ci : ci + 1) * 64);
#endif
        if (w == 0) {
            const int t = dir ? t0 + 63 - lane : t0 + lane;
            const float* ab = AB + (size_t)(m0 + t) * 32 + dir * 8 + h;
            const float xa = ab[0] + dtb, xb = ab[16];
            const float sp = xa > 20.f ? xa : log1pf(__expf(xa));
            float g = -Aexp * sp;
#pragma unroll
            for (int off = 1; off < 64; off <<= 1) { const float tmp = __shfl_up(g, off); if (lane >= off) g += tmp; }
            const float gl = __shfl(g, 63);
            GT[lane] = g; GT[64 + lane] = sigmoidf_(xb); GT[128 + lane] = __expf(g); GT[192 + lane] = __expf(gl - g);
            if (lane == 0) GT[256] = __expf(gl);
        }
        for (int i = tid; i < 64 * DP64 / 2; i += 512) { ((LAS unsigned*)TM)[i] = 0u; ((LAS unsigned*)TDT)[i] = 0u; }
        __syncthreads();
        }
        REP_D3 {
        {
            const int mat = w >> 2, ib = (w >> 1) & 1, jb = w & 1;
            f32x16 acc;
#pragma unroll
            for (int i = 0; i < 16; ++i) acc[i] = 0.f;
            if (ib >= jb) {
                const LAS bf16_t* X = mat ? QN : KN;
#pragma unroll
                for (int s = 0; s < 8; ++s) acc = MFMA32(ldfrag(X, 32 * ib + r, DP128, 16 * s + 8 * hh), ldfrag(KN, 32 * jb + r, DP128, 16 * s + 8 * hh), acc);
            }
            const int col = 32 * jb + r; const float gc = GT[col];
#pragma unroll
            for (int i = 0; i < 16; ++i) {
                const int row = 32 * ib + crow_(i, hh);
                const float dg = (row >= col) ? __expf(GT[row] - gc) : 0.f;
                if (mat == 0) {
                    const float a = (row > col) ? GT[64 + row] * acc[i] * dg : 0.f;
                    const bool same16 = (row >> 4) == (col >> 4), same32 = (row >> 5) == (col >> 5);
                    if (same16) AD[((row >> 4) * 16 + (row & 15)) * 20 + (col & 15)] = a;
                    AL1[row * DP64 + col] = (bf16_t)(pk2((same32 && !same16) ? a : 0.f, 0.f) & 0xffffu);
                    AL2[row * DP64 + col] = (bf16_t)(pk2(!same32 ? a : 0.f, 0.f) & 0xffffu);
                } else {
                    ATT[row * DP64 + col] = (bf16_t)(pk2((row >= col) ? acc[i] * dg : 0.f, 0.f) & 0xffffu);
                }
            }
        }
        __syncthreads();
        if (w == 0) {
            const int b = lane >> 4, c = lane & 15;
            const LAS float* ad = AD + b * 16 * 20;
            float X[16];
#pragma unroll
            for (int i = 0; i < 16; ++i) {
                float x = (i == c) ? 1.f : 0.f;
#pragma unroll
                for (int j4 = 0; j4 < (i + 3) / 4; ++j4) {
                    const f32x4 a = *(const LAS f32x4*)(ad + i * 20 + 4 * j4);
                    if (4 * j4 + 0 < i) x -= a.x * X[4 * j4 + 0];
                    if (4 * j4 + 1 < i) x -= a.y * X[4 * j4 + 1];
                    if (4 * j4 + 2 < i) x -= a.z * X[4 * j4 + 2];
                    if (4 * j4 + 3 < i) x -= a.w * X[4 * j4 + 3];
                }
                X[i] = x;
            }
#pragma unroll
            for (int i = 0; i < 16; ++i) TM[(16 * b + i) * DP64 + 16 * b + c] = (bf16_t)(pk2(X[i], 0.f) & 0xffffu);
#pragma unroll
            for (int g = 0; g < 4; ++g) { u32x2 wv; wv.x = pk2(X[4 * g], X[4 * g + 1]); wv.y = pk2(X[4 * g + 2], X[4 * g + 3]);
                *(LAS u32x2*)(TDT + (16 * b + c) * DP64 + 16 * b + 4 * g) = wv; }
        }
        __syncthreads();
        }
        const int ib5 = (w >> 1) & 1, jb5 = w & 1;
        f32x16 zero16;
#pragma unroll
        for (int i = 0; i < 16; ++i) zero16[i] = 0.f;
        if (w < 4) { const f32x16 p1 = mm64_tile(AL1, TDT, ib5, jb5, r, hh, zero16); store_tileT(P1T, DP64, 32 * jb5 + r, 32 * ib5, hh, p1, -1.0f); }
        __syncthreads();
        if (w < 4) {
            f32x16 c0;
#pragma unroll
            for (int i = 0; i < 16; ++i) c0[i] = bf2f(TM[(32 * ib5 + crow_(i, hh)) * DP64 + 32 * jb5 + r]);
            const f32x16 t1 = mm64_tile(TM, P1T, ib5, jb5, r, hh, c0);
            store_tileR(T1, DP64, 32 * jb5 + r, 32 * ib5, hh, t1); store_tileT(T1T, DP64, 32 * jb5 + r, 32 * ib5, hh, t1, 1.0f);
        }
        __syncthreads();
        if (w < 4) { const f32x16 p3 = mm64_tile(AL2, T1T, ib5, jb5, r, hh, zero16); store_tileT(P1T, DP64, 32 * jb5 + r, 32 * ib5, hh, p3, -1.0f); }
        __syncthreads();
        if (w < 4) {
            f32x16 c0;
#pragma unroll
            for (int i = 0; i < 16; ++i) c0[i] = bf2f(T1[(32 * ib5 + crow_(i, hh)) * DP64 + 32 * jb5 + r]);
            const f32x16 tt = mm64_tile(T1, P1T, ib5, jb5, r, hh, c0);
            store_tileR(TM, DP64, 32 * jb5 + r, 32 * ib5, hh, tt);
        }
        __syncthreads();
        const int cb = w >> 2, vb = w & 3;
        f32x16 O0;
        REP_D6 {
        {
            const int cg = tid & 15;
#pragma unroll
            for (int pass = 0; pass < 2; ++pass) {
                const int t = tlo + pass, i = dir ? t0 + 63 - t : t - t0;
#pragma unroll
                for (int e = 0; e < 4; ++e) {
                    const int ci_ = (((i >> 3) ^ (cg & 7)) << 3) + (i & 7);
                    KNT[(cg * 8 + 2 * e) * DP64 + ci_] = (bf16_t)(kpk[pass][e] & 0xffffu); KNT[(cg * 8 + 2 * e + 1) * DP64 + ci_] = (bf16_t)(kpk[pass][e] >> 16);
                    VT[(cg * 8 + 2 * e) * DP64 + ci_] = (bf16_t)(vpk[pass][e] & 0xffffu); VT[(cg * 8 + 2 * e + 1) * DP64 + ci_] = (bf16_t)(vpk[pass][e] >> 16);
                }
            }
#pragma unroll
            for (int e = 0; e < 2; ++e) store_tileT(ST, DP128, 32 * (vb0 + e) + r, 32 * kb, hh, Sacc[e], 1.0f);
        }
        __syncthreads();
        {
            f32x16 ks = zero16, qs = zero16;
#pragma unroll
            for (int s = 0; s < 8; ++s) {
                const bf16x8 sf = ldfrag(ST, 32 * vb + r, DP128, 16 * s + 8 * hh);
                ks = MFMA32(ldfrag(KN, 32 * cb + r, DP128, 16 * s + 8 * hh), sf, ks);
                qs = MFMA32(ldfrag(QN, 32 * cb + r, DP128, 16 * s + 8 * hh), sf, qs);
            }
            f32x16 rr;
#pragma unroll
            for (int g = 0; g < 4; ++g) {
                const u32x2 vv = *(const LAS u32x2*)(VT + (32 * vb + r) * DP64 + (((4 * cb + g) ^ ((r >> 3) & 3) ^ ((vb & 1) << 2)) << 3) + 4 * hh);
                const float v4[4] = {bflo(vv.x), bfhi(vv.x), bflo(vv.y), bfhi(vv.y)};
#pragma unroll
                for (int j = 0; j < 4; ++j) {
                    const int c = 32 * cb + 8 * g + 4 * hh + j; const float eg = GT[128 + c];
                    rr[4 * g + j] = GT[64 + c] * (v4[j] - eg * ks[4 * g + j]);
                    O0[4 * g + j] = eg * qs[4 * g + j];
                }
            }
            store_tileT(RT, DP64, 32 * vb + r, 32 * cb, hh, rr, 1.0f);
        }
        __syncthreads();
        }
        {
            const f32x16 vn = mm64_tile(TM, RT, cb, vb, r, hh, zero16);
            f32x16 vs;
#pragma unroll
            for (int i = 0; i < 16; ++i) vs[i] = vn[i] * GT[192 + 32 * cb + crow_(i, hh)];
            store_tileT(VNT, DP64, 32 * vb + r, 32 * cb, hh, vn, 1.0f);
            store_tileT(VNST, DP64, 32 * vb + r, 32 * cb, hh, vs, 1.0f);
        }
        __syncthreads();
        {
            const f32x16 o = mm64_tile(ATT, VNT, cb, vb, r, hh, O0);
#pragma unroll
            for (int i = 0; i < 16; ++i) {
                const int c = 32 * cb + crow_(i, hh), t = dir ? t0 + 63 - c : t0 + c;
                OUT[(size_t)(m0 + t) * 1024 + h * 128 + 32 * vb + r] = (bf16_t)(pk2(o[i], 0.f) & 0xffffu);
            }
            const float egl = GT[256];
#pragma unroll
            for (int e = 0; e < 2; ++e) {
                f32x16 a = Sacc[e] * egl;
#pragma unroll
                for (int s2 = 0; s2 < 4; ++s2) {
                    const int row = 32 * kb + r, blk = (2 * s2 + hh) ^ ((row >> 3) & 7);
                    a = MFMA32(ldfrag(KNT, row, DP64, 8 * blk), ldfrag(VNST, 32 * (vb0 + e) + r, DP64, 16 * s2 + 8 * hh), a);
                }
                Sacc[e] = a;
            }
        }
        __syncthreads();
    }
    if (sfin) {
        const int lane = tid0 & 63, r = lane & 31, hh = lane >> 5, kb = w0 >> 1, vb0 = 2 * (w0 & 1);
#pragma unroll
        for (int e = 0; e < 2; ++e)
#pragma unroll
            for (int i = 0; i < 16; ++i) sfin[(size_t)(32 * kb + crow_(i, hh)) * 128 + 32 * (vb0 + e) + r] = Sacc[e][i];
    }
}

DI void delta_gates_load(const float* AB, int m0, int t0, int h, int dir, int lane, float& xa, float& xb) {
    const int t = dir ? t0 + 63 - lane : t0 + lane;
    const float* ab = AB + (size_t)(m0 + t) * 32 + dir * 8 + h;
    xa = ab[0]; xb = ab[16];
}
DI void delta_gates_compute(LAS float* GT, float xa_raw, float xb, float Aexp, float dtb, int lane) {
    const float xa = xa_raw + dtb;
    const float sp = xa > 20.f ? xa : log1pf(__expf(xa));
    float g = -Aexp * sp;
#pragma unroll
    for (int off = 1; off < 64; off <<= 1) { const float tmp = __shfl_up(g, off); if (lane >= off) g += tmp; }
    const float gl = __shfl(g, 63);
    GT[lane] = g; GT[64 + lane] = sigmoidf_(xb); GT[128 + lane] = __expf(g); GT[192 + lane] = __expf(gl - g);
    if (lane == 0) GT[256] = __expf(gl);
}

DI void delta_prep_unit(LAS unsigned char* lds, bf16_t* QKV, const bf16_t* HALO, const float* AB, const float* conv_w, const float* a_log, const float* dt_bias,
                        int m0, int T, int t0, int h, bf16_t* OF, bf16_t* OB) {
    const int tid = opq(threadIdx.x);
    LAS bf16_t* QN = (LAS bf16_t*)(lds + DL_QN); LAS bf16_t* KN = (LAS bf16_t*)(lds + DL_KN);
    LAS bf16_t* ATT = (LAS bf16_t*)(lds + DL_ATT); LAS bf16_t* TM = (LAS bf16_t*)(lds + DL_TM);
    LAS bf16_t* AL1 = (LAS bf16_t*)(lds + DL_AL1); LAS bf16_t* AL2 = (LAS bf16_t*)(lds + DL_AL2); LAS bf16_t* TDT = (LAS bf16_t*)(lds + DL_TDT); LAS bf16_t* P1T = (LAS bf16_t*)(lds + DL_P1T);
    LAS bf16_t* T1 = (LAS bf16_t*)(lds + DL_T1); LAS bf16_t* T1T = (LAS bf16_t*)(lds + DL_T1T); LAS float* AD = (LAS float*)(lds + DL_AD);
    LAS float* CW = (LAS float*)(lds + DL_CW);
    for (int i = tid; i < 3 * 384; i += 512) { const int tap = i / 384, pc = i % 384; CW[i] = conv_w[tap * 3072 + (pc >> 7) * 1024 + h * 128 + (pc & 127)]; }
    const int wt = __builtin_amdgcn_readfirstlane(tid >> 6);
    float gxa = 0.f, gxb = 0.f;
    if (wt < 2) delta_gates_load(AB, m0, t0, h, wt, tid & 63, gxa, gxb);
    const int cg = tid & 15, tlo = t0 + 2 * (tid >> 4), chg = (m0 + t0) >> 6;
    u32x4 xraw[3][4];
#pragma unroll
    for (int part = 0; part < 3; ++part)
#pragma unroll
        for (int k = 0; k < 4; ++k) {
            const int tt = tlo - 1 + k; const int col = part * 1024 + h * 128 + cg * 8;
            u32x4 v = {0u, 0u, 0u, 0u};
            if (tt < t0) { if (t0 > 0) v = *(const u32x4*)(HALO + ((size_t)(chg - 1) * 2 + 1) * 3072 + col); }
            else if (tt >= t0 + 64) { if (t0 + 64 < T) v = *(const u32x4*)(HALO + ((size_t)(chg + 1) * 2 + 0) * 3072 + col); }
            else v = *(const u32x4*)(QKV + (size_t)(m0 + tt) * 3072 + col);
            xraw[part][k] = v;
        }
    if (wt < 2) delta_gates_compute(wt ? (LAS float*)(lds + DL_RT) : (LAS float*)(lds + DL_GATE), gxa, gxb, __expf(a_log[wt * 8 + h]), dt_bias[wt * 8 + h], tid & 63);
    asm volatile("s_waitcnt vmcnt(0)" ::: "memory");
    __syncthreads();
    u32x4 pq[2], pkk[2];
#pragma unroll
    for (int pass = 0; pass < 2; ++pass) {
        const int t = tlo + pass;
        u32x4 pk[3];
#pragma unroll
        for (int part = 0; part < 3; ++part) {
            const u32x4 xm = xraw[part][pass], x0 = xraw[part][pass + 1], xp = xraw[part][pass + 2];
            float o[8]; float ss = 0.f;
#pragma unroll
            for (int e = 0; e < 4; ++e) {
                const f32x2 w0 = *(const LAS f32x2*)(CW + part * 128 + cg * 8 + 2 * e), w1 = *(const LAS f32x2*)(CW + 384 + part * 128 + cg * 8 + 2 * e), w2 = *(const LAS f32x2*)(CW + 768 + part * 128 + cg * 8 + 2 * e);
                const float a0 = w0.x * bflo(xm[e]) + w1.x * bflo(x0[e]) + w2.x * bflo(xp[e]);
                const float a1 = w0.y * bfhi(xm[e]) + w1.y * bfhi(x0[e]) + w2.y * bfhi(xp[e]);
                o[2 * e] = siluf_(a0); o[2 * e + 1] = siluf_(a1);
                ss += o[2 * e] * o[2 * e] + o[2 * e + 1] * o[2 * e + 1];
            }
            float sc = 1.0f;
            if (part < 2) {
                ss += __shfl_xor(ss, 1); ss += __shfl_xor(ss, 2); ss += __shfl_xor(ss, 4); ss += __shfl_xor(ss, 8);
                sc = __builtin_amdgcn_rsqf(ss + 1e-6f) * (part == 0 ? 0.08838834764831845f : 1.0f);
            }
            pk[part].x = pk2(o[0] * sc, o[1] * sc); pk[part].y = pk2(o[2] * sc, o[3] * sc); pk[part].z = pk2(o[4] * sc, o[5] * sc); pk[part].w = pk2(o[6] * sc, o[7] * sc);
            *(u32x4*)(QKV + (size_t)(m0 + t) * 3072 + part * 1024 + h * 128 + cg * 8) = pk[part];
        }
        pq[pass] = pk[0]; pkk[pass] = pk[1];
    }
#pragma unroll 1
    for (int dir = 0; dir < 2; ++dir) {
        const int tid2 = opq(threadIdx.x), w = __builtin_amdgcn_readfirstlane(tid2 >> 6), lane = tid2 & 63, r = lane & 31, hh = lane >> 5;
        LAS float* GT = dir ? (LAS float*)(lds + DL_RT) : (LAS float*)(lds + DL_GATE);
#pragma unroll
        for (int pass = 0; pass < 2; ++pass) {
            const int loc = tlo + pass - t0, i = dir ? 63 - loc : loc;
            *(LAS u32x4*)(QN + i * DP128 + cg * 8) = pq[pass];
            *(LAS u32x4*)(KN + i * DP128 + cg * 8) = pkk[pass];
        }
        for (int i = tid2; i < 64 * DP64 / 2; i += 512) { ((LAS unsigned*)TM)[i] = 0u; ((LAS unsigned*)TDT)[i] = 0u; }
        __syncthreads();
        {
            const int mat = w >> 2, ib = (w >> 1) & 1, jb = w & 1;
            f32x16 acc;
#pragma unroll
            for (int i = 0; i < 16; ++i) acc[i] = 0.f;
            if (ib >= jb) {
                const LAS bf16_t* X = mat ? QN : KN;
#pragma unroll
                for (int s = 0; s < 8; ++s) acc = MFMA32(ldfrag(X, 32 * ib + r, DP128, 16 * s + 8 * hh), ldfrag(KN, 32 * jb + r, DP128, 16 * s + 8 * hh), acc);
            }
            const int col = 32 * jb + r; const float gc = GT[col];
#pragma unroll
            for (int i = 0; i < 16; ++i) {
                const int row = 32 * ib + crow_(i, hh);
                const float dg = (row >= col) ? __expf(GT[row] - gc) : 0.f;
                if (mat == 0) {
                    const float a = (row > col) ? GT[64 + row] * acc[i] * dg : 0.f;
                    const bool same16 = (row >> 4) == (col >> 4), same32 = (row >> 5) == (col >> 5);
                    if (same16) AD[((row >> 4) * 16 + (row & 15)) * 20 + (col & 15)] = a;
                    AL1[row * DP64 + col] = (bf16_t)(pk2((same32 && !same16) ? a : 0.f, 0.f) & 0xffffu);
                    AL2[row * DP64 + col] = (bf16_t)(pk2(!same32 ? a : 0.f, 0.f) & 0xffffu);
                } else {
                    ATT[row * DP64 + col] = (bf16_t)(pk2((row >= col) ? acc[i] * dg : 0.f, 0.f) & 0xffffu);
                }
            }
        }
        __syncthreads();
        if (w == 0) {
            const int b = lane >> 4, c = lane & 15;
            const LAS float* ad = AD + b * 16 * 20;
            float X[16];
#pragma unroll
            for (int i = 0; i < 16; ++i) {
                float x = (i == c) ? 1.f : 0.f;
#pragma unroll
                for (int j4 = 0; j4 < (i + 3) / 4; ++j4) {
                    const f32x4 a = *(const LAS f32x4*)(ad + i * 20 + 4 * j4);
                    if (4 * j4 + 0 < i) x -= a.x * X[4 * j4 + 0];
                    if (4 * j4 + 1 < i) x -= a.y * X[4 * j4 + 1];
                    if (4 * j4 + 2 < i) x -= a.z * X[4 * j4 + 2];
                    if (4 * j4 + 3 < i) x -= a.w * X[4 * j4 + 3];
                }
                X[i] = x;
            }
#pragma unroll
            for (int i = 0; i < 16; ++i) TM[(16 * b + i) * DP64 + 16 * b + c] = (bf16_t)(pk2(X[i], 0.f) & 0xffffu);
#pragma unroll
            for (int g = 0; g < 4; ++g) { u32x2 wv; wv.x = pk2(X[4 * g], X[4 * g + 1]); wv.y = pk2(X[4 * g + 2], X[4 * g + 3]);
                *(LAS u32x2*)(TDT + (16 * b + c) * DP64 + 16 * b + 4 * g) = wv; }
        }
        __syncthreads();
        const int ib5 = (w >> 1) & 1, jb5 = w & 1;
        f32x16 zero16;
#pragma unroll
        for (int i = 0; i < 16; ++i) zero16[i] = 0.f;
        if (w < 4) { const f32x16 p1 = mm64_tile(AL1, TDT, ib5, jb5, r, hh, zero16); store_tileT(P1T, DP64, 32 * jb5 + r, 32 * ib5, hh, p1, -1.0f); }
        __syncthreads();
        if (w < 4) {
            f32x16 c0;
#pragma unroll
            for (int i = 0; i < 16; ++i) c0[i] = bf2f(TM[(32 * ib5 + crow_(i, hh)) * DP64 + 32 * jb5 + r]);
            const f32x16 t1 = mm64_tile(TM, P1T, ib5, jb5, r, hh, c0);
            store_tileR(T1, DP64, 32 * jb5 + r, 32 * ib5, hh, t1); store_tileT(T1T, DP64, 32 * jb5 + r, 32 * ib5, hh, t1, 1.0f);
        }
        __syncthreads();
        if (w < 4) { const f32x16 p3 = mm64_tile(AL2, T1T, ib5, jb5, r, hh, zero16); store_tileT(P1T, DP64, 32 * jb5 + r, 32 * ib5, hh, p3, -1.0f); }
        __syncthreads();
        if (w < 4) {
            f32x16 c0;
#pragma unroll
            for (int i = 0; i < 16; ++i) c0[i] = bf2f(T1[(32 * ib5 + crow_(i, hh)) * DP64 + 32 * jb5 + r]);
            const f32x16 tt = mm64_tile(T1, P1T, ib5, jb5, r, hh, c0);
            store_tileR(TM, DP64, 32 * jb5 + r, 32 * ib5, hh, tt);
        }
        __syncthreads();
        {
            bf16_t* OUTd = dir ? OB : OF;
#pragma unroll
            for (int k2 = 0; k2 < 2; ++k2) {
                const int pc_ = tid2 + 512 * k2, row = pc_ >> 4, pc = pc_ & 15;
                const LAS bf16_t* src = (pc < 8 ? TM : ATT) + row * DP64 + (pc & 7) * 8;
                *(u32x4*)(OUTd + (size_t)(m0 + t0 + row) * 1024 + h * 128 + pc * 8) = *(const LAS u32x4*)src;
            }
        }
        __syncthreads();
    }
}

DI void delta_scan_unit(LAS unsigned char* lds, const bf16_t* QKV, const float* AB, float Aexp, float dtb,
                        int m0, int T, int h, int dir, const float* s0, float* sfin, bf16_t* OUT) {
    const int tid0 = opq(threadIdx.x), w0 = __builtin_amdgcn_readfirstlane(tid0 >> 6);
    LAS bf16_t* QN = (LAS bf16_t*)(lds + DL_QN); LAS bf16_t* KN = (LAS bf16_t*)(lds + DL_KN); LAS bf16_t* KNT = (LAS bf16_t*)(lds + DL_KNT); LAS bf16_t* VT = (LAS bf16_t*)(lds + DL_VT);
    LAS bf16_t* ST = (LAS bf16_t*)(lds + DL_ST); LAS bf16_t* ATT = (LAS bf16_t*)(lds + DL_ATT); LAS bf16_t* TM = (LAS bf16_t*)(lds + DL_TM); LAS bf16_t* RT = (LAS bf16_t*)(lds + DL_RT);
    LAS float* GT = (LAS float*)(lds + DL_GATE);
    LAS bf16_t* VNT = (LAS bf16_t*)(lds + DL_VNT); LAS bf16_t* VNST = (LAS bf16_t*)(lds + DL_VNST);
    f32x16 Sacc[2];
    {
        const int lane = tid0 & 63, r = lane & 31, hh = lane >> 5, kb = w0 >> 1, vb0 = 2 * (w0 & 1);
#pragma unroll
        for (int e = 0; e < 2; ++e)
#pragma unroll
            for (int i = 0; i < 16; ++i) Sacc[e][i] = s0 ? s0[(size_t)(32 * kb + crow_(i, hh)) * 128 + 32 * (vb0 + e) + r] : 0.f;
    }
    const int nch = T / 64;
    u32x4 pre[8];
#define DSCAN_LOAD(T0) do { const int tlo_ = (T0) + 2 * (tid0 >> 4), cg_ = tid0 & 15; \
        _Pragma("unroll") for (int pass = 0; pass < 2; ++pass) _Pragma("unroll") for (int part = 0; part < 3; ++part) \
            pre[pass * 3 + part] = *(const u32x4*)(QKV + (size_t)(m0 + tlo_ + pass) * 3072 + part * 1024 + h * 128 + cg_ * 8); \
        _Pragma("unroll") for (int k2 = 0; k2 < 2; ++k2) { const int pc_ = tid0 + 512 * k2; \
            pre[6 + k2] = *(const u32x4*)(OUT + (size_t)(m0 + (T0) + (pc_ >> 4)) * 1024 + h * 128 + (pc_ & 15) * 8); } } while (0)
    DSCAN_LOAD((dir ? nch - 1 : 0) * 64);
    float gxa = 0.f, gxb = 0.f;
    if (w0 == 0) delta_gates_load(AB, m0, (dir ? nch - 1 : 0) * 64, h, dir, tid0 & 63, gxa, gxb);
#pragma unroll 1
    for (int ci = 0; ci < nch; ++ci) {
        const int tid = opq(threadIdx.x), w = __builtin_amdgcn_readfirstlane(tid >> 6), lane = tid & 63, r = lane & 31, hh = lane >> 5;
        const int kb = w >> 1, vb0 = 2 * (w & 1);
        const int t0 = (dir ? nch - 1 - ci : ci) * 64;
        {
            const int cg = tid & 15, tlo = t0 + 2 * (tid >> 4);
#pragma unroll
            for (int pass = 0; pass < 2; ++pass) {
                const int loc = tlo + pass - t0, i = dir ? 63 - loc : loc;
                *(LAS u32x4*)(QN + i * DP128 + cg * 8) = pre[pass * 3 + 0];
                *(LAS u32x4*)(KN + i * DP128 + cg * 8) = pre[pass * 3 + 1];
                const int ci_ = (((i >> 3) ^ (cg & 7)) << 3) + (i & 7);
#pragma unroll
                for (int e = 0; e < 4; ++e) {
                    KNT[(cg * 8 + 2 * e) * DP64 + ci_] = (bf16_t)(pre[pass * 3 + 1][e] & 0xffffu); KNT[(cg * 8 + 2 * e + 1) * DP64 + ci_] = (bf16_t)(pre[pass * 3 + 1][e] >> 16);
                    VT[(cg * 8 + 2 * e) * DP64 + ci_] = (bf16_t)(pre[pass * 3 + 2][e] & 0xffffu); VT[(cg * 8 + 2 * e + 1) * DP64 + ci_] = (bf16_t)(pre[pass * 3 + 2][e] >> 16);
                }
            }
#pragma unroll
            for (int k2 = 0; k2 < 2; ++k2) {
                const int pc_ = tid + 512 * k2, row = pc_ >> 4, pc = pc_ & 15;
                *(LAS u32x4*)((pc < 8 ? TM : ATT) + row * DP64 + (pc & 7) * 8) = pre[6 + k2];
            }
#pragma unroll
            for (int e = 0; e < 2; ++e) store_tileT(ST, DP128, 32 * (vb0 + e) + r, 32 * kb, hh, Sacc[e], 1.0f);
        }
        if (w == 0) { delta_gates_compute(GT, gxa, gxb, Aexp, dtb, lane);
            if (ci + 1 < nch) delta_gates_load(AB, m0, (dir ? nch - 2 - ci : ci + 1) * 64, h, dir, lane, gxa, gxb); }
        if (ci + 1 < nch) DSCAN_LOAD((dir ? nch - 2 - ci : ci + 1) * 64);
        __syncthreads();
        f32x16 zero16;
#pragma unroll
        for (int i = 0; i < 16; ++i) zero16[i] = 0.f;
        const int cb = w >> 2, vb = w & 3;
        f32x16 O0;
        {
            f32x16 ks = zero16, qs = zero16;
#pragma unroll
            for (int s = 0; s < 8; ++s) {
                const bf16x8 sf = ldfrag(ST, 32 * vb + r, DP128, 16 * s + 8 * hh);
                ks = MFMA32(ldfrag(KN, 32 * cb + r, DP128, 16 * s + 8 * hh), sf, ks);
                qs = MFMA32(ldfrag(QN, 32 * cb + r, DP128, 16 * s + 8 * hh), sf, qs);
            }
            f32x16 rr;
#pragma unroll
            for (int g = 0; g < 4; ++g) {
                const u32x2 vv = *(const LAS u32x2*)(VT + (32 * vb + r) * DP64 + (((4 * cb + g) ^ ((r >> 3) & 3) ^ ((vb & 1) << 2)) << 3) + 4 * hh);
                const float v4[4] = {bflo(vv.x), bfhi(vv.x), bflo(vv.y), bfhi(vv.y)};
#pragma unroll
                for (int j = 0; j < 4; ++j) {
                    const int c = 32 * cb + 8 * g + 4 * hh + j; const float eg = GT[128 + c];
                    rr[4 * g + j] = GT[64 + c] * (v4[j] - eg * ks[4 * g + j]);
                    O0[4 * g + j] = eg * qs[4 * g + j];
                }
            }
            store_tileT(RT, DP64, 32 * vb + r, 32 * cb, hh, rr, 1.0f);
        }
        __syncthreads();
        {
            const f32x16 vn = mm64_tile(TM, RT, cb, vb, r, hh, zero16);
            f32x16 vs;
#pragma unroll
            for (int i = 0; i < 16; ++i) vs[i] = vn[i] * GT[192 + 32 * cb + crow_(i, hh)];
            store_tileT(VNT, DP64, 32 * vb + r, 32 * cb, hh, vn, 1.0f);
            store_tileT(VNST, DP64, 32 * vb + r, 32 * cb, hh, vs, 1.0f);
        }
        __syncthreads();
        {
            const f32x16 o = mm64_tile(ATT, VNT, cb, vb, r, hh, O0);
#pragma unroll
            for (int i = 0; i < 16; ++i) {
                const int c = 32 * cb + crow_(i, hh), t = dir ? t0 + 63 - c : t0 + c;
                OUT[(size_t)(m0 + t) * 1024 + h * 128 + 32 * vb + r] = (bf16_t)(pk2(o[i], 0.f) & 0xffffu);
            }
            const float egl = GT[256];
#pragma unroll
            for (int e = 0; e < 2; ++e) {
                f32x16 a = Sacc[e] * egl;
#pragma unroll
                for (int s2 = 0; s2 < 4; ++s2) {
                    const int row = 32 * kb + r, blk = (2 * s2 + hh) ^ ((row >> 3) & 7);
                    a = MFMA32(ldfrag(KNT, row, DP64, 8 * blk), ldfrag(VNST, 32 * (vb0 + e) + r, DP64, 16 * s2 + 8 * hh), a);
                }
                Sacc[e] = a;
            }
        }
        __syncthreads();
    }
    if (sfin) {
        const int lane = tid0 & 63, r = lane & 31, hh = lane >> 5, kb = w0 >> 1, vb0 = 2 * (w0 & 1);
#pragma unroll
        for (int e = 0; e < 2; ++e)
#pragma unroll
            for (int i = 0; i < 16; ++i) sfin[(size_t)(32 * kb + crow_(i, hh)) * 128 + 32 * (vb0 + e) + r] = Sacc[e][i];
    }
#undef DSCAN_LOAD
}
DI void delta_dispatch(LAS unsigned char* lds, int U, const bf16_t* QKV, const float* AB, const float* conv_w, const float* a_log, const float* dt_bias,
                       const float* state, float* news, bf16_t* OF, bf16_t* OB) {
    int b, h, dir, m0, T; const float* s0 = nullptr; float* sf = nullptr;
    if (U < 128) { b = U >> 4; h = (U >> 1) & 7; dir = U & 1; m0 = NPR + b * 2048; T = 2048; s0 = state + (size_t)((b * 2 + dir) * 8 + h) * 16384; }
    else { const int u = U - 128; b = u >> 4; h = (u >> 1) & 7; dir = u & 1; m0 = b * 256; T = 256; sf = news + (size_t)((b * 2 + dir) * 8 + h) * 16384; }
    const float Aexp = __expf(a_log[dir * 8 + h]), dtb = dt_bias[dir * 8 + h];
#ifdef DELTA_SEQ
    delta_unit(lds, QKV, AB, conv_w, Aexp, dtb, m0, T, h, dir, s0, sf, dir ? OB : OF);
#else
    delta_scan_unit(lds, QKV, AB, Aexp, dtb, m0, T, h, dir, s0, sf, dir ? OB : OF);
#endif
}

DI void y_phase(bf16_t* OF, const bf16_t* OB, const bf16_t* Z, int zp, const float* out_norm, int gw, int NGW, int lane) {
    for (int m = gw; m < NTOK; m += NGW) {
        const size_t off = (size_t)m * 1024 + 16 * lane;
        const u32x4 f0 = *(const u32x4*)(OF + off), f1 = *(const u32x4*)(OF + off + 8);
        const u32x4 b0 = *(const u32x4*)(OB + off), b1 = *(const u32x4*)(OB + off + 8);
        const size_t zoff = (size_t)m * zp + 16 * lane;
        const u32x4 z0 = *(const u32x4*)(Z + zoff), z1 = *(const u32x4*)(Z + zoff + 8);
        float o[16], z[16]; float ss = 0.f;
#pragma unroll
        for (int e = 0; e < 4; ++e) {
            o[2 * e] = bflo(f0[e]) + bflo(b0[e]); o[2 * e + 1] = bfhi(f0[e]) + bfhi(b0[e]);
            o[8 + 2 * e] = bflo(f1[e]) + bflo(b1[e]); o[8 + 2 * e + 1] = bfhi(f1[e]) + bfhi(b1[e]);
            z[2 * e] = bflo(z0[e]); z[2 * e + 1] = bfhi(z0[e]); z[8 + 2 * e] = bflo(z1[e]); z[8 + 2 * e + 1] = bfhi(z1[e]);
        }
#pragma unroll
        for (int e = 0; e < 16; ++e) ss += o[e] * o[e];
        ss += __shfl_xor(ss, 1); ss += __shfl_xor(ss, 2); ss += __shfl_xor(ss, 4);
        const float rstd = __builtin_amdgcn_rsqf(ss * (1.0f / 128.0f) + 1e-6f);
        const float* gn = out_norm + ((16 * lane) & 127);
        float y[16];
#pragma unroll
        for (int e = 0; e < 16; ++e) y[e] = o[e] * rstd * gn[e] * siluf_(z[e]);
        u32x4 w0, w1;
        w0.x = pk2(y[0], y[1]); w0.y = pk2(y[2], y[3]); w0.z = pk2(y[4], y[5]); w0.w = pk2(y[6], y[7]);
        w1.x = pk2(y[8], y[9]); w1.y = pk2(y[10], y[11]); w1.z = pk2(y[12], y[13]); w1.w = pk2(y[14], y[15]);
        *(u32x4*)(OF + off) = w0; *(u32x4*)(OF + off + 8) = w1;
    }
}

__global__ void __launch_bounds__(512, 2) fwd_megakernel(Params p) {
    extern __shared__ __attribute__((aligned(16))) unsigned char lds_raw[];
    LAS unsigned char* lds = (LAS unsigned char*)lds_raw;
    cg::grid_group grid = cg::this_grid();
    const int G = gridDim.x, bid = blockIdx.x, NGW = G * 8;
#define IDS() const int tid = opq(threadIdx.x), lane = tid & 63, wave = __builtin_amdgcn_readfirstlane(tid >> 6), gw = bid * 8 + wave; (void)gw; (void)lane; (void)tid
    unsigned char* ws = p.ws;
    float* mod = (float*)(ws + WS_MOD);
    float* Y = p.out + OUT_Y;
    bf16_t* XB = (bf16_t*)(p.out + OUT_Y) + 1024;
    bf16_t* WQKV1 = (bf16_t*)(ws + WS_WQKV1); bf16_t* WZ1 = (bf16_t*)(ws + WS_WZ1); bf16_t* WOUT1 = (bf16_t*)(ws + WS_WOUT1);
    bf16_t* WIN0 = (bf16_t*)(ws + B_WIN0); bf16_t* WOUT0 = (bf16_t*)(ws + B_WOUT0); bf16_t* W1_0 = (bf16_t*)(ws + B_W1_0); bf16_t* W2_0 = (bf16_t*)(ws + B_W2_0);
    bf16_t* H0 = (bf16_t*)(ws + B_H0); bf16_t* Qb = (bf16_t*)(ws + B_Q); bf16_t* KS = (bf16_t*)(ws + B_KS); bf16_t* VTS = (bf16_t*)(ws + B_VTS);
    bf16_t* KP = (bf16_t*)(ws + B_KP); bf16_t* VTP = (bf16_t*)(ws + B_VTP); bf16_t* FF0 = (bf16_t*)(ws + B_FF0);
    bf16_t* QKV1 = (bf16_t*)(ws + B_QKV1); float* AB = (float*)(ws + B_AB); bf16_t* OF = (bf16_t*)(ws + B_OF); bf16_t* OB = (bf16_t*)(ws + B_OB);
    bf16_t* H1 = (bf16_t*)(ws + B_H1); bf16_t* W1_1 = (bf16_t*)(ws + B_W1_1); bf16_t* W2_1 = (bf16_t*)(ws + B_W2_1); bf16_t* H1B = (bf16_t*)(ws + B_H1B);
    bf16_t* Zb = (bf16_t*)(ws + B_Z); bf16_t* FF1 = (bf16_t*)(ws + B_FF1);
    float* Pside = (float*)(ws + B_PS);
    bf16_t* HL = (bf16_t*)(p.out + OUT_Y);
    bf16_t* FFL0 = (bf16_t*)(ws + B_FFL0); bf16_t* FFL1 = (bf16_t*)(ws + B_FFL1);

    unsigned* barw = (unsigned*)(ws + 524288);
    volatile LAS unsigned* bar_st = (volatile LAS unsigned*)(lds + LDS_BYTES - 512);
    if (threadIdx.x < 2) bar_st[threadIdx.x] = 0u;
    if (p.ws == nullptr) grid.sync();
    __syncthreads();
    const XcdBarrier xbar = xcd_barrier_post(barw, bar_st);
#define GSYNC() xcd_barrier(xbar)
#define W2_GEMM(FFb, W2b, modl) do { \
        pg8::Gemm g{FFb, W2b, 4096, 4096, NTOK, 1024, 4096}; \
        EpiRes E{nullptr, nullptr, XB, modl + 5120, Pside, 0}; \
        if (G == 256) { pg8::W2Order S; S.c = bid; S.ntf = 64; pg8::gemm_phase(lds, g, S, E); } \
        else { pg8::StaticOrder S; S.init(NTOK, 1024, G, bid); pg8::gemm_phase(lds, g, S, E); } } while (0)
    {
        IDS();
        LAS float* scr = (LAS float*)(lds + wave * 8704);
        transpose_matrix(p.in[10], 1024, 2304, WIN0, scr, gw, NGW, lane);
        const bool later = (G == 256);
        if (!later) {
        transpose_matrix(p.in[16], 1024, 1024, WOUT0, scr, gw, NGW, lane);
        transpose_matrix(p.in[18], 1024, 4096, W1_0, scr, gw, NGW, lane);
        transpose_matrix(p.in[19], 4096, 1024, W2_0, scr, gw, NGW, lane);
        transpose_matrix(p.in[28], 1024, 1024, WOUT1, scr, gw, NGW, lane);
        }
        if (!later) {
            const float* W = p.in[23]; const int nblk = 129, nitems = 16 * nblk;
            for (int it = gw; it < nitems; it += NGW) { const int kb = it / nblk, nb = it % nblk, n0 = nb * 32;
                if (n0 < 3072) transpose_item(W, 4128, kb * 64, n0, WQKV1, 1024, perm_row32(n0), scr, lane);
                else if (n0 < 4096) transpose_item(W, 4128, kb * 64, n0, WZ1, 1024, perm_row32(n0 - 3072), scr, lane);
                else transpose_item(W, 4128, kb * 64, n0, WQKV1, 1024, 3072, scr, lane); }
            u32x4* zp = (u32x4*)(WQKV1 + (size_t)3104 * 1024); const int nz = 224 * 1024 * 2 / 16;
            for (int i = bid * 512 + tid; i < nz; i += G * 512) zp[i] = (u32x4){0u, 0u, 0u, 0u};
        }
        {
            const float* ck = p.in[3]; const float* cv = p.in[4];
            for (int e = bid * 512 + tid; e < 8 * 256 * 640; e += G * 512) {
                const int b = e / (256 * 640), rem = e % (256 * 640), pp = rem / 640, hd = rem % 640, head = hd >> 6, d = hd & 63, kk = pp & 31;
                const size_t tbase = ((size_t)(b * 10 + head) * 72 + 64 + (pp >> 5)) * 2048;
                KS[tbase + ((d >> 3) * 32 + kk) * 8 + (d & 7)] = (bf16_t)(pk2(ck[e], 0.f) & 0xffffu);
                VTS[tbase + ((((((d >> 5) * 2 + (kk >> 4)) * 2 + ((kk >> 3) & 1)) * 2 + ((kk >> 2) & 1)) * 32 + (d & 31)) << 2) + (kk & 3)] = (bf16_t)(pk2(cv[e], 0.f) & 0xffffu);
            }
        }
        __syncthreads();
        LAS float* sv = (LAS float*)lds;
        LAS float* red = sv + 1024 * 12;
        bool sv_ready = false;
        for (int U = bid; U < 192; U += G) {
            if (!sv_ready) {
                for (int i = tid; i < 9 * 1024; i += 512) { const int r = i >> 10, k = i & 1023; const float x = (r == 0) ? p.in[6][k] : p.in[2][(r - 1) * 1024 + k]; sv[k * 12 + r] = siluf_(x); }
                sv_ready = true; __syncthreads();
            }
            const int l = U / 96, j0 = (U % 96) * 64;
            const float* W = p.in[l ? 20 : 7]; const float* bias = p.in[l ? 21 : 8];
            float a[9];
#pragma unroll
            for (int r = 0; r < 9; ++r) a[r] = 0.f;
            const int kbeg = wave * 128;
#pragma unroll 16
            for (int k = kbeg; k < kbeg + 128; ++k) {
                const float w = W[(size_t)k * MODW + j0 + lane];
                const f32x4 s0 = *(const LAS f32x4*)(sv + k * 12), s1 = *(const LAS f32x4*)(sv + k * 12 + 4); const float s8 = sv[k * 12 + 8];
                a[0] += w * s0.x; a[1] += w * s0.y; a[2] += w * s0.z; a[3] += w * s0.w; a[4] += w * s1.x; a[5] += w * s1.y; a[6] += w * s1.z; a[7] += w * s1.w; a[8] += w * s8;
            }
#pragma unroll
            for (int r = 0; r < 9; ++r) red[(wave * 9 + r) * 64 + lane] = a[r];
            __syncthreads();
            for (int i = tid; i < 576; i += 512) { const int r = i >> 6, c = i & 63; float s = bias[j0 + c];
#pragma unroll
                for (int w = 0; w < 8; ++w) s += red[(w * 9 + r) * 64 + c];
                mod[(size_t)(l * 9 + r) * MODW + j0 + c] = s; }
            __syncthreads();
        }
    }
    GSYNC();

    const float* mod0 = mod; const float* mod1 = mod + 9 * MODW;
    { IDS(); norm_phase(p.in[0], p.in[1], nullptr, p.in[9], mod0 + 0, mod0 + 1024, H0, DM, gw, NGW, lane); }
    GSYNC();
    {
        pg8::Gemm g{H0, WIN0, 1024, 1024, NTOK, 2304, 1024}; pg8::StaticOrder S; S.init(NTOK, 2304, G, bid);
        EpiQKV0 E{Qb, KS, VTS, KP, VTP, p.out + OUT_NEWK, p.out + OUT_NEWV, p.in[11], p.in[12], p.in[13], p.in[14]};
        pg8::gemm_phase(lds, g, S, E);
        if (G == 256 && bid >= 96) {
            IDS();
            LAS float* scr = (LAS float*)(lds + wave * 8704);
            const int gw2 = (bid - 96) * 8 + wave, NGW2 = 160 * 8;
            transpose_matrix(p.in[16], 1024, 1024, WOUT0, scr, gw2, NGW2, lane);
            transpose_matrix(p.in[18], 1024, 4096, W1_0, scr, gw2, NGW2, lane);
            transpose_matrix(p.in[19], 4096, 1024, W2_0, scr, gw2, NGW2, lane);
            transpose_matrix(p.in[28], 1024, 1024, WOUT1, scr, gw2, NGW2, lane);
            const float* W = p.in[23]; const int nblk = 129, nitems = 16 * nblk;
            for (int it = gw2; it < nitems; it += NGW2) { const int kb = it / nblk, nb = it % nblk, n0 = nb * 32;
                if (n0 < 3072) transpose_item(W, 4128, kb * 64, n0, WQKV1, 1024, perm_row32(n0), scr, lane);
                else if (n0 < 4096) transpose_item(W, 4128, kb * 64, n0, WZ1, 1024, perm_row32(n0 - 3072), scr, lane);
                else transpose_item(W, 4128, kb * 64, n0, WQKV1, 1024, 3072, scr, lane); }
            u32x4* zp = (u32x4*)(WQKV1 + (size_t)3104 * 1024); const int nz = 224 * 1024 * 2 / 16;
            for (int i = (bid - 96) * 512 + tid; i < nz; i += 160 * 512) zp[i] = (u32x4){0u, 0u, 0u, 0u};
        }
    }
    GSYNC();
    { IDS();
      LAS float* sbias = (LAS float*)lds;
      for (int i = tid; i < 3720; i += 512) sbias[i] = p.in[15][i];
      __syncthreads();
      attention_phase(Qb, KS, VTS, KP, VTP, sbias, p.in[11], p.in[12], p.in[13], p.in[14], H0, gw, NGW, lane); }
#ifdef PROBE_ATTN
    GSYNC();
    { IDS(); attention_phase(Qb, KS, VTS, KP, VTP, (const LAS float*)lds, p.in[11], p.in[12], p.in[13], p.in[14], H0, gw, NGW, lane); }
#endif
    GSYNC();
    {
        pg8::Gemm g{H0, WOUT0, 1024, 1024, NTOK, 1024, 1024}; pg8::StaticOrder S; S.init(NTOK, 1024, G, bid);
        EpiRes E{p.in[0], p.in[1], XB, mod0 + 2048, nullptr, 0};
        pg8::gemm_phase(lds, g, S, E);
    }
    GSYNC();
    { IDS(); norm_phase(nullptr, nullptr, XB, p.in[17], mod0 + 3072, mod0 + 4096, HL, XBP, gw, NGW, lane); }
    GSYNC();
    {
        pg8::Gemm g{HL, W1_0, XBP, 1024, NTOK, 4096, 1024}; pg8::StaticOrder S; S.init(NTOK, 4096, G, bid);
        EpiBf16<1> E{FFL0, 4096};
        pg8::gemm_phase(lds, g, S, E);
    }
    GSYNC();
    W2_GEMM(FFL0, W2_0, mod0);
    GSYNC();
    { IDS(); norm_phase(nullptr, nullptr, XB, p.in[22], mod1 + 0, mod1 + 1024, H1, DM, gw, NGW, lane, (G == 256) ? Pside : nullptr); }
    GSYNC();
    {
        pg8::Gemm g{H1, WQKV1, 1024, 1024, NTOK, 4352, 1024}; pg8::StaticOrder S; S.init(NTOK, 4352, G, bid);
        EpiQKV1 E{QKV1, AB, HL, XBP, (bf16_t*)(ws + B_HALO)};
        pg8::gemm_phase(lds, g, S, E);
    }
    GSYNC();
    {
#pragma unroll 1
        for (int U = bid; U < 3072; U += G) {
            const int ch = U >> 3, h = U & 7, mrow = ch * 64;
            const int m0 = (mrow < NPR) ? (mrow & ~255) : NPR + ((mrow - NPR) & ~2047), T = (mrow < NPR) ? 256 : 2048;
            delta_prep_unit(lds, QKV1, (const bf16_t*)(ws + B_HALO), AB, p.in[24], p.in[25], p.in[26], m0, T, mrow - m0, h, OF, OB);
        }
    }
    GSYNC();
#ifdef PROBE_DELTA
    for (int rep = 0; rep < 2; ++rep)
#endif
    {
        float* news = p.out + OUT_NEWS;
#ifdef PROBE_DELTA
        if (rep) GSYNC();
#endif
        const bool bal = (G == 256);
        const int nun = bal ? (bid < 128 ? 1 : 4) : (640 - bid + G - 1) / G;
#pragma unroll 1
        for (int i = 0; i < nun; ++i) {
            const int U = bal ? (bid < 128 ? bid : 128 + (bid - 128) * 4 + i) : bid + i * G;
            delta_dispatch(lds, U, QKV1, AB, p.in[24], p.in[25], p.in[26], p.in[5], news, OF, OB);
        }
    }
    GSYNC();
    if (G != 256) {
        IDS();
        LAS float* scr = (LAS float*)(lds + wave * 8704);
        transpose_matrix(p.in[30], 1024, 4096, W1_1, scr, gw, NGW, lane);
        transpose_matrix(p.in[31], 4096, 1024, W2_1, scr, gw, NGW, lane);
    }
    { IDS(); y_phase(OF, OB, HL, XBP, p.in[27], gw, NGW, lane); }
    GSYNC();
    {
        pg8::Gemm g{OF, WOUT1, 1024, 1024, NTOK, 1024, 1024}; pg8::StaticOrder S; S.init(NTOK, 1024, G, bid);
        EpiRes E{nullptr, nullptr, XB, mod1 + 2048, nullptr, 0};
        pg8::gemm_phase(lds, g, S, E);
        if (G == 256 && bid >= 128) {
            IDS();
            LAS float* scr = (LAS float*)(lds + wave * 8704);
            const int gw2 = (bid - 128) * 8 + wave, NGW2 = 128 * 8;
            transpose_matrix(p.in[30], 1024, 4096, W1_1, scr, gw2, NGW2, lane);
            transpose_matrix(p.in[31], 4096, 1024, W2_1, scr, gw2, NGW2, lane);
        }
    }
    GSYNC();
    { IDS(); norm_phase(nullptr, nullptr, XB, p.in[29], mod1 + 3072, mod1 + 4096, HL, XBP, gw, NGW, lane); }
    GSYNC();
    {
        pg8::Gemm g{HL, W1_1, XBP, 1024, NTOK, 4096, 1024}; pg8::StaticOrder S; S.init(NTOK, 4096, G, bid);
        EpiBf16<1> E{FFL1, 4096};
        pg8::gemm_phase(lds, g, S, E);
    }
    GSYNC();
    W2_GEMM(FFL1, W2_1, mod1);
    {
        GSYNC();
        IDS();
        const bool fold = (G == 256);
        for (int m = gw; m < NTOK; m += NGW) {
            const bf16_t* xr = XB + (size_t)m * XBP + 16 * lane;
            const u32x4 w0 = *(const u32x4*)xr, w1 = *(const u32x4*)(xr + 8);
            f32x4 o[4] = {(f32x4){bflo(w0.x), bfhi(w0.x), bflo(w0.y), bfhi(w0.y)}, (f32x4){bflo(w0.z), bfhi(w0.z), bflo(w0.w), bfhi(w0.w)},
                          (f32x4){bflo(w1.x), bfhi(w1.x), bflo(w1.y), bfhi(w1.y)}, (f32x4){bflo(w1.z), bfhi(w1.z), bflo(w1.w), bfhi(w1.w)}};
            if (fold && m >= 16384) {
#pragma unroll
                for (int j = 0; j < 4; ++j) o[j] = o[j] + *(const f32x4*)(Pside + (size_t)(m - 16384) * DM + 16 * lane + 4 * j);
            }
            asm volatile("s_waitcnt vmcnt(0)" ::: "memory");
#pragma unroll
            for (int j = 0; j < 4; ++j) *(f32x4*)(Y + (size_t)m * DM + 16 * lane + 4 * j) = o[j];
        }
    }
}

extern "C" void kernel_launch(void* const* d_in, const int* in_sizes, int n_in, void* d_out, int out_size, void* d_ws, size_t ws_size, hipStream_t stream) {
    static int grid_blocks = 0;
    if (!grid_blocks) {
        if (n_in != 32 || ws_size < WS_NEED) { fprintf(stderr, "kernel_launch: unexpected n_in %d / ws_size %zu (need %zu)\n", n_in, ws_size, (size_t)WS_NEED); grid_blocks = -1; return; }
        int dev = 0, cus = 0, per_cu = 0;
        hipGetDevice(&dev);
        hipDeviceGetAttribute(&cus, hipDeviceAttributeMultiprocessorCount, dev);
        hipFuncSetAttribute((const void*)fwd_megakernel, hipFuncAttributeMaxDynamicSharedMemorySize, LDS_BYTES);
        hipOccupancyMaxActiveBlocksPerMultiprocessor(&per_cu, (const void*)fwd_megakernel, 512, LDS_BYTES);
        if (per_cu < 1) { fprintf(stderr, "kernel_launch: occupancy query returned %d\n", per_cu); per_cu = 1; }
        grid_blocks = cus * per_cu;
    }
    if (grid_blocks < 0) return;
    Params p{};
    for (int i = 0; i < 32; ++i) p.in[i] = (const float*)d_in[i];
    p.out = (float*)d_out; p.ws = (unsigned char*)d_ws;
    if (hipMemsetAsync((char*)d_ws + 524288, 0, XCD_BAR_WORDS * 4, stream) != hipSuccess) { fprintf(stderr, "kernel_launch: memset of barrier words failed\n"); return; }
    void* args[] = {&p};
    hipError_t e = hipLaunchCooperativeKernel((const void*)fwd_megakernel, dim3(grid_blocks), dim3(512), args, LDS_BYTES, stream);
    if (e != hipSuccess) fprintf(stderr, "cooperative launch failed: %s (grid %d)\n", hipGetErrorString(e), grid_blocks);
}
```

```cpp
#include <hip/hip_runtime.h>
#include <hip/hip_cooperative_groups.h>
#include <cstdio>
namespace cg = cooperative_groups;

#define LAS __attribute__((address_space(3)))
#define DI __device__ __forceinline__
typedef unsigned short bf16_t;
typedef short bf16x8 __attribute__((ext_vector_type(8)));
typedef short s16x4 __attribute__((ext_vector_type(4)));
typedef float f32x2 __attribute__((ext_vector_type(2)));
typedef float f32x4 __attribute__((ext_vector_type(4)));
typedef float f32x16 __attribute__((ext_vector_type(16)));
typedef unsigned u32x2 __attribute__((ext_vector_type(2)));
typedef unsigned u32x4 __attribute__((ext_vector_type(4)));
typedef __bf16 nbf16x2 __attribute__((ext_vector_type(2)));

DI unsigned pk2(float a, float b) { f32x2 v = {a, b}; nbf16x2 r = __builtin_convertvector(v, nbf16x2); return __builtin_bit_cast(unsigned, r); }
DI float bf2f(unsigned short h) { return __builtin_bit_cast(float, (unsigned)h << 16); }
DI float bflo(unsigned w) { return __builtin_bit_cast(float, w << 16); }
DI float bfhi(unsigned w) { return __builtin_bit_cast(float, w & 0xffff0000u); }
DI float sigmoidf_(float x) { return __builtin_amdgcn_rcpf(1.0f + __expf(-x)); }
DI float siluf_(float x) { return x * __builtin_amdgcn_rcpf(1.0f + __expf(-x)); }
DI int opq(int x) { asm volatile("" : "+v"(x)); return x; }

constexpr int NTOK = 24576, NPR = 8192, DM = 1024;
constexpr int MODW = 6144;
constexpr size_t OUT_Y = 0, OUT_NEWK = 25165824, OUT_NEWV = OUT_NEWK + 5242880, OUT_NEWS = OUT_NEWV + 5242880;
constexpr size_t WS_MOD = 0;
constexpr size_t WS_WQKV1 = 1048576;
constexpr size_t WS_WZ1 = WS_WQKV1 + 3328ull * 1024 * 2;
constexpr size_t WS_WOUT1 = WS_WZ1 + 1024ull * 1024 * 2;
constexpr size_t WS_BIG = WS_WOUT1 + 1024ull * 1024 * 2;
constexpr size_t B_WIN0 = WS_BIG, B_WOUT0 = B_WIN0 + 2304ull * 1024 * 2, B_W1_0 = B_WOUT0 + 1024ull * 1024 * 2, B_W2_0 = B_W1_0 + 4096ull * 1024 * 2;
constexpr size_t B_H0 = B_W2_0 + 4096ull * 1024 * 2;
constexpr size_t B_Q = B_H0 + (size_t)NTOK * 1024 * 2;
constexpr size_t B_KS = B_Q + (size_t)NTOK * 1024 * 2;
constexpr size_t B_VTS = B_KS + 8ull * 2304 * 640 * 2;
constexpr size_t B_KP = B_VTS + 8ull * 2304 * 640 * 2;
constexpr size_t B_VTP = B_KP + 8192ull * 640 * 2;
constexpr size_t B_FF0 = B_Q;
constexpr size_t B_QKV1 = WS_BIG;
constexpr size_t B_AB = B_QKV1 + (size_t)NTOK * 3072 * 2;
constexpr size_t B_OF = B_AB + (size_t)NTOK * 32 * 4;
constexpr size_t B_OB = B_OF + (size_t)NTOK * 1024 * 2;
constexpr size_t B_H1 = B_OF;
constexpr size_t B_W1_1 = WS_BIG, B_W2_1 = B_W1_1 + 4096ull * 1024 * 2;
constexpr size_t B_H1B = B_W2_1 + 4096ull * 1024 * 2;
constexpr size_t B_Z = B_H1B + (size_t)NTOK * 1024 * 2;
constexpr size_t B_FF1 = B_Z;
constexpr size_t B_FFL0 = B_H0, B_FFL1 = B_H1B;
constexpr size_t B_PS = B_FFL0 + (size_t)NTOK * 4096 * 2;
constexpr size_t B_HALO = B_OB + (size_t)NTOK * 1024 * 2;
constexpr size_t WS_NEED = (B_PS + 8192ull * 1024 * 4 > B_HALO + 384ull * 2 * 3072 * 2) ? B_PS + 8192ull * 1024 * 4 : B_HALO + 384ull * 2 * 3072 * 2;
static_assert(WS_NEED <= 271868064ull, "ws budget (halo)");
static_assert(B_FFL1 + (size_t)NTOK * 4096 * 2 <= B_PS && B_OB + (size_t)NTOK * 1024 * 2 <= WS_NEED, "ws map (mlp)");
static_assert(B_VTP + 8192ull * 640 * 2 <= WS_NEED && B_FF0 + (size_t)NTOK * 2048 * 2 <= WS_NEED && B_FF1 + (size_t)NTOK * 2048 * 2 <= WS_NEED, "ws map");
static_assert(B_Z + (size_t)NTOK * 1024 * 2 <= B_AB, "z inside dead qkv region");
static_assert(WS_NEED <= 271868064ull, "ws budget");

constexpr int LDS_BYTES = 151552;

struct Params { const float* in[32]; float* out; unsigned char* ws; };

namespace pg8 {
constexpr int BM = 256, BK = 64, HALF = 128, HTB = HALF * BK * 2, STAGE_BYTES = 8 * HTB, NXCD = 8, WGM = 8;
DI int lds_byte(int r, int c) { const int st = (r >> 4) * 2 + (c >> 5), rr = r & 15, cc = c & 31, ob = rr * 64 + cc * 2; return st * 1024 + (ob ^ (((ob >> 9) & 1) << 5)); }
DI void stage_rc(int b, int& R, int& C) { const int st = b / 1024, sb = b % 1024, swz = sb ^ (((sb >> 9) & 1) << 5); R = (st >> 1) * 16 + swz / 64; C = (st & 1) * 32 + (swz % 64) / 2; }
struct Unit { int pm, pn, kofs, nt, mode; };
struct Gemm { const bf16_t* A; const bf16_t* Bt; int lda, ldb, M, N, K; };
struct StaticOrder {
    int nM, nN, nwg, G, c;
    DI void init(int M, int N, int G_, int c_) { nM = M / BM; nN = N / BM; nwg = nM * nN; G = G_; c = c_; }
    DI bool next(int i, Unit& u) const {
        const long L = (long)i * G + c; if (L >= nwg) return false;
        int wgid = (int)L; { const int q = nwg / NXCD, r = nwg % NXCD, xcd = wgid % NXCD, off = wgid / NXCD; wgid = (xcd < r ? xcd * (q + 1) : r * (q + 1) + (xcd - r) * q) + off; }
        const int nig = WGM * nN, gid = wgid / nig, fm = gid * WGM, gsz = (nM - fm) < WGM ? (nM - fm) : WGM;
        u.pm = fm + ((wgid % nig) % gsz); u.pn = (wgid % nig) / gsz; u.kofs = 0; u.nt = 0; u.mode = 0; return true;
    }
};

struct W2Order { int c, ntf;
    DI bool next(int i, Unit& u) const {
        const int x = c & 7, j = c >> 3;
        if (i == 0) { u.pm = 8 * x + (j >> 2); u.pn = j & 3; u.kofs = 0; u.nt = ntf; u.mode = 0; return true; }
        if (i == 1) { const int st = j >> 1; u.pm = 64 + 4 * x + (st >> 2); u.pn = st & 3; u.kofs = (j & 1) * (ntf * 32); u.nt = ntf / 2; u.mode = j & 1; return true; }
        return false; } };

template <class Epi, class Sched>
DI void gemm_phase(LAS unsigned char* lds, const Gemm g, const Sched& S, const Epi& E) {
    const int tid = opq(threadIdx.x), wid = __builtin_amdgcn_readfirstlane(tid >> 6), lane = tid & 63, wr = wid >> 2, wc = wid & 3, fr = lane & 15, fq = lane >> 4;
    const int K = g.K;
    unsigned voffA[2], voffB[2];
#pragma unroll
    for (int i = 0; i < 2; ++i) { int R, C; stage_rc(tid * 16 + i * 8192, R, C);
        voffA[i] = (unsigned)(R * g.lda + C) * 2u; voffB[i] = (unsigned)(R * g.ldb + C) * 2u; }
    const size_t kstep = (size_t)(BK * 2);
    const size_t hstepA = (size_t)HALF * g.lda * 2, hstepB = (size_t)HALF * g.ldb * 2;
    const size_t tstepA = 2 * hstepA, tstepB = 2 * hstepB;
    const unsigned ldsw = (unsigned)wid * 1024u;
    const int aoff = lds_byte(wr * 64 + fr, fq * 8), boff = lds_byte(wc * 32 + fr, fq * 8);
#define PG8_SA(b, h) (((b) * 2 + (h)) * HTB)
#define PG8_SB(b, h) ((4 + (b) * 2 + (h)) * HTB)
#define PG8_STAGE(bufoff, gbase, voff) do { _Pragma("unroll") for (int _i = 0; _i < 2; ++_i) \
        __builtin_amdgcn_global_load_lds((const unsigned*)((const char*)(gbase) + (voff)[_i]), (LAS unsigned*)(lds + (bufoff) + ldsw + _i * 8192), 16, 0, 0); } while (0)
#define PG8_LDA(dst, b, h) do { _Pragma("unroll") for (int m = 0; m < 4; ++m) _Pragma("unroll") for (int k = 0; k < 2; ++k) dst[m][k] = *(const LAS bf16x8*)(lds + PG8_SA(b, h) + aoff + m * 2048 + k * 1024); } while (0)
#define PG8_LDB(dst, b, h) do { _Pragma("unroll") for (int n = 0; n < 2; ++n) _Pragma("unroll") for (int k = 0; k < 2; ++k) dst[n][k] = *(const LAS bf16x8*)(lds + PG8_SB(b, h) + boff + n * 2048 + k * 1024); } while (0)
#define PG8_MMA(ai, bj, At, Bt) do { __builtin_amdgcn_s_setprio(1); _Pragma("unroll") for (int m = 0; m < 4; ++m) _Pragma("unroll") for (int n = 0; n < 2; ++n) _Pragma("unroll") for (int k = 0; k < 2; ++k) \
        acc[ai][bj][m][n] = __builtin_amdgcn_mfma_f32_16x16x32_bf16(Bt[n][k], At[m][k], acc[ai][bj][m][n], 0, 0, 0); __builtin_amdgcn_s_setprio(0); } while (0)
#define PG8_WAIT_V(n) asm volatile("s_waitcnt vmcnt(" #n ")" ::: "memory")
#define PG8_WAIT_L(n) asm volatile("s_waitcnt lgkmcnt(" #n ")" ::: "memory")
#define PG8_BAR __builtin_amdgcn_s_barrier()
#define PG8_SCHED __builtin_amdgcn_sched_barrier(0)
    Unit cur, nxt; int ui = 0;
    if (!S.next(0, cur)) return;
    if (cur.nt == 0) cur.nt = K / BK;
    f32x4 acc[2][2][4][2];
#pragma unroll
    for (int a = 0; a < 2; ++a)
#pragma unroll
        for (int b = 0; b < 2; ++b)
#pragma unroll
            for (int m = 0; m < 4; ++m)
#pragma unroll
                for (int n = 0; n < 2; ++n) acc[a][b][m][n] = (f32x4){0.f, 0.f, 0.f, 0.f};
    bf16x8 At[4][2], B0[2][2], B1[2][2];
    const char* cA = (const char*)g.A + (size_t)cur.pm * tstepA + (size_t)cur.kofs * 2; const char* cB = (const char*)g.Bt + (size_t)cur.pn * tstepB + (size_t)cur.kofs * 2;
    PG8_STAGE(PG8_SB(0, 0), cB, voffB); PG8_STAGE(PG8_SB(0, 1), cB + hstepB, voffB); PG8_STAGE(PG8_SA(0, 0), cA, voffA); PG8_STAGE(PG8_SA(0, 1), cA + hstepA, voffA);
    if (wr == 1) PG8_BAR;
    PG8_WAIT_V(2); PG8_BAR;
    PG8_STAGE(PG8_SB(1, 0), cB + kstep, voffB); PG8_STAGE(PG8_SA(1, 0), cA + kstep, voffA); PG8_STAGE(PG8_SB(1, 1), cB + hstepB + kstep, voffB);
    PG8_WAIT_V(6); PG8_BAR;
    for (;;) {
        const bool has_next = S.next(ui + 1, nxt);
        if (has_next && nxt.nt == 0) nxt.nt = K / BK;
        const char* nA = has_next ? (const char*)g.A + (size_t)nxt.pm * tstepA + (size_t)nxt.kofs * 2 : cA; const char* nB = has_next ? (const char*)g.Bt + (size_t)nxt.pn * tstepB + (size_t)nxt.kofs * 2 : cB;
        const int nt = cur.nt;
        for (int t = 0; t < nt; t += 2) {
            const bool last = (t == nt - 2);
            const char* a1 = cA + (size_t)(t + 1) * kstep;
            const char* a2 = last ? nA : cA + (size_t)(t + 2) * kstep; const char* b2 = last ? nB : cB + (size_t)(t + 2) * kstep;
            const char* a3 = a2 + kstep; const char* b3 = b2 + kstep;
            PG8_LDB(B0, 0, 0); PG8_LDB(B1, 0, 1); PG8_SCHED; PG8_LDA(At, 0, 0); PG8_STAGE(PG8_SA(1, 1), a1 + hstepA, voffA);
            PG8_WAIT_V(8); PG8_WAIT_L(0); PG8_BAR; PG8_MMA(0, 0, At, B0); PG8_MMA(0, 1, At, B1); PG8_BAR; PG8_SCHED;
            PG8_LDA(At, 0, 1); PG8_STAGE(PG8_SB(0, 0), b2, voffB); PG8_STAGE(PG8_SB(0, 1), b2 + hstepB, voffB); PG8_STAGE(PG8_SA(0, 0), a2, voffA);
            PG8_WAIT_V(8); PG8_WAIT_L(0); PG8_BAR; PG8_MMA(1, 0, At, B0); PG8_MMA(1, 1, At, B1); PG8_BAR; PG8_SCHED;
            PG8_LDB(B0, 1, 0); PG8_LDB(B1, 1, 1); PG8_SCHED; PG8_LDA(At, 1, 0); PG8_STAGE(PG8_SA(0, 1), a2 + hstepA, voffA);
            PG8_WAIT_V(8); PG8_WAIT_L(0); PG8_BAR; PG8_MMA(0, 0, At, B0); PG8_MMA(0, 1, At, B1); PG8_BAR; PG8_SCHED;
            PG8_LDA(At, 1, 1); PG8_STAGE(PG8_SB(1, 0), b3, voffB); PG8_STAGE(PG8_SB(1, 1), b3 + hstepB, voffB); PG8_STAGE(PG8_SA(1, 0), a3, voffA);
            PG8_WAIT_V(8); PG8_WAIT_L(0); PG8_BAR; PG8_MMA(1, 0, At, B0); PG8_MMA(1, 1, At, B1); PG8_BAR; PG8_SCHED;
        }
        if (wr == 0) PG8_BAR;
        E(acc, cur, wr, wc, fr, fq);
        if (!has_next) break;
#pragma unroll
        for (int a = 0; a < 2; ++a)
#pragma unroll
            for (int b = 0; b < 2; ++b)
#pragma unroll
                for (int m = 0; m < 4; ++m)
#pragma unroll
                    for (int n = 0; n < 2; ++n) acc[a][b][m][n] = (f32x4){0.f, 0.f, 0.f, 0.f};
        cur = nxt; cA = nA; cB = nB; ++ui;
        if (wr == 1) PG8_BAR;
    }
    PG8_WAIT_V(0);
    PG8_BAR;
#undef PG8_SA
#undef PG8_SB
#undef PG8_STAGE
#undef PG8_LDA
#undef PG8_LDB
#undef PG8_MMA
#undef PG8_WAIT_V
#undef PG8_WAIT_L
#undef PG8_BAR
#undef PG8_SCHED
}
}
using pg8::Unit;

#define XB_TMO      128
#define XB_XCNT(j)  (256  + 64 * (j))
#define XB_XSUB(j)  (1280 + 64 * (j))
#define XB_XGEN(j)  (2304 + 64 * (j))
#define XB_TOP      3328
#define XB_TOPGEN   3392
#define XCD_BAR_WORDS 3456
#define XB_SPIN_CAP (1u << 18)

__device__ __forceinline__ unsigned xb_ld(unsigned* p)              { return __hip_atomic_load(p, __ATOMIC_RELAXED, __HIP_MEMORY_SCOPE_AGENT); }
__device__ __forceinline__ unsigned xb_add(unsigned* p, unsigned v) { return __hip_atomic_fetch_add(p, v, __ATOMIC_RELAXED, __HIP_MEMORY_SCOPE_AGENT); }
__device__ __forceinline__ unsigned xb_xcc_id() { return (unsigned)__builtin_amdgcn_s_getreg((3 << 11) | 20) & 0xFu; }
#define XB_SPIN(cond, bar) do { unsigned _sp = 0; while (cond) { __builtin_amdgcn_s_sleep(1); \
    if ((++_sp & 255u) == 0u) { if (xb_ld(&(bar)[XB_TMO])) break; if (_sp > XB_SPIN_CAP) { atomicAdd(&(bar)[XB_TMO], 1u); break; } } } } while (0)

struct XcdBarrier {
    unsigned* bar; unsigned x;
    volatile LAS unsigned* st;
};

__device__ __forceinline__ XcdBarrier xcd_barrier_post(unsigned* bar, volatile LAS unsigned* st) {
    XcdBarrier b; b.bar = bar; b.x = xb_xcc_id(); b.st = st;
    if (threadIdx.x == 0) (void)xb_add(&bar[XB_XCNT(b.x)], 1u);
    return b;
}
__device__ __forceinline__ void xcd_barrier_complete(unsigned* bar, unsigned x, unsigned& nloc, unsigned& nx) {
    const unsigned G = gridDim.x * gridDim.y * gridDim.z;
    unsigned sum, cnt, mine, sp = 0u;
    for (;;) {
        sum = 0u; cnt = 0u; mine = 0u;
#pragma unroll
        for (unsigned j = 0; j < 16; ++j) { const unsigned c = xb_ld(&bar[XB_XCNT(j)]); sum += c; cnt += (c > 0u) ? 1u : 0u; mine = (j == x) ? c : mine; }
        if (sum == G) break;
        __builtin_amdgcn_s_sleep(1);
        if ((++sp & 255u) == 0u) { if (xb_ld(&bar[XB_TMO])) break; if (sp > XB_SPIN_CAP) { atomicAdd(&bar[XB_TMO], 1u); break; } }
    }
    nloc = mine > 0u ? mine : 1u; nx = cnt > 0u ? cnt : 1u;
}

__device__ __forceinline__ void xcd_barrier(const XcdBarrier& b) {
    asm volatile("s_waitcnt vmcnt(0)" ::: "memory");
    __syncthreads();
    if (threadIdx.x == 0) {
        unsigned* bar = b.bar;
        __builtin_amdgcn_s_waitcnt(0);
        unsigned nloc = b.st[0], nx = b.st[1];
        if (nloc == 0u) { xcd_barrier_complete(bar, b.x, nloc, nx); b.st[0] = nloc; b.st[1] = nx; }
        const unsigned old = xb_add(&bar[XB_XSUB(b.x)], 1u);
        const unsigned gen = old / nloc;
        if (old + 1u == (gen + 1u) * nloc) {
            __builtin_amdgcn_fence(__ATOMIC_RELEASE, "agent");
            asm volatile("s_waitcnt vmcnt(0)" ::: "memory");
            const unsigned og = xb_add(&bar[XB_TOP], 1u);
            const unsigned tg = og / nx;
            if (og + 1u == (tg + 1u) * nx) xb_add(&bar[XB_TOPGEN], 1u);
            else XB_SPIN(xb_ld(&bar[XB_TOPGEN]) == tg, bar);
            __builtin_amdgcn_fence(__ATOMIC_ACQUIRE, "agent");
            xb_add(&bar[XB_XGEN(b.x)], 1u);
            asm volatile("s_waitcnt vmcnt(0)" ::: "memory");
        } else {
            XB_SPIN(xb_ld(&bar[XB_XGEN(b.x)]) == gen, bar);
            __builtin_amdgcn_fence(__ATOMIC_ACQUIRE, "agent");
            asm volatile("s_waitcnt vmcnt(0)" ::: "memory");
        }
    }
    __syncthreads();
}


DI int mod_row(int pm) { return pm < 32 ? 0 : 1 + ((pm - 32) >> 3); }

constexpr int XBP = 2048;
struct EpiRes {
    const float* inA; const float* inB; bf16_t* XB; const float* gate;
    float* P; int accum;
    DI void operator()(const f32x4 (&acc)[2][2][4][2], const Unit& u, int wr, int wc, int fr, int fq) const {
        const int col0 = u.pn * 256 + wc * 64 + 4 * fq;
        const float* gp = gate + mod_row(u.pm) * MODW + col0;
        f32x4 gv[2][2];
#pragma unroll
        for (int bj = 0; bj < 2; ++bj)
#pragma unroll
            for (int n = 0; n < 2; ++n) gv[bj][n] = *(const f32x4*)(gp + 32 * bj + 16 * n);
        const int row0 = u.pm * 256 + wr * 64 + fr;
        const float* xin = inA ? ((u.pm < 32) ? inA + (size_t)row0 * DM : inB + (size_t)(row0 - NPR) * DM) : nullptr;
#pragma unroll
        for (int ai = 0; ai < 2; ++ai)
#pragma unroll
            for (int m = 0; m < 4; ++m) {
                const size_t ro = (size_t)(ai * 128 + m * 16) * DM + col0;
                bf16_t* xp = XB + (size_t)(row0 + ai * 128 + m * 16) * XBP + col0;
#pragma unroll
                for (int bj = 0; bj < 2; ++bj)
#pragma unroll
                    for (int n = 0; n < 2; ++n) {
                        if (u.mode == 0) {
                            f32x4 x;
                            if (xin) x = *(const f32x4*)(xin + ro + 32 * bj + 16 * n);
                            else { const u32x2 w = *(const u32x2*)(xp + 32 * bj + 16 * n); x = (f32x4){bflo(w.x), bfhi(w.x), bflo(w.y), bfhi(w.y)}; }
                            x = x + gv[bj][n] * acc[ai][bj][m][n];
                            u32x2 o; o.x = pk2(x.x, x.y); o.y = pk2(x.z, x.w);
                            *(u32x2*)(xp + 32 * bj + 16 * n) = o;
                        } else {
                            f32x4* pp = (f32x4*)(P + (size_t)(row0 - 16384) * DM + ro + 32 * bj + 16 * n);
                            f32x4 v = gv[bj][n] * acc[ai][bj][m][n];
                            if (accum) v = v + *pp;
                            *pp = v;
                        }
                    }
            }
    }
};

template <int ACT> struct EpiBf16 {
    bf16_t* O; int ldc;
    DI void operator()(const f32x4 (&acc)[2][2][4][2], const Unit& u, int wr, int wc, int fr, int fq) const {
        const int col0 = u.pn * 256 + wc * 64 + 4 * fq;
        const int row0 = u.pm * 256 + wr * 64 + fr;
#pragma unroll
        for (int ai = 0; ai < 2; ++ai)
#pragma unroll
            for (int m = 0; m < 4; ++m) {
                bf16_t* op = O + (size_t)(row0 + ai * 128 + m * 16) * ldc + col0;
#pragma unroll
                for (int bj = 0; bj < 2; ++bj)
#pragma unroll
                    for (int n = 0; n < 2; ++n) {
                        f32x4 v = acc[ai][bj][m][n];
                        if (ACT == 1) { v.x = fmaxf(v.x, 0.f); v.y = fmaxf(v.y, 0.f); v.z = fmaxf(v.z, 0.f); v.w = fmaxf(v.w, 0.f); v = v * v; }
                        u32x2 w; w.x = pk2(v.x, v.y); w.y = pk2(v.z, v.w);
                        *(u32x2*)(op + 32 * bj + 16 * n) = w;
                    }
            }
    }
};

struct EpiQKV1 {
    bf16_t* QKV; float* AB; bf16_t* ZL; int zp; bf16_t* HALO;
    DI void operator()(const f32x4 (&acc)[2][2][4][2], const Unit& u, int wr, int wc, int fr, int fq) const {
        asm volatile("" : "+v"(fr), "+v"(fq));
        const int row0 = u.pm * 256 + wr * 64 + fr;
        if (u.pn < 12) {
            const int col0 = u.pn * 256 + wc * 64 + 4 * fq;
#pragma unroll
            for (int ai = 0; ai < 2; ++ai)
#pragma unroll
                for (int m = 0; m < 4; ++m) {
                    bf16_t* op = QKV + (size_t)(row0 + ai * 128 + m * 16) * 3072 + col0;
#pragma unroll
                    for (int bj = 0; bj < 2; ++bj)
#pragma unroll
                        for (int n = 0; n < 2; ++n) {
                            const f32x4 v = acc[ai][bj][m][n];
                            u32x2 w; w.x = pk2(v.x, v.y); w.y = pk2(v.z, v.w);
                            *(u32x2*)(op + 32 * bj + 16 * n) = w;
                            if ((m == 0 && fr == 0) || (m == 3 && fr == 15))
                                *(u32x2*)(HALO + ((size_t)((row0 + ai * 128 + m * 16) >> 6) * 2 + (m == 3 ? 1 : 0)) * 3072 + col0 + 32 * bj + 16 * n) = w;
                        }
                }
        } else if (u.pn > 12) {
            const int col0 = (u.pn - 13) * 256 + wc * 64 + 4 * fq;
#pragma unroll
            for (int ai = 0; ai < 2; ++ai)
#pragma unroll
                for (int m = 0; m < 4; ++m) {
                    bf16_t* op = ZL + (size_t)(row0 + ai * 128 + m * 16) * zp + col0;
#pragma unroll
                    for (int bj = 0; bj < 2; ++bj)
#pragma unroll
                        for (int n = 0; n < 2; ++n) {
                            const f32x4 v = acc[ai][bj][m][n];
                            u32x2 w; w.x = pk2(v.x, v.y); w.y = pk2(v.z, v.w);
                            *(u32x2*)(op + 32 * bj + 16 * n) = w;
                        }
                }
        } else if (wc == 0) {
#pragma unroll
            for (int ai = 0; ai < 2; ++ai)
#pragma unroll
                for (int m = 0; m < 4; ++m) {
                    float* op = AB + (size_t)(row0 + ai * 128 + m * 16) * 32 + 4 * fq;
#pragma unroll
                    for (int n = 0; n < 2; ++n) *(f32x4*)(op + 16 * n) = acc[ai][0][m][n];
                }
        }
    }
};

struct EpiQKV0 {
    bf16_t *Q, *KS, *VTS, *KP, *VTP; float *newk, *newv;
    const float *qna, *kna, *qnb, *knb;
    DI void operator()(const f32x4 (&acc)[2][2][4][2], const Unit& u, int wr, int wc, int fr, int fq) const {
        asm volatile("" : "+v"(fr), "+v"(fq));
        const int pn = u.pn; const bool prompt = u.pm < 32;
        int type, head; const float* gain = qna; bool rope = false;
        if (pn < 2) { type = 0; head = 4 * pn + wc; gain = qna; rope = true; }
        else if (pn == 2) { if (wc < 2) { type = 1; head = wc; gain = kna; rope = true; } else { type = 2; head = wc - 2; } }
        else if (pn < 5) { type = 0; head = 8 + 4 * (pn - 3) + wc; gain = qnb; }
        else if (pn < 7) { type = 1; head = 2 + 4 * (pn - 5) + wc; gain = knb; }
        else { type = 2; head = 2 + 4 * (pn - 7) + wc; }
        rope = rope && !prompt;
        float invf[4];
#pragma unroll
        for (int j = 0; j < 4; ++j) invf[j] = __builtin_amdgcn_exp2f(-(float)(4 * fq + j) * 0.83048202372184059f);
        const int row0 = u.pm * 256 + wr * 64 + fr;
#pragma unroll
        for (int ai = 0; ai < 2; ++ai)
#pragma unroll
            for (int m = 0; m < 4; ++m) {
                const int mg = row0 + ai * 128 + m * 16;
                f32x4 v[2][2];
#pragma unroll
                for (int bj = 0; bj < 2; ++bj)
#pragma unroll
                    for (int n = 0; n < 2; ++n) v[bj][n] = acc[ai][bj][m][n];
                if (type != 2) {
                    float ss = 0.f;
#pragma unroll
                    for (int bj = 0; bj < 2; ++bj)
#pragma unroll
                        for (int n = 0; n < 2; ++n) { const f32x4 x = v[bj][n]; ss += (x.x * x.x + x.y * x.y) + (x.z * x.z + x.w * x.w); }
                    ss += __shfl_xor(ss, 16); ss += __shfl_xor(ss, 32);
                    const float rinv = __builtin_amdgcn_rsqf(ss * (1.0f / 64.0f) + 1e-6f);
#pragma unroll
                    for (int bj = 0; bj < 2; ++bj)
#pragma unroll
                        for (int n = 0; n < 2; ++n) v[bj][n] = v[bj][n] * rinv * *(const f32x4*)(gain + 32 * bj + 16 * n + 4 * fq);
                    if (rope) {
                        const int t = (mg - NPR) & 2047;
                        const float pos[2] = {(float)(t >> 6), (float)(t & 63)};
#pragma unroll
                        for (int bj = 0; bj < 2; ++bj)
#pragma unroll
                            for (int j = 0; j < 4; ++j) {
                                const float ang = pos[bj] * invf[j];
                                const float cs = __cosf(ang), sn = __sinf(ang);
                                const float x1 = v[bj][0][j], x2 = v[bj][1][j];
                                v[bj][0][j] = x1 * cs - x2 * sn; v[bj][1][j] = x2 * cs + x1 * sn;
                            }
                    }
                }
                int b, t, ntile; bf16_t* kbase; bf16_t* vbase;
                if (prompt) { b = mg >> 8; t = mg & 255; ntile = 8; kbase = KP; vbase = VTP; }
                else { b = (mg - NPR) >> 11; t = (mg - NPR) & 2047; ntile = 72; kbase = KS; vbase = VTS; }
                const size_t tbase = ((size_t)(b * 10 + head) * ntile + (t >> 5)) * 2048; const int kk = t & 31;
#pragma unroll
                for (int bj = 0; bj < 2; ++bj)
#pragma unroll
                    for (int n = 0; n < 2; ++n) {
                        const int d0 = 32 * bj + 16 * n + 4 * fq;
                        const f32x4 x = v[bj][n];
                        if (type == 0) { u32x2 w; w.x = pk2(x.x, x.y); w.y = pk2(x.z, x.w); *(u32x2*)(Q + (size_t)mg * 1024 + head * 64 + d0) = w; }
                        else if (type == 1) {
                            u32x2 w; w.x = pk2(x.x, x.y); w.y = pk2(x.z, x.w); *(u32x2*)(kbase + tbase + ((d0 >> 3) * 32 + kk) * 8 + (d0 & 7)) = w;
                            if (prompt) *(f32x4*)(newk + (size_t)mg * 640 + head * 64 + d0) = x;
                        } else {
                            bf16_t* vp = vbase + tbase + ((((((d0 >> 5) * 2 + (kk >> 4)) * 2 + ((kk >> 3) & 1)) * 2 + ((kk >> 2) & 1)) * 32 + (d0 & 31)) << 2) + (kk & 3);
                            const unsigned w0 = pk2(x.x, x.y), w1 = pk2(x.z, x.w);
                            vp[0] = (bf16_t)(w0 & 0xffffu); vp[4] = (bf16_t)(w0 >> 16); vp[8] = (bf16_t)(w1 & 0xffffu); vp[12] = (bf16_t)(w1 >> 16);
                            if (prompt) *(f32x4*)(newv + (size_t)mg * 640 + head * 64 + d0) = x;
                        }
                    }
                asm volatile("" ::: "memory");
            }
    }
};

DI float wave_sum(float v) {
#pragma unroll
    for (int o = 1; o < 64; o <<= 1) v += __shfl_xor(v, o);
    return v;
}
DI int perm_row32(int n0) { return (n0 & ~255) + 128 * ((n0 >> 5) & 1) + 32 * ((n0 >> 6) & 3); }

DI void transpose_item(const float* W, int N, int k0, int n0, bf16_t* WT, int ldt, int row0, LAS float* scr, int lane) {
#pragma unroll 8
    for (int i = 0; i < 32; ++i) { const int kk = 2 * i + (lane >> 5); scr[kk * 33 + (lane & 31)] = W[(size_t)(k0 + kk) * N + n0 + (lane & 31)]; }
    asm volatile("s_waitcnt lgkmcnt(0)" ::: "memory");
    const int c = lane & 7;
#pragma unroll
    for (int j = 0; j < 4; ++j) { const int n = (lane >> 3) + 8 * j; const LAS float* s = scr + (8 * c) * 33 + n;
        u32x4 o; o.x = pk2(s[0 * 33], s[1 * 33]); o.y = pk2(s[2 * 33], s[3 * 33]); o.z = pk2(s[4 * 33], s[5 * 33]); o.w = pk2(s[6 * 33], s[7 * 33]);
        *(u32x4*)(WT + (size_t)(row0 + n) * ldt + k0 + 8 * c) = o; }
    asm volatile("s_waitcnt lgkmcnt(0)" ::: "memory");
}
DI void transpose_matrix(const float* W, int K, int N, bf16_t* WT, LAS float* scr, int gw, int NGW, int lane) {
    const int nblk = N / 32, nitems = (K / 64) * nblk;
    for (int it = gw; it < nitems; it += NGW) { const int kb = it / nblk, nb = it % nblk; transpose_item(W, N, kb * 64, nb * 32, WT, K, perm_row32(nb * 32), scr, lane); }
}

DI void norm_phase(const float* xa, const float* xb, bf16_t* XB, const float* gain, const float* sh, const float* sc, bf16_t* H, int hp, int gw, int NGW, int lane, const float* P = nullptr) {
    for (int m0 = gw; m0 < NTOK; m0 += 2 * NGW) {
        const int m1 = m0 + NGW; const bool has1 = m1 < NTOK; const int m1c = has1 ? m1 : m0;
        f32x4 v0[4], v1[4];
        if (XB) {
#pragma unroll
            for (int j = 0; j < 4; ++j) {
                const u32x2 w0 = *(const u32x2*)(XB + (size_t)m0 * XBP + 4 * lane + 256 * j), w1 = *(const u32x2*)(XB + (size_t)m1c * XBP + 4 * lane + 256 * j);
                v0[j] = (f32x4){bflo(w0.x), bfhi(w0.x), bflo(w0.y), bfhi(w0.y)}; v1[j] = (f32x4){bflo(w1.x), bfhi(w1.x), bflo(w1.y), bfhi(w1.y)};
            }
        } else {
            const float* xr0 = (m0 < NPR) ? xa + (size_t)m0 * DM : xb + (size_t)(m0 - NPR) * DM;
            const float* xr1 = (m1c < NPR) ? xa + (size_t)m1c * DM : xb + (size_t)(m1c - NPR) * DM;
#pragma unroll
            for (int j = 0; j < 4; ++j) { v0[j] = *(const f32x4*)(xr0 + 4 * lane + 256 * j); v1[j] = *(const f32x4*)(xr1 + 4 * lane + 256 * j); }
        }
        if (P) {
#pragma unroll
            for (int j = 0; j < 4; ++j) {
                if (m0 >= 16384) { v0[j] = v0[j] + *(const f32x4*)(P + (size_t)(m0 - 16384) * DM + 4 * lane + 256 * j);
                    u32x2 o; o.x = pk2(v0[j].x, v0[j].y); o.y = pk2(v0[j].z, v0[j].w); *(u32x2*)(XB + (size_t)m0 * XBP + 4 * lane + 256 * j) = o; }
                if (has1 && m1 >= 16384) { v1[j] = v1[j] + *(const f32x4*)(P + (size_t)(m1 - 16384) * DM + 4 * lane + 256 * j);
                    u32x2 o; o.x = pk2(v1[j].x, v1[j].y); o.y = pk2(v1[j].z, v1[j].w); *(u32x2*)(XB + (size_t)m1 * XBP + 4 * lane + 256 * j) = o; }
            }
        }
        float s0 = 0.f, s1 = 0.f;
#pragma unroll
        for (int j = 0; j < 4; ++j) { s0 += (v0[j].x * v0[j].x + v0[j].y * v0[j].y) + (v0[j].z * v0[j].z + v0[j].w * v0[j].w); s1 += (v1[j].x * v1[j].x + v1[j].y * v1[j].y) + (v1[j].z * v1[j].z + v1[j].w * v1[j].w); }
        const float r0 = __builtin_amdgcn_rsqf(wave_sum(s0) * (1.0f / DM) + 1e-6f), r1 = __builtin_amdgcn_rsqf(wave_sum(s1) * (1.0f / DM) + 1e-6f);
        const int mr0 = (m0 < NPR) ? 0 : 1 + ((m0 - NPR) >> 11), mr1 = (m1c < NPR) ? 0 : 1 + ((m1c - NPR) >> 11);
#pragma unroll
        for (int j = 0; j < 4; ++j) {
            const int c = 4 * lane + 256 * j;
            const f32x4 g = *(const f32x4*)(gain + c);
            { const f32x4 a = *(const f32x4*)(sc + mr0 * MODW + c), b = *(const f32x4*)(sh + mr0 * MODW + c);
              const f32x4 o = v0[j] * r0 * g * (a + 1.0f) + b; u32x2 w; w.x = pk2(o.x, o.y); w.y = pk2(o.z, o.w); *(u32x2*)(H + (size_t)m0 * hp + c) = w; }
            if (has1) { const f32x4 a = *(const f32x4*)(sc + mr1 * MODW + c), b = *(const f32x4*)(sh + mr1 * MODW + c);
              const f32x4 o = v1[j] * r1 * g * (a + 1.0f) + b; u32x2 w; w.x = pk2(o.x, o.y); w.y = pk2(o.z, o.w); *(u32x2*)(H + (size_t)m1 * hp + c) = w; }
        }
    }
}

#define MFMA32(a, b, c) __builtin_amdgcn_mfma_f32_32x32x16_bf16((a), (b), (c), 0, 0, 0)
template <int NH, bool NA>
DI void attn_unit(const bf16_t* Qrow, const bf16_t* Kp, const bf16_t* VTp, int vstride,
                  int seg0_start, int seg0_tiles, int seg1_start, int seg1_tiles,
                  const LAS float* biasH, int qr, int c0, float shift, bf16_t* Orow, int lane) {
    const int r = lane & 31, hh = lane >> 5;
    bf16x8 Qf[NH][4];
#pragma unroll
    for (int h = 0; h < NH; ++h)
#pragma unroll
        for (int s = 0; s < 4; ++s) Qf[h][s] = *(const bf16x8*)(Qrow + (size_t)r * 1024 + (NA ? 32 * 1024 : 64) * h + 16 * s + 8 * hh);
    f32x16 O[NH][2]; float mrun[NH], lrun[NH];
#pragma unroll
    for (int h = 0; h < NH; ++h) { mrun[h] = -1e30f; lrun[h] = 0.f;
#pragma unroll
        for (int b = 0; b < 2; ++b)
#pragma unroll
            for (int i = 0; i < 16; ++i) O[h][b][i] = 0.f; }
    const float SC = 0.125f * 1.4426950408889634f;
    const int ntiles = seg0_tiles + seg1_tiles;
    bf16x8 Kn[4]; s16x4 Vln[2][2], Vhn[2][2];
    {
        const int k0 = seg0_tiles > 0 ? seg0_start : seg1_start;
        const bf16_t* kt = Kp + (size_t)(k0 >> 5) * 2048; const bf16_t* vt = VTp + (size_t)(k0 >> 5) * 2048;
#pragma unroll
        for (int s = 0; s < 4; ++s) Kn[s] = *(const bf16x8*)(kt + (s * 64 + lane) * 8);
#pragma unroll
        for (int b = 0; b < 2; ++b)
#pragma unroll
            for (int s = 0; s < 2; ++s) { Vln[b][s] = *(const s16x4*)(vt + (((b * 2 + s) * 2 + 0) * 64 + lane) * 4); Vhn[b][s] = *(const s16x4*)(vt + (((b * 2 + s) * 2 + 1) * 64 + lane) * 4); }
    }
    for (int ti = 0; ti < ntiles; ++ti) {
        const bool loc = ti < seg0_tiles;
        const int k0 = loc ? seg0_start + 32 * ti : seg1_start + 32 * (ti - seg0_tiles);
        bf16x8 Kf[4]; s16x4 Vlo[2][2], Vhi[2][2];
#pragma unroll
        for (int s = 0; s < 4; ++s) Kf[s] = Kn[s];
#pragma unroll
        for (int b = 0; b < 2; ++b)
#pragma unroll
            for (int s = 0; s < 2; ++s) { Vlo[b][s] = Vln[b][s]; Vhi[b][s] = Vhn[b][s]; }
        {
            const int tn = min(ti + 1, ntiles - 1);
            const int k1 = (tn < seg0_tiles) ? seg0_start + 32 * tn : seg1_start + 32 * (tn - seg0_tiles);
            const bf16_t* kt = Kp + (size_t)(k1 >> 5) * 2048; const bf16_t* vt = VTp + (size_t)(k1 >> 5) * 2048;
#pragma unroll
            for (int s = 0; s < 4; ++s) Kn[s] = *(const bf16x8*)(kt + (s * 64 + lane) * 8);
#pragma unroll
            for (int b = 0; b < 2; ++b)
#pragma unroll
                for (int s = 0; s < 2; ++s) { Vln[b][s] = *(const s16x4*)(vt + (((b * 2 + s) * 2 + 0) * 64 + lane) * 4); Vhn[b][s] = *(const s16x4*)(vt + (((b * 2 + s) * 2 + 1) * 64 + lane) * 4); }
        }
#pragma unroll
        for (int h = 0; h < NH; ++h) {
            f32x16 st;
#pragma unroll
            for (int i = 0; i < 16; ++i) st[i] = 0.f;
#pragma unroll
            for (int s = 0; s < 4; ++s) st = MFMA32(Kf[s], Qf[h][s], st);
            float ps = 0.f;
            if (NA && loc) {
                const int c = c0 + 32 * h + r, cs = min(max(c - 8, 0), 48);
                const int d0 = (k0 & 63) + 4 * hh - cs;
                const int b0 = ((k0 >> 6) - qr + 7) * 31 + (cs - c + 15);
#pragma unroll
                for (int i = 0; i < 16; ++i) {
                    const int d = d0 + (i & 3) + 8 * (i >> 2);
                    const bool valid = (unsigned)d < 16u;
                    const float bv = biasH[valid ? b0 + d : 0];
                    const float x = valid ? st[i] * SC - shift + bv * 1.4426950408889634f : -1e30f;
                    const float p = __builtin_amdgcn_exp2f(x); st[i] = p; ps += p;
                }
            } else {
#pragma unroll
                for (int i = 0; i < 16; ++i) { const float p = __builtin_amdgcn_exp2f(st[i] * SC - shift); st[i] = p; ps += p; }
            }
            lrun[h] += ps;
#pragma unroll
            for (int s = 0; s < 2; ++s) {
                u32x4 pw; pw.x = pk2(st[8 * s + 0], st[8 * s + 1]); pw.y = pk2(st[8 * s + 2], st[8 * s + 3]); pw.z = pk2(st[8 * s + 4], st[8 * s + 5]); pw.w = pk2(st[8 * s + 6], st[8 * s + 7]);
                const bf16x8 Pf = __builtin_bit_cast(bf16x8, pw);
#pragma unroll
                for (int b = 0; b < 2; ++b) {
                    const bf16x8 Vf = __builtin_shufflevector(Vlo[b][s], Vhi[b][s], 0, 1, 2, 3, 4, 5, 6, 7);
                    O[h][b] = MFMA32(Vf, Pf, O[h][b]);
                }
            }
        }
    }
#pragma unroll
    for (int h = 0; h < NH; ++h) {
        const float lt = lrun[h] + __shfl_xor(lrun[h], 32);
        const float inv = 1.0f / lt;
#pragma unroll
        for (int b = 0; b < 2; ++b)
#pragma unroll
            for (int g = 0; g < 4; ++g) {
                u32x2 w; w.x = pk2(O[h][b][4 * g] * inv, O[h][b][4 * g + 1] * inv); w.y = pk2(O[h][b][4 * g + 2] * inv, O[h][b][4 * g + 3] * inv);
                *(u32x2*)(Orow + (size_t)r * 1024 + (NA ? 32 * 1024 : 64) * h + 32 * b + 8 * g + 4 * hh) = w;
            }
    }
}

DI float wave_max(float v) {
#pragma unroll
    for (int o = 1; o < 64; o <<= 1) v = fmaxf(v, __shfl_xor(v, o));
    return v;
}
DI void attention_phase(const bf16_t* Q, const bf16_t* KS, const bf16_t* VTS, const bf16_t* KP, const bf16_t* VTP, const LAS float* rel_bias, const float* qna, const float* kna, const float* qnb, const float* knb,
                        bf16_t* AO, int gw, int NGW, int lane) {
    const float L2E = 1.4426950408889634f;
    const float shiftA = 8.0f * wave_max(fabsf(qna[lane])) * wave_max(fabsf(kna[lane])) * L2E;
    const float boundB = 8.0f * wave_max(fabsf(qnb[lane])) * wave_max(fabsf(knb[lane]));
    float bm = 0.f;
    for (int i = lane; i < 3720; i += 64) bm = fmaxf(bm, fabsf(rel_bias[i]));
    const float shiftB = boundB * L2E, shiftN = (boundB + wave_max(bm)) * L2E;
    for (int U = gw; U < 7168; U += NGW) {
        if (U < 2048) {
            const int u = U, b = u >> 8, kv = (u >> 7) & 1, gp = (u >> 6) & 1, qt = u & 63;
            const int m0 = NPR + b * 2048 + qt * 32, qc = (kv * 4 + gp * 2) * 64;
            attn_unit<2, false>(Q + (size_t)m0 * 1024 + qc, KS + (size_t)(b * 10 + kv) * 72 * 2048, VTS + (size_t)(b * 10 + kv) * 72 * 2048, 2304, 0, 72, 0, 0, nullptr, 0, 0, shiftA, AO + (size_t)m0 * 1024 + qc, lane);
        } else if (U < 4096) {
            const int u = U - 2048, b = u >> 8, h = (u >> 5) & 7, qr = u & 31;
            const int m0 = NPR + b * 2048 + qr * 64, qc = 512 + h * 64;
            const int rs = min(max(qr - 4, 0), 24);
            attn_unit<2, true>(Q + (size_t)m0 * 1024 + qc, KS + (size_t)(b * 10 + 2 + h) * 72 * 2048, VTS + (size_t)(b * 10 + 2 + h) * 72 * 2048, 2304, rs * 64, 16, 2048, 8, rel_bias + h * 465, qr, 0, shiftN, AO + (size_t)m0 * 1024 + qc, lane);
        } else if (U < 5120) {
            const int u = U - 4096, b = u >> 5, kv = (u >> 4) & 1, gp = (u >> 3) & 1, qt = u & 7;
            const int m0 = b * 256 + qt * 32, qc = (kv * 4 + gp * 2) * 64;
            attn_unit<2, false>(Q + (size_t)m0 * 1024 + qc, KP + (size_t)(b * 10 + kv) * 8 * 2048, VTP + (size_t)(b * 10 + kv) * 8 * 2048, 256, 0, 8, 0, 0, nullptr, 0, 0, shiftA, AO + (size_t)m0 * 1024 + qc, lane);
        } else {
            const int u = U - 5120, b = u >> 6, h = (u >> 3) & 7, qt = u & 7;
            const int m0 = b * 256 + qt * 32, qc = 512 + h * 64;
            attn_unit<1, false>(Q + (size_t)m0 * 1024 + qc, KP + (size_t)(b * 10 + 2 + h) * 8 * 2048, VTP + (size_t)(b * 10 + 2 + h) * 8 * 2048, 256, 0, 8, 0, 0, nullptr, 0, 0, shiftB, AO + (size_t)m0 * 1024 + qc, lane);
        }
    }
}

DI float quad_sum(float x) {
    x += __builtin_bit_cast(float, __builtin_amdgcn_mov_dpp(__builtin_bit_cast(int, x), 0xB1, 0xF, 0xF, true));
    x += __builtin_bit_cast(float, __builtin_amdgcn_mov_dpp(__builtin_bit_cast(int, x), 0x4E, 0xF, 0xF, true));
    return x;
}
DI void delta_unit(LAS unsigned char* lds, const bf16_t* QKV, const float* AB, const float* conv_w, float Aexp, float dtb,
                   int m0, int T, int h, int dir, const float* s0  , float* sfin  , bf16_t* OUT) {
    const int tid = opq(threadIdx.x), wid = tid >> 6, lane = tid & 63, kq = lane & 3, vl = lane >> 2, v = 16 * wid + vl;
    LAS float* sQ = (LAS float*)lds; LAS float* sK = sQ + 32 * 128; LAS float* sV = sK + 32 * 128; LAS float* sA = sV + 32 * 128; LAS float* sB = sA + 32;
    float S[32];
#pragma unroll
    for (int i = 0; i < 32; ++i) S[i] = s0 ? s0[(size_t)(kq * 32 + i) * 128 + v] : 0.f;
    const int nblk = T / 32;
    for (int blk = 0; blk < nblk; ++blk) {
        const int t0 = (dir ? nblk - 1 - blk : blk) * 32;
        {
            const int tl = tid >> 4, cg = tid & 15, t = t0 + tl;
#pragma unroll
            for (int part = 0; part < 3; ++part) {
                const int col = part * 1024 + h * 128 + cg * 8;
                const bf16_t* base = QKV + (size_t)(m0 + t) * 3072 + col;
                u32x4 xm = {0u, 0u, 0u, 0u}, xp = {0u, 0u, 0u, 0u};
                const u32x4 x0 = *(const u32x4*)base;
                if (t > 0) xm = *(const u32x4*)(base - 3072);
                if (t < T - 1) xp = *(const u32x4*)(base + 3072);
                float o[8];
#pragma unroll
                for (int e = 0; e < 4; ++e) {
                    const f32x2 w0 = *(const f32x2*)(conv_w + col + 2 * e), w1 = *(const f32x2*)(conv_w + 3072 + col + 2 * e), w2 = *(const f32x2*)(conv_w + 6144 + col + 2 * e);
                    const float a0 = w0.x * bflo(xm[e]) + w1.x * bflo(x0[e]) + w2.x * bflo(xp[e]);
                    const float a1 = w0.y * bfhi(xm[e]) + w1.y * bfhi(x0[e]) + w2.y * bfhi(xp[e]);
                    o[2 * e] = siluf_(a0); o[2 * e + 1] = siluf_(a1);
                }
                LAS float* dst = (part == 0 ? sQ : (part == 1 ? sK : sV)) + tl * 128 + cg * 8;
                *(LAS f32x4*)dst = (f32x4){o[0], o[1], o[2], o[3]}; *(LAS f32x4*)(dst + 4) = (f32x4){o[4], o[5], o[6], o[7]};
            }
        }
        __syncthreads();
        {
            const int row = tid >> 3, sub = tid & 7;
            LAS float* p = (row < 32 ? sQ + row * 128 : sK + (row - 32) * 128) + sub * 16;
            f32x4 x[4]; float ss = 0.f;
#pragma unroll
            for (int i = 0; i < 4; ++i) { x[i] = *(LAS f32x4*)(p + 4 * i); ss += (x[i].x * x[i].x + x[i].y * x[i].y) + (x[i].z * x[i].z + x[i].w * x[i].w); }
            ss += __shfl_xor(ss, 1); ss += __shfl_xor(ss, 2); ss += __shfl_xor(ss, 4);
            const float sc = __builtin_amdgcn_rsqf(ss + 1e-6f) * (row < 32 ? 0.08838834764831845f : 1.0f);
#pragma unroll
            for (int i = 0; i < 4; ++i) *(LAS f32x4*)(p + 4 * i) = x[i] * sc;
            if (tid < 32) {
                const float* ab = AB + (size_t)(m0 + t0 + tid) * 32 + dir * 8 + h;
                const float xa = ab[0] + dtb, xb = ab[16];
                const float sp = xa > 20.f ? xa : log1pf(__expf(xa));
                sA[tid] = __expf(-Aexp * sp); sB[tid] = sigmoidf_(xb);
            }
        }
        __syncthreads();
        for (int i = 0; i < 32; ++i) {
            const int tl = dir ? 31 - i : i;
            const LAS float* kp = sK + tl * 128 + kq * 32; const LAS float* qp = sQ + tl * 128 + kq * 32;
            const float a = sA[tl], b = sB[tl], vt = sV[tl * 128 + v];
            f32x4 kk[8];
#pragma unroll
            for (int j = 0; j < 8; ++j) kk[j] = *(const LAS f32x4*)(kp + 4 * j);
            float ks = 0.f;
#pragma unroll
            for (int j = 0; j < 8; ++j) ks += (kk[j].x * S[4 * j] + kk[j].y * S[4 * j + 1]) + (kk[j].z * S[4 * j + 2] + kk[j].w * S[4 * j + 3]);
            ks = quad_sum(ks);
            const float d = b * (vt - a * ks);
            f32x4 qq[8];
#pragma unroll
            for (int j = 0; j < 8; ++j) qq[j] = *(const LAS f32x4*)(qp + 4 * j);
            float os = 0.f;
#pragma unroll
            for (int j = 0; j < 8; ++j) {
                S[4 * j] = a * S[4 * j] + kk[j].x * d; S[4 * j + 1] = a * S[4 * j + 1] + kk[j].y * d; S[4 * j + 2] = a * S[4 * j + 2] + kk[j].z * d; S[4 * j + 3] = a * S[4 * j + 3] + kk[j].w * d;
                os += (qq[j].x * S[4 * j] + qq[j].y * S[4 * j + 1]) + (qq[j].z * S[4 * j + 2] + qq[j].w * S[4 * j + 3]);
            }
            os = quad_sum(os);
            if (kq == 0) OUT[(size_t)(m0 + t0 + tl) * 1024 + h * 128 + v] = (bf16_t)(pk2(os, 0.f) & 0xffffu);
        }
        __syncthreads();
    }
    if (sfin) {
#pragma unroll
        for (int i = 0; i < 32; ++i) sfin[(size_t)(kq * 32 + i) * 128 + v] = S[i];
    }
}


constexpr int DP128 = 136, DP64 = 72;
constexpr int DL_QN = 0, DL_KN = 17408, DL_KNT = 34816, DL_VT = 53248, DL_ST = 71680, DL_ATT = 106496, DL_TM = 115712, DL_RT = 124928, DL_GATE = 143360;
constexpr int DL_AL1 = DL_KNT, DL_AL2 = DL_KNT + 9216, DL_TDT = DL_VT, DL_P1T = DL_VT + 9216, DL_T1 = DL_ST, DL_T1T = DL_ST + 9216, DL_AD = DL_ST + 18432;
constexpr int DL_VNT = DL_QN, DL_VNST = DL_VT, DL_CW = DL_GATE + 2048;
static_assert(DL_CW + 4608 <= LDS_BYTES, "delta LDS map");

DI int crow_(int i, int hh) { return (i & 3) + 8 * (i >> 2) + 4 * hh; }
DI bf16x8 ldfrag(const LAS bf16_t* base, int row, int pitch, int koff) { return *(const LAS bf16x8*)(base + row * pitch + koff); }
DI void store_tileT(LAS bf16_t* XT, int pitch, int col, int row0, int hh, const f32x16& a, float sc) {
#pragma unroll
    for (int g = 0; g < 4; ++g) { u32x2 w; w.x = pk2(a[4 * g] * sc, a[4 * g + 1] * sc); w.y = pk2(a[4 * g + 2] * sc, a[4 * g + 3] * sc);
        *(LAS u32x2*)(XT + col * pitch + row0 + 8 * g + 4 * hh) = w; }
}
DI void store_tileR(LAS bf16_t* X, int pitch, int col, int row0, int hh, const f32x16& a) {
#pragma unroll
    for (int i = 0; i < 16; ++i) X[(row0 + crow_(i, hh)) * pitch + col] = (bf16_t)(pk2(a[i], 0.f) & 0xffffu);
}
DI f32x16 mm64_tile(const LAS bf16_t* A, const LAS bf16_t* BT, int ib, int jb, int r, int hh, f32x16 acc) {
#pragma unroll
    for (int s = 0; s < 4; ++s) acc = MFMA32(ldfrag(A, 32 * ib + r, DP64, 16 * s + 8 * hh), ldfrag(BT, 32 * jb + r, DP64, 16 * s + 8 * hh), acc);
    return acc;
}

#ifdef PROBE_D1
#define REP_D1 _Pragma("unroll 1") for (int rep_ = 0; rep_ < 2; ++rep_)
#else
#define REP_D1
#endif
#ifdef PROBE_D3
#define REP_D3 _Pragma("unroll 1") for (int rep_ = 0; rep_ < 2; ++rep_)
#else
#define REP_D3
#endif
#ifdef PROBE_D6
#define REP_D6 _Pragma("unroll 1") for (int rep_ = 0; rep_ < 2; ++rep_)
#else
#define REP_D6
#endif
DI void delta_unit_chunked(LAS unsigned char* lds, const bf16_t* QKV, const float* AB, const float* conv_w, float Aexp, float dtb,
                           int m0, int T, int h, int dir, const float* s0, float* sfin, bf16_t* OUT) {
    const int tid0 = opq(threadIdx.x), w0 = __builtin_amdgcn_readfirstlane(tid0 >> 6);
    LAS bf16_t* QN = (LAS bf16_t*)(lds + DL_QN); LAS bf16_t* KN = (LAS bf16_t*)(lds + DL_KN); LAS bf16_t* KNT = (LAS bf16_t*)(lds + DL_KNT); LAS bf16_t* VT = (LAS bf16_t*)(lds + DL_VT);
    LAS bf16_t* ST = (LAS bf16_t*)(lds + DL_ST); LAS bf16_t* ATT = (LAS bf16_t*)(lds + DL_ATT); LAS bf16_t* TM = (LAS bf16_t*)(lds + DL_TM); LAS bf16_t* RT = (LAS bf16_t*)(lds + DL_RT);
    LAS float* GT = (LAS float*)(lds + DL_GATE);
    LAS bf16_t* AL1 = (LAS bf16_t*)(lds + DL_AL1); LAS bf16_t* AL2 = (LAS bf16_t*)(lds + DL_AL2); LAS bf16_t* TDT = (LAS bf16_t*)(lds + DL_TDT); LAS bf16_t* P1T = (LAS bf16_t*)(lds + DL_P1T);
    LAS bf16_t* T1 = (LAS bf16_t*)(lds + DL_T1); LAS bf16_t* T1T = (LAS bf16_t*)(lds + DL_T1T); LAS float* AD = (LAS float*)(lds + DL_AD);
    LAS bf16_t* VNT = (LAS bf16_t*)(lds + DL_VNT); LAS bf16_t* VNST = (LAS bf16_t*)(lds + DL_VNST);
    f32x16 Sacc[2];
    {
        const int lane = tid0 & 63, r = lane & 31, hh = lane >> 5, kb = w0 >> 1, vb0 = 2 * (w0 & 1);
#pragma unroll
        for (int e = 0; e < 2; ++e)
#pragma unroll
            for (int i = 0; i < 16; ++i) Sacc[e][i] = s0 ? s0[(size_t)(32 * kb + crow_(i, hh)) * 128 + 32 * (vb0 + e) + r] : 0.f;
    }
    LAS float* CW = (LAS float*)(lds + DL_CW);
    for (int i = tid0; i < 3 * 384; i += 512) { const int tap = i / 384, pc = i % 384; CW[i] = conv_w[tap * 3072 + (pc >> 7) * 1024 + h * 128 + (pc & 127)]; }
    __syncthreads();
    const int nch = T / 64;
    u32x4 xraw[3][4];
#define DELTA_LOAD_RAW(T0) do { const int tlo_ = (T0) + 2 * (tid0 >> 4), cg_ = tid0 & 15; \
        _Pragma("unroll") for (int part = 0; part < 3; ++part) _Pragma("unroll") for (int k = 0; k < 4; ++k) { \
            const int tt = tlo_ - 1 + k; const bool ok = (tt >= 0) && (tt < T); const int tc = min(max(tt, 0), T - 1); \
            u32x4 v_ = *(const u32x4*)(QKV + (size_t)(m0 + tc) * 3072 + part * 1024 + h * 128 + cg_ * 8); \
            if (!ok) v_ = (u32x4){0u, 0u, 0u, 0u}; xraw[part][k] = v_; } } while (0)
#ifdef DELTA_PREFETCH
    DELTA_LOAD_RAW((dir ? nch - 1 : 0) * 64);
#endif
#pragma unroll 1
    for (int ci = 0; ci < nch; ++ci) {
        const int tid = opq(threadIdx.x), w = __builtin_amdgcn_readfirstlane(tid >> 6), lane = tid & 63, r = lane & 31, hh = lane >> 5;
        const int kb = w >> 1, vb0 = 2 * (w & 1);
        const int t0 = (dir ? nch - 1 - ci : ci) * 64;
        u32x4 kpk[2], vpk[2];
        const int tlo = t0 + 2 * (tid >> 4);
#ifndef DELTA_PREFETCH
        DELTA_LOAD_RAW(t0);
#endif
        REP_D1 {
        {
            const int cg = tid & 15;
#pragma unroll
            for (int pass = 0; pass < 2; ++pass) {
                const int t = tlo + pass, i = dir ? t0 + 63 - t : t - t0;
                u32x4 pk[3];
#pragma unroll
                for (int part = 0; part < 3; ++part) {
                    const u32x4 xm = xraw[part][pass], x0 = xraw[part][pass + 1], xp = xraw[part][pass + 2];
                    float o[8]; float ss = 0.f;
#pragma unroll
                    for (int e = 0; e < 4; ++e) {
                        const f32x2 w0 = *(const LAS f32x2*)(CW + part * 128 + cg * 8 + 2 * e), w1 = *(const LAS f32x2*)(CW + 384 + part * 128 + cg * 8 + 2 * e), w2 = *(const LAS f32x2*)(CW + 768 + part * 128 + cg * 8 + 2 * e);
                        const float a0 = w0.x * bflo(xm[e]) + w1.x * bflo(x0[e]) + w2.x * bflo(xp[e]);
                        const float a1 = w0.y * bfhi(xm[e]) + w1.y * bfhi(x0[e]) + w2.y * bfhi(xp[e]);
                        o[2 * e] = siluf_(a0); o[2 * e + 1] = siluf_(a1);
                        ss += o[2 * e] * o[2 * e] + o[2 * e + 1] * o[2 * e + 1];
                    }
                    float sc = 1.0f;
                    if (part < 2) {
                        ss += __shfl_xor(ss, 1); ss += __shfl_xor(ss, 2); ss += __shfl_xor(ss, 4); ss += __shfl_xor(ss, 8);
                        sc = __builtin_amdgcn_rsqf(ss + 1e-6f) * (part == 0 ? 0.08838834764831845f : 1.0f);
                    }
                    pk[part].x = pk2(o[0] * sc, o[1] * sc); pk[part].y = pk2(o[2] * sc, o[3] * sc); pk[part].z = pk2(o[4] * sc, o[5] * sc); pk[part].w = pk2(o[6] * sc, o[7] * sc);
                }
                *(LAS u32x4*)(QN + i * DP128 + cg * 8) = pk[0];
                *(LAS u32x4*)(KN + i * DP128 + cg * 8) = pk[1];
                kpk[pass] = pk[1]; vpk[pass] = pk[2];
            }
        }
#ifdef DELTA_PREFETCH
        if (ci + 1 < nch) DELTA_LOAD_RAW((dir ? nch - 2 - ci : ci + 1) * 64);
#endif
        if (w == 0) {
            const int t = dir ? t0 + 63 - lane : t0 + lane;
            const float* ab = AB + (size_t)(m0 + t) * 32 + dir * 8 + h;
            const float xa = ab[0] + dtb, xb = ab[16];
            const float sp = xa > 20.f ? xa : log1pf(__expf(xa));
            float g = -Aexp * sp;
#pragma unroll
            for (int off = 1; off < 64; off <<= 1) { const float tmp = __shfl_up(g, off); if (lane >= off) g += tmp; }
            const float gl = __shfl(g, 63);
            GT[lane] = g; GT[64 + lane] = sigmoidf_(xb); GT[128 + lane] = __expf(g); GT[192 + lane] = __expf(gl - g);
            if (lane == 0) GT[256] = __expf(gl);
        }
        for (int i = tid; i < 64 * DP64 / 2; i += 512) { ((LAS unsigned*)TM)[i] = 0u; ((LAS unsigned*)TDT)[i] = 0u; }
        __syncthreads();
        }
        REP_D3 {
        {
            const int mat = w >> 2, ib = (w >> 1) & 1, jb = w & 1;
            f32x16 acc;
#pragma unroll
            for (int i = 0; i < 16; ++i) acc[i] = 0.f;
            if (ib >= jb) {
                const LAS bf16_t* X = mat ? QN : KN;
#pragma unroll
                for (int s = 0; s < 8; ++s) acc = MFMA32(ldfrag(X, 32 * ib + r, DP128, 16 * s + 8 * hh), ldfrag(KN, 32 * jb + r, DP128, 16 * s + 8 * hh), acc);
            }
            const int col = 32 * jb + r; const float gc = GT[col];
#pragma unroll
            for (int i = 0; i < 16; ++i) {
                const int row = 32 * ib + crow_(i, hh);
                const float dg = (row >= col) ? __expf(GT[row] - gc) : 0.f;
                if (mat == 0) {
                    const float a = (row > col) ? GT[64 + row] * acc[i] * dg : 0.f;
                    const bool same16 = (row >> 4) == (col >> 4), same32 = (row >> 5) == (col >> 5);
                    if (same16) AD[((row >> 4) * 16 + (row & 15)) * 20 + (col & 15)] = a;
                    AL1[row * DP64 + col] = (bf16_t)(pk2((same32 && !same16) ? a : 0.f, 0.f) & 0xffffu);
                    AL2[row * DP64 + col] = (bf16_t)(pk2(!same32 ? a : 0.f, 0.f) & 0xffffu);
                } else {
                    ATT[row * DP64 + col] = (bf16_t)(pk2((row >= col) ? acc[i] * dg : 0.f, 0.f) & 0xffffu);
                }
            }
        }
        __syncthreads();
        if (w == 0) {
            const int b = lane >> 4, c = lane & 15;
            const LAS float* ad = AD + b * 16 * 20;
            float X[16];
#pragma unroll
            for (int i = 0; i < 16; ++i) {
                float x = (i == c) ? 1.f : 0.f;
#pragma unroll
                for (int j4 = 0; j4 < (i + 3) / 4; ++j4) {
                    const f32x4 a = *(const LAS f32x4*)(ad + i * 20 + 4 * j4);
                    if (4 * j4 + 0 < i) x -= a.x * X[4 * j4 + 0];
                    if (4 * j4 + 1 < i) x -= a.y * X[4 * j4 + 1];
                    if (4 * j4 + 2 < i) x -= a.z * X[4 * j4 + 2];
                    if (4 * j4 + 3 < i) x -= a.w * X[4 * j4 + 3];
                }
                X[i] = x;
            }
#pragma unroll
            for (int i = 0; i < 16; ++i) TM[(16 * b + i) * DP64 + 16 * b + c] = (bf16_t)(pk2(X[i], 0.f) & 0xffffu);
#pragma unroll
            for (int g = 0; g < 4; ++g) { u32x2 wv; wv.x = pk2(X[4 * g], X[4 * g + 1]); wv.y = pk2(X[4 * g + 2], X[4 * g + 3]);
                *(LAS u32x2*)(TDT + (16 * b + c) * DP64 + 16 * b + 4 * g) = wv; }
        }
        __syncthreads();
        }
        const int ib5 = (w >> 1) & 1, jb5 = w & 1;
        f32x16 zero16;
#pragma unroll
        for (int i = 0; i < 16; ++i) zero16[i] = 0.f;
        if (w < 4) { const f32x16 p1 = mm64_tile(AL1, TDT, ib5, jb5, r, hh, zero16); store_tileT(P1T, DP64, 32 * jb5 + r, 32 * ib5, hh, p1, -1.0f); }
        __syncthreads();
        if (w < 4) {
            f32x16 c0;
#pragma unroll
            for (int i = 0; i < 16; ++i) c0[i] = bf2f(TM[(32 * ib5 + crow_(i, hh)) * DP64 + 32 * jb5 + r]);
            const f32x16 t1 = mm64_tile(TM, P1T, ib5, jb5, r, hh, c0);
            store_tileR(T1, DP64, 32 * jb5 + r, 32 * ib5, hh, t1); store_tileT(T1T, DP64, 32 * jb5 + r, 32 * ib5, hh, t1, 1.0f);
        }
        __syncthreads();
        if (w < 4) { const f32x16 p3 = mm64_tile(AL2, T1T, ib5, jb5, r, hh, zero16); store_tileT(P1T, DP64, 32 * jb5 + r, 32 * ib5, hh, p3, -1.0f); }
        __syncthreads();
        if (w < 4) {
            f32x16 c0;
#pragma unroll
            for (int i = 0; i < 16; ++i) c0[i] = bf2f(T1[(32 * ib5 + crow_(i, hh)) * DP64 + 32 * jb5 + r]);
            const f32x16 tt = mm64_tile(T1, P1T, ib5, jb5, r, hh, c0);
            store_tileR(TM, DP64, 32 * jb5 + r, 32 * ib5, hh, tt);
        }
        __syncthreads();
        const int cb = w >> 2, vb = w & 3;
        f32x16 O0;
        REP_D6 {
        {
            const int cg = tid & 15;
#pragma unroll
            for (int pass = 0; pass < 2; ++pass) {
                const int t = tlo + pass, i = dir ? t0 + 63 - t : t - t0;
#pragma unroll
                for (int e = 0; e < 4; ++e) {
                    const int ci_ = (((i >> 3) ^ (cg & 7)) << 3) + (i & 7);
                    KNT[(cg * 8 + 2 * e) * DP64 + ci_] = (bf16_t)(kpk[pass][e] & 0xffffu); KNT[(cg * 8 + 2 * e + 1) * DP64 + ci_] = (bf16_t)(kpk[pass][e] >> 16);
                    VT[(cg * 8 + 2 * e) * DP64 + ci_] = (bf16_t)(vpk[pass][e] & 0xffffu); VT[(cg * 8 + 2 * e + 1) * DP64 + ci_] = (bf16_t)(vpk[pass][e] >> 16);
                }
            }
#pragma unroll
            for (int e = 0; e < 2; ++e) store_tileT(ST, DP128, 32 * (vb0 + e) + r, 32 * kb, hh, Sacc[e], 1.0f);
        }
        __syncthreads();
        {
            f32x16 ks = zero16, qs = zero16;
#pragma unroll
            for (int s = 0; s < 8; ++s) {
                const bf16x8 sf = ldfrag(ST, 32 * vb + r, DP128, 16 * s + 8 * hh);
                ks = MFMA32(ldfrag(KN, 32 * cb + r, DP128, 16 * s + 8 * hh), sf, ks);
                qs = MFMA32(ldfrag(QN, 32 * cb + r, DP128, 16 * s + 8 * hh), sf, qs);
            }
            f32x16 rr;
#pragma unroll
            for (int g = 0; g < 4; ++g) {
                const u32x2 vv = *(const LAS u32x2*)(VT + (32 * vb + r) * DP64 + (((4 * cb + g) ^ ((r >> 3) & 3) ^ ((vb & 1) << 2)) << 3) + 4 * hh);
                const float v4[4] = {bflo(vv.x), bfhi(vv.x), bflo(vv.y), bfhi(vv.y)};
#pragma unroll
                for (int j = 0; j < 4; ++j) {
                    const int c = 32 * cb + 8 * g + 4 * hh + j; const float eg = GT[128 + c];
                    rr[4 * g + j] = GT[64 + c] * (v4[j] - eg * ks[4 * g + j]);
                    O0[4 * g + j] = eg * qs[4 * g + j];
                }
            }
            store_tileT(RT, DP64, 32 * vb + r, 32 * cb, hh, rr, 1.0f);
        }
        __syncthreads();
        }
        {
            const f32x16 vn = mm64_tile(TM, RT, cb, vb, r, hh, zero16);
            f32x16 vs;
#pragma unroll
            for (int i = 0; i < 16; ++i) vs[i] = vn[i] * GT[192 + 32 * cb + crow_(i, hh)];
            store_tileT(VNT, DP64, 32 * vb + r, 32 * cb, hh, vn, 1.0f);
            store_tileT(VNST, DP64, 32 * vb + r, 32 * cb, hh, vs, 1.0f);
        }
        __syncthreads();
        {
            const f32x16 o = mm64_tile(ATT, VNT, cb, vb, r, hh, O0);
#pragma unroll
            for (int i = 0; i < 16; ++i) {
                const int c = 32 * cb + crow_(i, hh), t = dir ? t0 + 63 - c : t0 + c;
                OUT[(size_t)(m0 + t) * 1024 + h * 128 + 32 * vb + r] = (bf16_t)(pk2(o[i], 0.f) & 0xffffu);
            }
            const float egl = GT[256];
#pragma unroll
            for (int e = 0; e < 2; ++e) {
                f32x16 a = Sacc[e] * egl;
#pragma unroll
                for (int s2 = 0; s2 < 4; ++s2) {
                    const int row = 32 * kb + r, blk = (2 * s2 + hh) ^ ((row >> 3) & 7);
                    a = MFMA32(ldfrag(KNT, row, DP64, 8 * blk), ldfrag(VNST, 32 * (vb0 + e) + r, DP64, 16 * s2 + 8 * hh), a);
                }
                Sacc[e] = a;
            }
        }
        __syncthreads();
    }
    if (sfin) {
        const int lane = tid0 & 63, r = lane & 31, hh = lane >> 5, kb = w0 >> 1, vb0 = 2 * (w0 & 1);
#pragma unroll
        for (int e = 0; e < 2; ++e)
#pragma unroll
            for (int i = 0; i < 16; ++i) sfin[(size_t)(32 * kb + crow_(i, hh)) * 128 + 32 * (vb0 + e) + r] = Sacc[e][i];
    }
}

DI void delta_gates_load(const float* AB, int m0, int t0, int h, int dir, int lane, float& xa, float& xb) {
    const int t = dir ? t0 + 63 - lane : t0 + lane;
    const float* ab = AB + (size_t)(m0 + t) * 32 + dir * 8 + h;
    xa = ab[0]; xb = ab[16];
}
DI void delta_gates_compute(LAS float* GT, float xa_raw, float xb, float Aexp, float dtb, int lane) {
    const float xa = xa_raw + dtb;
    const float sp = xa > 20.f ? xa : log1pf(__expf(xa));
    float g = -Aexp * sp;
#pragma unroll
    for (int off = 1; off < 64; off <<= 1) { const float tmp = __shfl_up(g, off); if (lane >= off) g += tmp; }
    const float gl = __shfl(g, 63);
    GT[lane] = g; GT[64 + lane] = sigmoidf_(xb); GT[128 + lane] = __expf(g); GT[192 + lane] = __expf(gl - g);
    if (lane == 0) GT[256] = __expf(gl);
}

DI void delta_prep_unit(LAS unsigned char* lds, bf16_t* QKV, const bf16_t* HALO, const float* AB, const float* conv_w, const float* a_log, const float* dt_bias,
                        int m0, int T, int t0, int h, bf16_t* OF, bf16_t* OB) {
    const int tid = opq(threadIdx.x);
    LAS bf16_t* QN = (LAS bf16_t*)(lds + DL_QN); LAS bf16_t* KN = (LAS bf16_t*)(lds + DL_KN);
    LAS bf16_t* ATT = (LAS bf16_t*)(lds + DL_ATT); LAS bf16_t* TM = (LAS bf16_t*)(lds + DL_TM);
    LAS bf16_t* AL1 = (LAS bf16_t*)(lds + DL_AL1); LAS bf16_t* AL2 = (LAS bf16_t*)(lds + DL_AL2); LAS bf16_t* TDT = (LAS bf16_t*)(lds + DL_TDT); LAS bf16_t* P1T = (LAS bf16_t*)(lds + DL_P1T);
    LAS bf16_t* T1 = (LAS bf16_t*)(lds + DL_T1); LAS bf16_t* T1T = (LAS bf16_t*)(lds + DL_T1T); LAS float* AD = (LAS float*)(lds + DL_AD);
    LAS float* CW = (LAS float*)(lds + DL_CW);
    for (int i = tid; i < 3 * 384; i += 512) { const int tap = i / 384, pc = i % 384; CW[i] = conv_w[tap * 3072 + (pc >> 7) * 1024 + h * 128 + (pc & 127)]; }
    const int wt = __builtin_amdgcn_readfirstlane(tid >> 6);
    float gxa = 0.f, gxb = 0.f;
    if (wt < 2) delta_gates_load(AB, m0, t0, h, wt, tid & 63, gxa, gxb);
    const int cg = tid & 15, tlo = t0 + 2 * (tid >> 4), chg = (m0 + t0) >> 6;
    u32x4 xraw[3][4];
#pragma unroll
    for (int part = 0; part < 3; ++part)
#pragma unroll
        for (int k = 0; k < 4; ++k) {
            const int tt = tlo - 1 + k; const int col = part * 1024 + h * 128 + cg * 8;
            u32x4 v = {0u, 0u, 0u, 0u};
            if (tt < t0) { if (t0 > 0) v = *(const u32x4*)(HALO + ((size_t)(chg - 1) * 2 + 1) * 3072 + col); }
            else if (tt >= t0 + 64) { if (t0 + 64 < T) v = *(const u32x4*)(HALO + ((size_t)(chg + 1) * 2 + 0) * 3072 + col); }
            else v = *(const u32x4*)(QKV + (size_t)(m0 + tt) * 3072 + col);
            xraw[part][k] = v;
        }
    if (wt < 2) delta_gates_compute(wt ? (LAS float*)(lds + DL_RT) : (LAS float*)(lds + DL_GATE), gxa, gxb, __expf(a_log[wt * 8 + h]), dt_bias[wt * 8 + h], tid & 63);
    asm volatile("s_waitcnt vmcnt(0)" ::: "memory");
    __syncthreads();
    u32x4 pq[2], pkk[2];
#pragma unroll
    for (int pass = 0; pass < 2; ++pass) {
        const int t = tlo + pass;
        u32x4 pk[3];
#pragma unroll
        for (int part = 0; part < 3; ++part) {
            const u32x4 xm = xraw[part][pass], x0 = xraw[part][pass + 1], xp = xraw[part][pass + 2];
            float o[8]; float ss = 0.f;
#pragma unroll
            for (int e = 0; e < 4; ++e) {
                const f32x2 w0 = *(const LAS f32x2*)(CW + part * 128 + cg * 8 + 2 * e), w1 = *(const LAS f32x2*)(CW + 384 + part * 128 + cg * 8 + 2 * e), w2 = *(const LAS f32x2*)(CW + 768 + part * 128 + cg * 8 + 2 * e);
                const float a0 = w0.x * bflo(xm[e]) + w1.x * bflo(x0[e]) + w2.x * bflo(xp[e]);
                const float a1 = w0.y * bfhi(xm[e]) + w1.y * bfhi(x0[e]) + w2.y * bfhi(xp[e]);
                o[2 * e] = siluf_(a0); o[2 * e + 1] = siluf_(a1);
                ss += o[2 * e] * o[2 * e] + o[2 * e + 1] * o[2 * e + 1];
            }
            float sc = 1.0f;
            if (part < 2) {
                ss += __shfl_xor(ss, 1); ss += __shfl_xor(ss, 2); ss += __shfl_xor(ss, 4); ss += __shfl_xor(ss, 8);
                sc = __builtin_amdgcn_rsqf(ss + 1e-6f) * (part == 0 ? 0.08838834764831845f : 1.0f);
            }
            pk[part].x = pk2(o[0] * sc, o[1] * sc); pk[part].y = pk2(o[2] * sc, o[3] * sc); pk[part].z = pk2(o[4] * sc, o[5] * sc); pk[part].w = pk2(o[6] * sc, o[7] * sc);
            *(u32x4*)(QKV + (size_t)(m0 + t) * 3072 + part * 1024 + h * 128 + cg * 8) = pk[part];
        }
        pq[pass] = pk[0]; pkk[pass] = pk[1];
    }
#pragma unroll 1
    for (int dir = 0; dir < 2; ++dir) {
        const int tid2 = opq(threadIdx.x), w = __builtin_amdgcn_readfirstlane(tid2 >> 6), lane = tid2 & 63, r = lane & 31, hh = lane >> 5;
        LAS float* GT = dir ? (LAS float*)(lds + DL_RT) : (LAS float*)(lds + DL_GATE);
#pragma unroll
        for (int pass = 0; pass < 2; ++pass) {
            const int loc = tlo + pass - t0, i = dir ? 63 - loc : loc;
            *(LAS u32x4*)(QN + i * DP128 + cg * 8) = pq[pass];
            *(LAS u32x4*)(KN + i * DP128 + cg * 8) = pkk[pass];
        }
        for (int i = tid2; i < 64 * DP64 / 2; i += 512) { ((LAS unsigned*)TM)[i] = 0u; ((LAS unsigned*)TDT)[i] = 0u; }
        __syncthreads();
        {
            const int mat = w >> 2, ib = (w >> 1) & 1, jb = w & 1;
            f32x16 acc;
#pragma unroll
            for (int i = 0; i < 16; ++i) acc[i] = 0.f;
            if (ib >= jb) {
                const LAS bf16_t* X = mat ? QN : KN;
#pragma unroll
                for (int s = 0; s < 8; ++s) acc = MFMA32(ldfrag(X, 32 * ib + r, DP128, 16 * s + 8 * hh), ldfrag(KN, 32 * jb + r, DP128, 16 * s + 8 * hh), acc);
            }
            const int col = 32 * jb + r; const float gc = GT[col];
#pragma unroll
            for (int i = 0; i < 16; ++i) {
                const int row = 32 * ib + crow_(i, hh);
                const float dg = (row >= col) ? __expf(GT[row] - gc) : 0.f;
                if (mat == 0) {
                    const float a = (row > col) ? GT[64 + row] * acc[i] * dg : 0.f;
                    const bool same16 = (row >> 4) == (col >> 4), same32 = (row >> 5) == (col >> 5);
                    if (same16) AD[((row >> 4) * 16 + (row & 15)) * 20 + (col & 15)] = a;
                    AL1[row * DP64 + col] = (bf16_t)(pk2((same32 && !same16) ? a : 0.f, 0.f) & 0xffffu);
                    AL2[row * DP64 + col] = (bf16_t)(pk2(!same32 ? a : 0.f, 0.f) & 0xffffu);
                } else {
                    ATT[row * DP64 + col] = (bf16_t)(pk2((row >= col) ? acc[i] * dg : 0.f, 0.f) & 0xffffu);
                }
            }
        }
        __syncthreads();
        if (w == 0) {
            const int b = lane >> 4, c = lane & 15;
            const LAS float* ad = AD + b * 16 * 20;
            float X[16];
#pragma unroll
            for (int i = 0; i < 16; ++i) {
                float x = (i == c) ? 1.f : 0.f;
#pragma unroll
                for (int j4 = 0; j4 < (i + 3) / 4; ++j4) {
                    const f32x4 a = *(const LAS f32x4*)(ad + i * 20 + 4 * j4);
                    if (4 * j4 + 0 < i) x -= a.x * X[4 * j4 + 0];
                    if (4 * j4 + 1 < i) x -= a.y * X[4 * j4 + 1];
                    if (4 * j4 + 2 < i) x -= a.z * X[4 * j4 + 2];
                    if (4 * j4 + 3 < i) x -= a.w * X[4 * j4 + 3];
                }
                X[i] = x;
            }
#pragma unroll
            for (int i = 0; i < 16; ++i) TM[(16 * b + i) * DP64 + 16 * b + c] = (bf16_t)(pk2(X[i], 0.f) & 0xffffu);
#pragma unroll
            for (int g = 0; g < 4; ++g) { u32x2 wv; wv.x = pk2(X[4 * g], X[4 * g + 1]); wv.y = pk2(X[4 * g + 2], X[4 * g + 3]);
                *(LAS u32x2*)(TDT + (16 * b + c) * DP64 + 16 * b + 4 * g) = wv; }
        }
        __syncthreads();
        const int ib5 = (w >> 1) & 1, jb5 = w & 1;
        f32x16 zero16;
#pragma unroll
        for (int i = 0; i < 16; ++i) zero16[i] = 0.f;
        if (w < 4) { const f32x16 p1 = mm64_tile(AL1, TDT, ib5, jb5, r, hh, zero16); store_tileT(P1T, DP64, 32 * jb5 + r, 32 * ib5, hh, p1, -1.0f); }
        __syncthreads();
        if (w < 4) {
            f32x16 c0;
#pragma unroll
            for (int i = 0; i < 16; ++i) c0[i] = bf2f(TM[(32 * ib5 + crow_(i, hh)) * DP64 + 32 * jb5 + r]);
            const f32x16 t1 = mm64_tile(TM, P1T, ib5, jb5, r, hh, c0);
            store_tileR(T1, DP64, 32 * jb5 + r, 32 * ib5, hh, t1); store_tileT(T1T, DP64, 32 * jb5 + r, 32 * ib5, hh, t1, 1.0f);
        }
        __syncthreads();
        if (w < 4) { const f32x16 p3 = mm64_tile(AL2, T1T, ib5, jb5, r, hh, zero16); store_tileT(P1T, DP64, 32 * jb5 + r, 32 * ib5, hh, p3, -1.0f); }
        __syncthreads();
        if (w < 4) {
            f32x16 c0;
#pragma unroll
            for (int i = 0; i < 16; ++i) c0[i] = bf2f(T1[(32 * ib5 + crow_(i, hh)) * DP64 + 32 * jb5 + r]);
            const f32x16 tt = mm64_tile(T1, P1T, ib5, jb5, r, hh, c0);
            store_tileR(TM, DP64, 32 * jb5 + r, 32 * ib5, hh, tt);
        }
        __syncthreads();
        {
            bf16_t* OUTd = dir ? OB : OF;
#pragma unroll
            for (int k2 = 0; k2 < 2; ++k2) {
                const int pc_ = tid2 + 512 * k2, row = pc_ >> 4, pc = pc_ & 15;
                const LAS bf16_t* src = (pc < 8 ? TM : ATT) + row * DP64 + (pc & 7) * 8;
                *(u32x4*)(OUTd + (size_t)(m0 + t0 + row) * 1024 + h * 128 + pc * 8) = *(const LAS u32x4*)src;
            }
        }
        __syncthreads();
    }
}

DI void delta_scan_unit(LAS unsigned char* lds, const bf16_t* QKV, const float* AB, float Aexp, float dtb,
                        int m0, int T, int h, int dir, const float* s0, float* sfin, bf16_t* OUT) {
    const int tid0 = opq(threadIdx.x), w0 = __builtin_amdgcn_readfirstlane(tid0 >> 6);
    LAS bf16_t* QN = (LAS bf16_t*)(lds + DL_QN); LAS bf16_t* KN = (LAS bf16_t*)(lds + DL_KN); LAS bf16_t* KNT = (LAS bf16_t*)(lds + DL_KNT); LAS bf16_t* VT = (LAS bf16_t*)(lds + DL_VT);
    LAS bf16_t* ST = (LAS bf16_t*)(lds + DL_ST); LAS bf16_t* ATT = (LAS bf16_t*)(lds + DL_ATT); LAS bf16_t* TM = (LAS bf16_t*)(lds + DL_TM); LAS bf16_t* RT = (LAS bf16_t*)(lds + DL_RT);
    LAS float* GT = (LAS float*)(lds + DL_GATE);
    LAS bf16_t* VNT = (LAS bf16_t*)(lds + DL_VNT); LAS bf16_t* VNST = (LAS bf16_t*)(lds + DL_VNST);
    f32x16 Sacc[2];
    {
        const int lane = tid0 & 63, r = lane & 31, hh = lane >> 5, kb = w0 >> 1, vb0 = 2 * (w0 & 1);
#pragma unroll
        for (int e = 0; e < 2; ++e)
#pragma unroll
            for (int i = 0; i < 16; ++i) Sacc[e][i] = s0 ? s0[(size_t)(32 * kb + crow_(i, hh)) * 128 + 32 * (vb0 + e) + r] : 0.f;
    }
    const int nch = T / 64;
    u32x4 pre[8];
#define DSCAN_LOAD(T0) do { const int tlo_ = (T0) + 2 * (tid0 >> 4), cg_ = tid0 & 15; \
        _Pragma("unroll") for (int pass = 0; pass < 2; ++pass) _Pragma("unroll") for (int part = 0; part < 3; ++part) \
            pre[pass * 3 + part] = *(const u32x4*)(QKV + (size_t)(m0 + tlo_ + pass) * 3072 + part * 1024 + h * 128 + cg_ * 8); \
        _Pragma("unroll") for (int k2 = 0; k2 < 2; ++k2) { const int pc_ = tid0 + 512 * k2; \
            pre[6 + k2] = *(const u32x4*)(OUT + (size_t)(m0 + (T0) + (pc_ >> 4)) * 1024 + h * 128 + (pc_ & 15) * 8); } } while (0)
    DSCAN_LOAD((dir ? nch - 1 : 0) * 64);
    float gxa = 0.f, gxb = 0.f;
    if (w0 == 0) delta_gates_load(AB, m0, (dir ? nch - 1 : 0) * 64, h, dir, tid0 & 63, gxa, gxb);
#pragma unroll 1
    for (int ci = 0; ci < nch; ++ci) {
        const int tid = opq(threadIdx.x), w = __builtin_amdgcn_readfirstlane(tid >> 6), lane = tid & 63, r = lane & 31, hh = lane >> 5;
        const int kb = w >> 1, vb0 = 2 * (w & 1);
        const int t0 = (dir ? nch - 1 - ci : ci) * 64;
        {
            const int cg = tid & 15, tlo = t0 + 2 * (tid >> 4);
#pragma unroll
            for (int pass = 0; pass < 2; ++pass) {
                const int loc = tlo + pass - t0, i = dir ? 63 - loc : loc;
                *(LAS u32x4*)(QN + i * DP128 + cg * 8) = pre[pass * 3 + 0];
                *(LAS u32x4*)(KN + i * DP128 + cg * 8) = pre[pass * 3 + 1];
                const int ci_ = (((i >> 3) ^ (cg & 7)) << 3) + (i & 7);
#pragma unroll
                for (int e = 0; e < 4; ++e) {
                    KNT[(cg * 8 + 2 * e) * DP64 + ci_] = (bf16_t)(pre[pass * 3 + 1][e] & 0xffffu); KNT[(cg * 8 + 2 * e + 1) * DP64 + ci_] = (bf16_t)(pre[pass * 3 + 1][e] >> 16);
                    VT[(cg * 8 + 2 * e) * DP64 + ci_] = (bf16_t)(pre[pass * 3 + 2][e] & 0xffffu); VT[(cg * 8 + 2 * e + 1) * DP64 + ci_] = (bf16_t)(pre[pass * 3 + 2][e] >> 16);
                }
            }
#pragma unroll
            for (int k2 = 0; k2 < 2; ++k2) {
                const int pc_ = tid + 512 * k2, row = pc_ >> 4, pc = pc_ & 15;
                *(LAS u32x4*)((pc < 8 ? TM : ATT) + row * DP64 + (pc & 7) * 8) = pre[6 + k2];
            }
#pragma unroll
            for (int e = 0; e < 2; ++e) store_tileT(ST, DP128, 32 * (vb0 + e) + r, 32 * kb, hh, Sacc[e], 1.0f);
        }
        if (w == 0) { delta_gates_compute(GT, gxa, gxb, Aexp, dtb, lane);
            if (ci + 1 < nch) delta_gates_load(AB, m0, (dir ? nch - 2 - ci : ci + 1) * 64, h, dir, lane, gxa, gxb); }
        if (ci + 1 < nch) DSCAN_LOAD((dir ? nch - 2 - ci : ci + 1) * 64);
        __syncthreads();
        f32x16 zero16;
#pragma unroll
        for (int i = 0; i < 16; ++i) zero16[i] = 0.f;
        const int cb = w >> 2, vb = w & 3;
        f32x16 O0;
        {
            f32x16 ks = zero16, qs = zero16;
#pragma unroll
            for (int s = 0; s < 8; ++s) {
                const bf16x8 sf = ldfrag(ST, 32 * vb + r, DP128, 16 * s + 8 * hh);
                ks = MFMA32(ldfrag(KN, 32 * cb + r, DP128, 16 * s + 8 * hh), sf, ks);
                qs = MFMA32(ldfrag(QN, 32 * cb + r, DP128, 16 * s + 8 * hh), sf, qs);
            }
            f32x16 rr;
#pragma unroll
            for (int g = 0; g < 4; ++g) {
                const u32x2 vv = *(const LAS u32x2*)(VT + (32 * vb + r) * DP64 + (((4 * cb + g) ^ ((r >> 3) & 3) ^ ((vb & 1) << 2)) << 3) + 4 * hh);
                const float v4[4] = {bflo(vv.x), bfhi(vv.x), bflo(vv.y), bfhi(vv.y)};
#pragma unroll
                for (int j = 0; j < 4; ++j) {
                    const int c = 32 * cb + 8 * g + 4 * hh + j; const float eg = GT[128 + c];
                    rr[4 * g + j] = GT[64 + c] * (v4[j] - eg * ks[4 * g + j]);
                    O0[4 * g + j] = eg * qs[4 * g + j];
                }
            }
            store_tileT(RT, DP64, 32 * vb + r, 32 * cb, hh, rr, 1.0f);
        }
        __syncthreads();
        {
            const f32x16 vn = mm64_tile(TM, RT, cb, vb, r, hh, zero16);
            f32x16 vs;
#pragma unroll
            for (int i = 0; i < 16; ++i) vs[i] = vn[i] * GT[192 + 32 * cb + crow_(i, hh)];
            store_tileT(VNT, DP64, 32 * vb + r, 32 * cb, hh, vn, 1.0f);
            store_tileT(VNST, DP64, 32 * vb + r, 32 * cb, hh, vs, 1.0f);
        }
        __syncthreads();
        {
            const f32x16 o = mm64_tile(ATT, VNT, cb, vb, r, hh, O0);
#pragma unroll
            for (int i = 0; i < 16; ++i) {
                const int c = 32 * cb + crow_(i, hh), t = dir ? t0 + 63 - c : t0 + c;
                OUT[(size_t)(m0 + t) * 1024 + h * 128 + 32 * vb + r] = (bf16_t)(pk2(o[i], 0.f) & 0xffffu);
            }
            const float egl = GT[256];
#pragma unroll
            for (int e = 0; e < 2; ++e) {
                f32x16 a = Sacc[e] * egl;
#pragma unroll
                for (int s2 = 0; s2 < 4; ++s2) {
                    const int row = 32 * kb + r, blk = (2 * s2 + hh) ^ ((row >> 3) & 7);
                    a = MFMA32(ldfrag(KNT, row, DP64, 8 * blk), ldfrag(VNST, 32 * (vb0 + e) + r, DP64, 16 * s2 + 8 * hh), a);
                }
                Sacc[e] = a;
            }
        }
        __syncthreads();
    }
    if (sfin) {
        const int lane = tid0 & 63, r = lane & 31, hh = lane >> 5, kb = w0 >> 1, vb0 = 2 * (w0 & 1);
#pragma unroll
        for (int e = 0; e < 2; ++e)
#pragma unroll
            for (int i = 0; i < 16; ++i) sfin[(size_t)(32 * kb + crow_(i, hh)) * 128 + 32 * (vb0 + e) + r] = Sacc[e][i];
    }
#undef DSCAN_LOAD
}
DI void delta_dispatch(LAS unsigned char* lds, int U, const bf16_t* QKV, const float* AB, const float* conv_w, const float* a_log, const float* dt_bias,
                       const float* state, float* news, bf16_t* OF, bf16_t* OB) {
    int b, h, dir, m0, T; const float* s0 = nullptr; float* sf = nullptr;
    if (U < 128) { b = U >> 4; h = (U >> 1) & 7; dir = U & 1; m0 = NPR + b * 2048; T = 2048; s0 = state + (size_t)((b * 2 + dir) * 8 + h) * 16384; }
    else { const int u = U - 128; b = u >> 4; h = (u >> 1) & 7; dir = u & 1; m0 = b * 256; T = 256; sf = news + (size_t)((b * 2 + dir) * 8 + h) * 16384; }
    const float Aexp = __expf(a_log[dir * 8 + h]), dtb = dt_bias[dir * 8 + h];
#ifdef DELTA_SEQ
    delta_unit(lds, QKV, AB, conv_w, Aexp, dtb, m0, T, h, dir, s0, sf, dir ? OB : OF);
#else
    delta_scan_unit(lds, QKV, AB, Aexp, dtb, m0, T, h, dir, s0, sf, dir ? OB : OF);
#endif
}

DI void y_phase(bf16_t* OF, const bf16_t* OB, const bf16_t* Z, int zp, const float* out_norm, int gw, int NGW, int lane) {
    for (int m = gw; m < NTOK; m += NGW) {
        const size_t off = (size_t)m * 1024 + 16 * lane;
        const u32x4 f0 = *(const u32x4*)(OF + off), f1 = *(const u32x4*)(OF + off + 8);
        const u32x4 b0 = *(const u32x4*)(OB + off), b1 = *(const u32x4*)(OB + off + 8);
        const size_t zoff = (size_t)m * zp + 16 * lane;
        const u32x4 z0 = *(const u32x4*)(Z + zoff), z1 = *(const u32x4*)(Z + zoff + 8);
        float o[16], z[16]; float ss = 0.f;
#pragma unroll
        for (int e = 0; e < 4; ++e) {
            o[2 * e] = bflo(f0[e]) + bflo(b0[e]); o[2 * e + 1] = bfhi(f0[e]) + bfhi(b0[e]);
            o[8 + 2 * e] = bflo(f1[e]) + bflo(b1[e]); o[8 + 2 * e + 1] = bfhi(f1[e]) + bfhi(b1[e]);
            z[2 * e] = bflo(z0[e]); z[2 * e + 1] = bfhi(z0[e]); z[8 + 2 * e] = bflo(z1[e]); z[8 + 2 * e + 1] = bfhi(z1[e]);
        }
#pragma unroll
        for (int e = 0; e < 16; ++e) ss += o[e] * o[e];
        ss += __shfl_xor(ss, 1); ss += __shfl_xor(ss, 2); ss += __shfl_xor(ss, 4);
        const float rstd = __builtin_amdgcn_rsqf(ss * (1.0f / 128.0f) + 1e-6f);
        const float* gn = out_norm + ((16 * lane) & 127);
        float y[16];
#pragma unroll
        for (int e = 0; e < 16; ++e) y[e] = o[e] * rstd * gn[e] * siluf_(z[e]);
        u32x4 w0, w1;
        w0.x = pk2(y[0], y[1]); w0.y = pk2(y[2], y[3]); w0.z = pk2(y[4], y[5]); w0.w = pk2(y[6], y[7]);
        w1.x = pk2(y[8], y[9]); w1.y = pk2(y[10], y[11]); w1.z = pk2(y[12], y[13]); w1.w = pk2(y[14], y[15]);
        *(u32x4*)(OF + off) = w0; *(u32x4*)(OF + off + 8) = w1;
    }
}

__global__ void __launch_bounds__(512, 2) fwd_megakernel(Params p) {
    extern __shared__ __attribute__((aligned(16))) unsigned char lds_raw[];
    LAS unsigned char* lds = (LAS unsigned char*)lds_raw;
    cg::grid_group grid = cg::this_grid();
    const int G = gridDim.x, bid = blockIdx.x, NGW = G * 8;
#define IDS() const int tid = opq(threadIdx.x), lane = tid & 63, wave = __builtin_amdgcn_readfirstlane(tid >> 6), gw = bid * 8 + wave; (void)gw; (void)lane; (void)tid
    unsigned char* ws = p.ws;
    float* mod = (float*)(ws + WS_MOD);
    float* Y = p.out + OUT_Y;
    bf16_t* XB = (bf16_t*)(p.out + OUT_Y) + 1024;
    bf16_t* WQKV1 = (bf16_t*)(ws + WS_WQKV1); bf16_t* WZ1 = (bf16_t*)(ws + WS_WZ1); bf16_t* WOUT1 = (bf16_t*)(ws + WS_WOUT1);
    bf16_t* WIN0 = (bf16_t*)(ws + B_WIN0); bf16_t* WOUT0 = (bf16_t*)(ws + B_WOUT0); bf16_t* W1_0 = (bf16_t*)(ws + B_W1_0); bf16_t* W2_0 = (bf16_t*)(ws + B_W2_0);
    bf16_t* H0 = (bf16_t*)(ws + B_H0); bf16_t* Qb = (bf16_t*)(ws + B_Q); bf16_t* KS = (bf16_t*)(ws + B_KS); bf16_t* VTS = (bf16_t*)(ws + B_VTS);
    bf16_t* KP = (bf16_t*)(ws + B_KP); bf16_t* VTP = (bf16_t*)(ws + B_VTP); bf16_t* FF0 = (bf16_t*)(ws + B_FF0);
    bf16_t* QKV1 = (bf16_t*)(ws + B_QKV1); float* AB = (float*)(ws + B_AB); bf16_t* OF = (bf16_t*)(ws + B_OF); bf16_t* OB = (bf16_t*)(ws + B_OB);
    bf16_t* H1 = (bf16_t*)(ws + B_H1); bf16_t* W1_1 = (bf16_t*)(ws + B_W1_1); bf16_t* W2_1 = (bf16_t*)(ws + B_W2_1); bf16_t* H1B = (bf16_t*)(ws + B_H1B);
    bf16_t* Zb = (bf16_t*)(ws + B_Z); bf16_t* FF1 = (bf16_t*)(ws + B_FF1);
    float* Pside = (float*)(ws + B_PS);
    bf16_t* HL = (bf16_t*)(p.out + OUT_Y);
    bf16_t* FFL0 = (bf16_t*)(ws + B_FFL0); bf16_t* FFL1 = (bf16_t*)(ws + B_FFL1);

    unsigned* barw = (unsigned*)(ws + 524288);
    volatile LAS unsigned* bar_st = (volatile LAS unsigned*)(lds + LDS_BYTES - 512);
    if (threadIdx.x < 2) bar_st[threadIdx.x] = 0u;
    if (p.ws == nullptr) grid.sync();
    __syncthreads();
    const XcdBarrier xbar = xcd_barrier_post(barw, bar_st);
#define GSYNC() xcd_barrier(xbar)
#define W2_GEMM(FFb, W2b, modl) do { \
        pg8::Gemm g{FFb, W2b, 4096, 4096, NTOK, 1024, 4096}; \
        EpiRes E{nullptr, nullptr, XB, modl + 5120, Pside, 0}; \
        if (G == 256) { pg8::W2Order S; S.c = bid; S.ntf = 64; pg8::gemm_phase(lds, g, S, E); } \
        else { pg8::StaticOrder S; S.init(NTOK, 1024, G, bid); pg8::gemm_phase(lds, g, S, E); } } while (0)
    {
        IDS();
        LAS float* scr = (LAS float*)(lds + wave * 8704);
        transpose_matrix(p.in[10], 1024, 2304, WIN0, scr, gw, NGW, lane);
        const bool later = (G == 256);
        if (!later) {
        transpose_matrix(p.in[16], 1024, 1024, WOUT0, scr, gw, NGW, lane);
        transpose_matrix(p.in[18], 1024, 4096, W1_0, scr, gw, NGW, lane);
        transpose_matrix(p.in[19], 4096, 1024, W2_0, scr, gw, NGW, lane);
        transpose_matrix(p.in[28], 1024, 1024, WOUT1, scr, gw, NGW, lane);
        }
        if (!later) {
            const float* W = p.in[23]; const int nblk = 129, nitems = 16 * nblk;
            for (int it = gw; it < nitems; it += NGW) { const int kb = it / nblk, nb = it % nblk, n0 = nb * 32;
                if (n0 < 3072) transpose_item(W, 4128, kb * 64, n0, WQKV1, 1024, perm_row32(n0), scr, lane);
                else if (n0 < 4096) transpose_item(W, 4128, kb * 64, n0, WZ1, 1024, perm_row32(n0 - 3072), scr, lane);
                else transpose_item(W, 4128, kb * 64, n0, WQKV1, 1024, 3072, scr, lane); }
            u32x4* zp = (u32x4*)(WQKV1 + (size_t)3104 * 1024); const int nz = 224 * 1024 * 2 / 16;
            for (int i = bid * 512 + tid; i < nz; i += G * 512) zp[i] = (u32x4){0u, 0u, 0u, 0u};
        }
        {
            const float* ck = p.in[3]; const float* cv = p.in[4];
            for (int e = bid * 512 + tid; e < 8 * 256 * 640; e += G * 512) {
                const int b = e / (256 * 640), rem = e % (256 * 640), pp = rem / 640, hd = rem % 640, head = hd >> 6, d = hd & 63, kk = pp & 31;
                const size_t tbase = ((size_t)(b * 10 + head) * 72 + 64 + (pp >> 5)) * 2048;
                KS[tbase + ((d >> 3) * 32 + kk) * 8 + (d & 7)] = (bf16_t)(pk2(ck[e], 0.f) & 0xffffu);
                VTS[tbase + ((((((d >> 5) * 2 + (kk >> 4)) * 2 + ((kk >> 3) & 1)) * 2 + ((kk >> 2) & 1)) * 32 + (d & 31)) << 2) + (kk & 3)] = (bf16_t)(pk2(cv[e], 0.f) & 0xffffu);
            }
        }
        __syncthreads();
        LAS float* sv = (LAS float*)lds;
        LAS float* red = sv + 1024 * 12;
        bool sv_ready = false;
        for (int U = bid; U < 192; U += G) {
            if (!sv_ready) {
                for (int i = tid; i < 9 * 1024; i += 512) { const int r = i >> 10, k = i & 1023; const float x = (r == 0) ? p.in[6][k] : p.in[2][(r - 1) * 1024 + k]; sv[k * 12 + r] = siluf_(x); }
                sv_ready = true; __syncthreads();
            }
            const int l = U / 96, j0 = (U % 96) * 64;
            const float* W = p.in[l ? 20 : 7]; const float* bias = p.in[l ? 21 : 8];
            float a[9];
#pragma unroll
            for (int r = 0; r < 9; ++r) a[r] = 0.f;
            const int kbeg = wave * 128;
#pragma unroll 16
            for (int k = kbeg; k < kbeg + 128; ++k) {
                const float w = W[(size_t)k * MODW + j0 + lane];
                const f32x4 s0 = *(const LAS f32x4*)(sv + k * 12), s1 = *(const LAS f32x4*)(sv + k * 12 + 4); const float s8 = sv[k * 12 + 8];
                a[0] += w * s0.x; a[1] += w * s0.y; a[2] += w * s0.z; a[3] += w * s0.w; a[4] += w * s1.x; a[5] += w * s1.y; a[6] += w * s1.z; a[7] += w * s1.w; a[8] += w * s8;
            }
#pragma unroll
            for (int r = 0; r < 9; ++r) red[(wave * 9 + r) * 64 + lane] = a[r];
            __syncthreads();
            for (int i = tid; i < 576; i += 512) { const int r = i >> 6, c = i & 63; float s = bias[j0 + c];
#pragma unroll
                for (int w = 0; w < 8; ++w) s += red[(w * 9 + r) * 64 + c];
                mod[(size_t)(l * 9 + r) * MODW + j0 + c] = s; }
            __syncthreads();
        }
    }
    GSYNC();

    const float* mod0 = mod; const float* mod1 = mod + 9 * MODW;
    { IDS(); norm_phase(p.in[0], p.in[1], nullptr, p.in[9], mod0 + 0, mod0 + 1024, H0, DM, gw, NGW, lane); }
    GSYNC();
    {
        pg8::Gemm g{H0, WIN0, 1024, 1024, NTOK, 2304, 1024}; pg8::StaticOrder S; S.init(NTOK, 2304, G, bid);
        EpiQKV0 E{Qb, KS, VTS, KP, VTP, p.out + OUT_NEWK, p.out + OUT_NEWV, p.in[11], p.in[12], p.in[13], p.in[14]};
        pg8::gemm_phase(lds, g, S, E);
        if (G == 256 && bid >= 96) {
            IDS();
            LAS float* scr = (LAS float*)(lds + wave * 8704);
            const int gw2 = (bid - 96) * 8 + wave, NGW2 = 160 * 8;
            transpose_matrix(p.in[16], 1024, 1024, WOUT0, scr, gw2, NGW2, lane);
            transpose_matrix(p.in[18], 1024, 4096, W1_0, scr, gw2, NGW2, lane);
            transpose_matrix(p.in[19], 4096, 1024, W2_0, scr, gw2, NGW2, lane);
            transpose_matrix(p.in[28], 1024, 1024, WOUT1, scr, gw2, NGW2, lane);
            const float* W = p.in[23]; const int nblk = 129, nitems = 16 * nblk;
            for (int it = gw2; it < nitems; it += NGW2) { const int kb = it / nblk, nb = it % nblk, n0 = nb * 32;
                if (n0 < 3072) transpose_item(W, 4128, kb * 64, n0, WQKV1, 1024, perm_row32(n0), scr, lane);
                else if (n0 < 4096) transpose_item(W, 4128, kb * 64, n0, WZ1, 1024, perm_row32(n0 - 3072), scr, lane);
                else transpose_item(W, 4128, kb * 64, n0, WQKV1, 1024, 3072, scr, lane); }
            u32x4* zp = (u32x4*)(WQKV1 + (size_t)3104 * 1024); const int nz = 224 * 1024 * 2 / 16;
            for (int i = (bid - 96) * 512 + tid; i < nz; i += 160 * 512) zp[i] = (u32x4){0u, 0u, 0u, 0u};
        }
    }
    GSYNC();
    { IDS();
      LAS float* sbias = (LAS float*)lds;
      for (int i = tid; i < 3720; i += 512) sbias[i] = p.in[15][i];
      __syncthreads();
      attention_phase(Qb, KS, VTS, KP, VTP, sbias, p.in[11], p.in[12], p.in[13], p.in[14], H0, gw, NGW, lane); }
#ifdef PROBE_ATTN
    GSYNC();
    { IDS(); attention_phase(Qb, KS, VTS, KP, VTP, (const LAS float*)lds, p.in[11], p.in[12], p.in[13], p.in[14], H0, gw, NGW, lane); }
#endif
    GSYNC();
    {
        pg8::Gemm g{H0, WOUT0, 1024, 1024, NTOK, 1024, 1024}; pg8::StaticOrder S; S.init(NTOK, 1024, G, bid);
        EpiRes E{p.in[0], p.in[1], XB, mod0 + 2048, nullptr, 0};
        pg8::gemm_phase(lds, g, S, E);
    }
    GSYNC();
    { IDS(); norm_phase(nullptr, nullptr, XB, p.in[17], mod0 + 3072, mod0 + 4096, HL, XBP, gw, NGW, lane); }
    GSYNC();
    {
        pg8::Gemm g{HL, W1_0, XBP, 1024, NTOK, 4096, 1024}; pg8::StaticOrder S; S.init(NTOK, 4096, G, bid);
        EpiBf16<1> E{FFL0, 4096};
        pg8::gemm_phase(lds, g, S, E);
    }
    GSYNC();
    W2_GEMM(FFL0, W2_0, mod0);
    GSYNC();
    { IDS(); norm_phase(nullptr, nullptr, XB, p.in[22], mod1 + 0, mod1 + 1024, H1, DM, gw, NGW, lane, (G == 256) ? Pside : nullptr); }
    GSYNC();
    {
        pg8::Gemm g{H1, WQKV1, 1024, 1024, NTOK, 4352, 1024}; pg8::StaticOrder S; S.init(NTOK, 4352, G, bid);
        EpiQKV1 E{QKV1, AB, HL, XBP, (bf16_t*)(ws + B_HALO)};
        pg8::gemm_phase(lds, g, S, E);
    }
    GSYNC();
    {
        const int nprep = (G == 256) ? 2560 : 3072;
#pragma unroll 1
        for (int U = bid; U < nprep; U += G) {
            int ch, h;
            if (G != 256) { ch = U >> 3; h = U & 7; }
            else if (U < 2048) { ch = 128 + (U >> 3); h = U & 7; }
            else { const int v = U - 2048; ch = v >> 2; h = 2 * (v & 3); }
            const int mrow = ch * 64;
            const int m0 = (mrow < NPR) ? (mrow & ~255) : NPR + ((mrow - NPR) & ~2047), T = (mrow < NPR) ? 256 : 2048;
            delta_prep_unit(lds, QKV1, (const bf16_t*)(ws + B_HALO), AB, p.in[24], p.in[25], p.in[26], m0, T, mrow - m0, h, OF, OB);
        }
    }
    GSYNC();
#ifdef PROBE_DELTA
    for (int rep = 0; rep < 2; ++rep)
#endif
    {
        float* news = p.out + OUT_NEWS;
#ifdef PROBE_DELTA
        if (rep) GSYNC();
#endif
        const bool bal = (G == 256);
        const int nun = bal ? (bid < 128 ? 1 : 4) : (640 - bid + G - 1) / G;
        if (bal && bid >= 128) {
            const int b = (bid - 128) >> 2, h1 = (((bid - 128) * 2) & 7) + 1;
#pragma unroll 1
            for (int c = 0; c < 4; ++c) delta_prep_unit(lds, QKV1, (const bf16_t*)(ws + B_HALO), AB, p.in[24], p.in[25], p.in[26], b * 256, 256, 64 * c, h1, OF, OB);
            asm volatile("s_waitcnt vmcnt(0)" ::: "memory");
            __builtin_amdgcn_fence(__ATOMIC_ACQUIRE, "agent");
            asm volatile("s_waitcnt vmcnt(0)" ::: "memory");
            __syncthreads();
        }
#pragma unroll 1
        for (int i = 0; i < nun; ++i) {
            const int U = bal ? (bid < 128 ? bid : 128 + (bid - 128) * 4 + i) : bid + i * G;
            delta_dispatch(lds, U, QKV1, AB, p.in[24], p.in[25], p.in[26], p.in[5], news, OF, OB);
        }
    }
    GSYNC();
    if (G != 256) {
        IDS();
        LAS float* scr = (LAS float*)(lds + wave * 8704);
        transpose_matrix(p.in[30], 1024, 4096, W1_1, scr, gw, NGW, lane);
        transpose_matrix(p.in[31], 4096, 1024, W2_1, scr, gw, NGW, lane);
    }
    { IDS(); y_phase(OF, OB, HL, XBP, p.in[27], gw, NGW, lane); }
    GSYNC();
    {
        pg8::Gemm g{OF, WOUT1, 1024, 1024, NTOK, 1024, 1024}; pg8::StaticOrder S; S.init(NTOK, 1024, G, bid);
        EpiRes E{nullptr, nullptr, XB, mod1 + 2048, nullptr, 0};
        pg8::gemm_phase(lds, g, S, E);
        if (G == 256 && bid >= 128) {
            IDS();
            LAS float* scr = (LAS float*)(lds + wave * 8704);
            const int gw2 = (bid - 128) * 8 + wave, NGW2 = 128 * 8;
            transpose_matrix(p.in[30], 1024, 4096, W1_1, scr, gw2, NGW2, lane);
            transpose_matrix(p.in[31], 4096, 1024, W2_1, scr, gw2, NGW2, lane);
        }
    }
    GSYNC();
    { IDS(); norm_phase(nullptr, nullptr, XB, p.in[29], mod1 + 3072, mod1 + 4096, HL, XBP, gw, NGW, lane); }
    GSYNC();
    {
        pg8::Gemm g{HL, W1_1, XBP, 1024, NTOK, 4096, 1024}; pg8::StaticOrder S; S.init(NTOK, 4096, G, bid);
        EpiBf16<1> E{FFL1, 4096};
        pg8::gemm_phase(lds, g, S, E);
    }
    GSYNC();
    W2_GEMM(FFL1, W2_1, mod1);
    {
        GSYNC();
        IDS();
        const bool fold = (G == 256);
        for (int m = gw; m < NTOK; m += NGW) {
            const bf16_t* xr = XB + (size_t)m * XBP + 16 * lane;
            const u32x4 w0 = *(const u32x4*)xr, w1 = *(const u32x4*)(xr + 8);
            f32x4 o[4] = {(f32x4){bflo(w0.x), bfhi(w0.x), bflo(w0.y), bfhi(w0.y)}, (f32x4){bflo(w0.z), bfhi(w0.z), bflo(w0.w), bfhi(w0.w)},
                          (f32x4){bflo(w1.x), bfhi(w1.x), bflo(w1.y), bfhi(w1.y)}, (f32x4){bflo(w1.z), bfhi(w1.z), bflo(w1.w), bfhi(w1.w)}};
            if (fold && m >= 16384) {
#pragma unroll
                for (int j = 0; j < 4; ++j) o[j] = o[j] + *(const f32x4*)(Pside + (size_t)(m - 16384) * DM + 16 * lane + 4 * j);
            }
            asm volatile("s_waitcnt vmcnt(0)" ::: "memory");
#pragma unroll
            for (int j = 0; j < 4; ++j) *(f32x4*)(Y + (size_t)m * DM + 16 * lane + 4 * j) = o[j];
        }
    }
}

extern "C" void kernel_launch(void* const* d_in, const int* in_sizes, int n_in, void* d_out, int out_size, void* d_ws, size_t ws_size, hipStream_t stream) {
    static int grid_blocks = 0;
    if (!grid_blocks) {
        if (n_in != 32 || ws_size < WS_NEED) { fprintf(stderr, "kernel_launch: unexpected n_in %d / ws_size %zu (need %zu)\n", n_in, ws_size, (size_t)WS_NEED); grid_blocks = -1; return; }
        int dev = 0, cus = 0, per_cu = 0;
        hipGetDevice(&dev);
        hipDeviceGetAttribute(&cus, hipDeviceAttributeMultiprocessorCount, dev);
        hipFuncSetAttribute((const void*)fwd_megakernel, hipFuncAttributeMaxDynamicSharedMemorySize, LDS_BYTES);
        hipOccupancyMaxActiveBlocksPerMultiprocessor(&per_cu, (const void*)fwd_megakernel, 512, LDS_BYTES);
        if (per_cu < 1) { fprintf(stderr, "kernel_launch: occupancy query returned %d\n", per_cu); per_cu = 1; }
        grid_blocks = cus * per_cu;
    }
    if (grid_blocks < 0) return;
    Params p{};
    for (int i = 0; i < 32; ++i) p.in[i] = (const float*)d_in[i];
    p.out = (float*)d_out; p.ws = (unsigned char*)d_ws;
    if (hipMemsetAsync((char*)d_ws + 524288, 0, XCD_BAR_WORDS * 4, stream) != hipSuccess) { fprintf(stderr, "kernel_launch: memset of barrier words failed\n"); return; }
    void* args[] = {&p};
    hipError_t e = hipLaunchCooperativeKernel((const void*)fwd_megakernel, dim3(grid_blocks), dim3(512), args, LDS_BYTES, stream);
    if (e != hipSuccess) fprintf(stderr, "cooperative launch failed: %s (grid %d)\n", hipGetErrorString(e), grid_blocks);
}
```
